# Optimizing an MI355X kernel written in HIP

```python
import math
import jax, jax.numpy as jnp
from jax import lax
import numpy as np

D_MODEL = 1024
BATCH = 16
SEQ = 256
DEPTH = 4
DEC_BATCH = 4
DEC_SEQ = 1024
PAST_LEN = 512

GRID_W = 64
N_MIXERS = 2
N_S5_LAYERS = (DEPTH + 1) // 2
N_ATTN_LAYERS = DEPTH // 2
GROUP_CH = 16
N_GROUPS = D_MODEL // GROUP_CH
STATE_DIM = 64
DT_MIN = 0.001
DT_MAX = 0.1
HEAD_DIM = 128
N_HEADS = D_MODEL // HEAD_DIM
N_KV_HEADS = 2
KV_REP = N_HEADS // N_KV_HEADS
D_Q = N_HEADS * HEAD_DIM
D_KV = N_KV_HEADS * HEAD_DIM
QKV_DIM = D_Q + 2 * D_KV
Q_BLOCK = 128
ROPE_THETA = 10000.0
AXIS_PAIRS = HEAD_DIM // 4
ATTN_SCALE = HEAD_DIM ** -0.5
D_FF = -(-8 * D_MODEL // (3 * 256)) * 256
DEEPNORM_ALPHA = (2.0 * DEPTH) ** 0.25
DEEPNORM_BETA = (8.0 * DEPTH) ** -0.25
LN_EPS = 1e-6
RMS_EPS = 1e-6

kernel_name = "hybrid_s5_gqa_prefix_diffusion_step"


def layer_norm(x, g, b):
    xf = x.astype(jnp.float32)
    mu = xf.mean(-1, keepdims=True)
    var = jnp.square(xf - mu).mean(-1, keepdims=True)
    return ((xf - mu) * lax.rsqrt(var + LN_EPS) * g + b).astype(x.dtype)


def rms_norm(x, g):
    xf = x.astype(jnp.float32)
    return (xf * lax.rsqrt(jnp.mean(xf * xf, -1, keepdims=True) + RMS_EPS) * g).astype(x.dtype)


def adaln(cvec, w_mod, b_mod):
    m = jax.nn.silu(cvec) @ w_mod + b_mod
    return jnp.split(m[:, None, :], 6, axis=-1)


def modulate(x, shift, scale):
    return x * (1.0 + scale) + shift


def swiglu(h, w_in, w_out):
    gate, up = jnp.split(h @ w_in, 2, axis=-1)
    return (jax.nn.silu(gate) * up) @ w_out


def s5_discretize(a_re, a_im, log_dt, b_re, b_im):
    dt = jnp.exp(log_dt)[:, None]
    mag = jnp.exp(dt * a_re)
    ab_re = mag * jnp.cos(dt * a_im)
    ab_im = mag * jnp.sin(dt * a_im)
    den = a_re * a_re + a_im * a_im
    nr = ab_re - 1.0
    k_re = (nr * a_re + ab_im * a_im) / den
    k_im = (ab_im * a_re - nr * a_im) / den
    bb_re = k_re[..., None] * b_re - k_im[..., None] * b_im
    bb_im = k_re[..., None] * b_im + k_im[..., None] * b_re
    return ab_re, ab_im, bb_re, bb_im


def _complex_affine_combine(e1, e2):
    a1r, a1i, b1r, b1i = e1
    a2r, a2i, b2r, b2i = e2
    return (a2r * a1r - a2i * a1i,
            a2r * a1i + a2i * a1r,
            a2r * b1r - a2i * b1i + b2r,
            a2r * b1i + a2i * b1r + b2i)


def s5_direction(u, h0_re, h0_im, a_re, a_im, log_dt, b_re, b_im, c_re, c_im, reverse):
    ab_re, ab_im, bb_re, bb_im = s5_discretize(a_re, a_im, log_dt, b_re, b_im)
    bu_re = jnp.einsum('blgh,gph->blgp', u, bb_re)
    bu_im = jnp.einsum('blgh,gph->blgp', u, bb_im)
    if reverse:
        bu_re, bu_im = jnp.flip(bu_re, 1), jnp.flip(bu_im, 1)
    bu_re = bu_re.at[:, 0].add(ab_re * h0_re - ab_im * h0_im)
    bu_im = bu_im.at[:, 0].add(ab_re * h0_im + ab_im * h0_re)
    ar = jnp.broadcast_to(ab_re, bu_re.shape)
    ai = jnp.broadcast_to(ab_im, bu_im.shape)
    _, _, s_re, s_im = lax.associative_scan(_complex_affine_combine, (ar, ai, bu_re, bu_im), axis=1)
    fin_re, fin_im = s_re[:, -1], s_im[:, -1]
    if reverse:
        s_re, s_im = jnp.flip(s_re, 1), jnp.flip(s_im, 1)
    y = jnp.einsum('blgp,ghp->blgh', s_re, c_re) - jnp.einsum('blgp,ghp->blgh', s_im, c_im)
    return y, fin_re, fin_im


def s5_mixer(h, h0, w_in, a_re, a_im, log_dt, b_re, b_im, c_re, c_im, d_skip, w_glu, w_out):
    b, l, _ = h.shape
    u = (h @ w_in).reshape(b, l, N_GROUPS, GROUP_CH)
    y = d_skip.reshape(N_GROUPS, GROUP_CH) * u
    finals = []
    for d in range(2):
        yd, fr, fi = s5_direction(u, h0[:, d, 0], h0[:, d, 1], a_re[d], a_im[d], log_dt[d],
                                  b_re[d], b_im[d], c_re[d], c_im[d], reverse=(d == 1))
        y = y + yd
        finals.append(jnp.stack([fr, fi], axis=1))
    z = jax.nn.gelu(y.reshape(b, l, D_MODEL))
    val, gate = jnp.split(z @ w_glu, 2, axis=-1)
    return (val * jax.nn.sigmoid(gate)) @ w_out, jnp.stack(finals, axis=1)


def attn_project(h, w_qkv, q_gain, k_gain):
    b, l, _ = h.shape
    qkv = h @ w_qkv
    q = qkv[..., :D_Q].reshape(b, l, N_HEADS, HEAD_DIM)
    k = qkv[..., D_Q:D_Q + D_KV].reshape(b, l, N_KV_HEADS, HEAD_DIM)
    v = qkv[..., D_Q + D_KV:].reshape(b, l, N_KV_HEADS, HEAD_DIM)
    return rms_norm(q, q_gain), rms_norm(k, k_gain), v


def _rotate(x, ang):
    cos = jnp.cos(ang)[:, None, :].astype(x.dtype)
    sin = jnp.sin(ang)[:, None, :].astype(x.dtype)
    x1, x2 = x[..., :AXIS_PAIRS], x[..., AXIS_PAIRS:]
    return jnp.concatenate([x1 * cos - x2 * sin, x2 * cos + x1 * sin], axis=-1)


def axial_rope(x):
    l = x.shape[1]
    rows = l // GRID_W
    row = jnp.repeat(jnp.arange(rows, dtype=jnp.float32), GRID_W)
    col = jnp.tile(jnp.arange(GRID_W, dtype=jnp.float32), rows)
    inv = ROPE_THETA ** (-jnp.arange(AXIS_PAIRS, dtype=jnp.float32) / AXIS_PAIRS)
    half = HEAD_DIM // 2
    return jnp.concatenate([_rotate(x[..., :half], row[:, None] * inv),
                            _rotate(x[..., half:], col[:, None] * inv)], axis=-1)


def blocked_attention(q, k, v):
    b, lq = q.shape[0], q.shape[1]
    nb = lq // Q_BLOCK
    qb = q.reshape(b, nb, Q_BLOCK, N_KV_HEADS, KV_REP, HEAD_DIM).transpose(1, 0, 2, 3, 4, 5)

    def one_block(qblk):
        s = jnp.einsum('bqgrd,bkgd->bgrqk', qblk, k).astype(jnp.float32) * ATTN_SCALE
        p = jax.nn.softmax(s, axis=-1).astype(v.dtype)
        return jnp.einsum('bgrqk,bkgd->bqgrd', p, v)

    o = lax.map(one_block, qb)
    return o.transpose(1, 0, 2, 3, 4, 5).reshape(b, lq, D_Q)


def setup_inputs(seed: int = 0) -> dict:
    key = jax.random.key(seed)
    ks = jax.random.split(key, 32)
    f32 = jnp.float32

    def nrm(k, shape, s=1.0):
        return s * jax.random.normal(k, shape, f32)

    s5_shape = (N_S5_LAYERS, 2, N_GROUPS, STATE_DIM)
    n_idx = jnp.arange(STATE_DIM, dtype=f32)
    return {
        "x_prompt": nrm(ks[0], (BATCH, SEQ, D_MODEL)),
        "x_sample": nrm(ks[1], (DEC_BATCH, DEC_SEQ, D_MODEL)),
        "c": nrm(ks[2], (DEC_BATCH, D_MODEL)),
        "cache_k": nrm(ks[3], (DEC_BATCH, N_ATTN_LAYERS, PAST_LEN, N_KV_HEADS, HEAD_DIM)),
        "cache_v": nrm(ks[4], (DEC_BATCH, N_ATTN_LAYERS, PAST_LEN, N_KV_HEADS, HEAD_DIM)),
        "state_s5": nrm(ks[5], (DEC_BATCH, N_S5_LAYERS, 2, 2, N_GROUPS, STATE_DIM), 0.1),
        "c_ctx": nrm(ks[6], (D_MODEL,)),
        "w_mod": nrm(ks[7], (DEPTH, D_MODEL, 6 * D_MODEL), 0.5 * D_MODEL ** -0.5),
        "b_mod": nrm(ks[8], (DEPTH, 6 * D_MODEL), 0.01),
        "ln_g": 1.0 + nrm(ks[9], (DEPTH, 2, D_MODEL), 0.02),
        "ln_b": nrm(ks[10], (DEPTH, 2, D_MODEL), 0.02),
        "w_s5_in": nrm(ks[11], (N_S5_LAYERS, D_MODEL, D_MODEL), D_MODEL ** -0.5),
        "s5_a_re": -0.5 * jnp.exp(nrm(ks[12], s5_shape, 0.05)),
        "s5_a_im": jnp.pi * n_idx + nrm(ks[13], s5_shape, 0.01),
        "s5_log_dt": jax.random.uniform(ks[14], (N_S5_LAYERS, 2, N_GROUPS), f32,
                                        math.log(DT_MIN), math.log(DT_MAX)),
        "s5_b_re": nrm(ks[15], (N_S5_LAYERS, 2, N_GROUPS, STATE_DIM, GROUP_CH), (2 * GROUP_CH) ** -0.5),
        "s5_b_im": nrm(ks[16], (N_S5_LAYERS, 2, N_GROUPS, STATE_DIM, GROUP_CH), (2 * GROUP_CH) ** -0.5),
        "s5_c_re": nrm(ks[17], (N_S5_LAYERS, 2, N_GROUPS, GROUP_CH, STATE_DIM), STATE_DIM ** -0.5),
        "s5_c_im": nrm(ks[18], (N_S5_LAYERS, 2, N_GROUPS, GROUP_CH, STATE_DIM), STATE_DIM ** -0.5),
        "s5_d": nrm(ks[19], (N_S5_LAYERS, D_MODEL)),
        "w_s5_glu": nrm(ks[20], (N_S5_LAYERS, D_MODEL, 2 * D_MODEL), D_MODEL ** -0.5),
        "w_s5_out": nrm(ks[21], (N_S5_LAYERS, D_MODEL, D_MODEL), DEEPNORM_BETA * D_MODEL ** -0.5),
        "w_qkv": nrm(ks[22], (N_ATTN_LAYERS, D_MODEL, QKV_DIM), D_MODEL ** -0.5),
        "q_norm_g": 1.0 + nrm(ks[23], (N_ATTN_LAYERS, HEAD_DIM), 0.02),
        "k_norm_g": 1.0 + nrm(ks[24], (N_ATTN_LAYERS, HEAD_DIM), 0.02),
        "w_o": nrm(ks[25], (N_ATTN_LAYERS, D_Q, D_MODEL), DEEPNORM_BETA * D_Q ** -0.5),
        "w_ffn_in": nrm(ks[26], (DEPTH, D_MODEL, 2 * D_FF), D_MODEL ** -0.5),
        "w_ffn_out": nrm(ks[27], (DEPTH, D_FF, D_MODEL), DEEPNORM_BETA * D_FF ** -0.5),
    }


def reference(x_prompt, x_sample, c, cache_k, cache_v, state_s5, c_ctx, w_mod, b_mod, ln_g, ln_b,
              w_s5_in, s5_a_re, s5_a_im, s5_log_dt, s5_b_re, s5_b_im, s5_c_re, s5_c_im, s5_d,
              w_s5_glu, w_s5_out, w_qkv, q_norm_g, k_norm_g, w_o, w_ffn_in, w_ffn_out):
    xp, xs = x_prompt, x_sample
    ctx_state0 = jnp.zeros((xp.shape[0], 2, 2, N_GROUPS, STATE_DIM), xp.dtype)
    new_k, new_v, new_s = [], [], []
    for layer in range(DEPTH):
        j = layer // N_MIXERS
        sh1p, sc1p, g1p, sh2p, sc2p, g2p = adaln(c_ctx[None, :], w_mod[layer], b_mod[layer])
        sh1s, sc1s, g1s, sh2s, sc2s, g2s = adaln(c, w_mod[layer], b_mod[layer])
        hp = modulate(xp, sh1p, sc1p)
        hs = modulate(xs, sh1s, sc1s)
        if layer % N_MIXERS == 0:
            prm = (w_s5_in[j], s5_a_re[j], s5_a_im[j], s5_log_dt[j], s5_b_re[j], s5_b_im[j],
                   s5_c_re[j], s5_c_im[j], s5_d[j], w_s5_glu[j], w_s5_out[j])
            mp, fin = s5_mixer(hp, ctx_state0, *prm)
            ms, _ = s5_mixer(hs, state_s5[:, j], *prm)
            new_s.append(fin)
        else:
            qp, kp, vp = attn_project(hp, w_qkv[j], q_norm_g[j], k_norm_g[j])
            mp = blocked_attention(qp, kp, vp) @ w_o[j]
            qs, ks_, vs = attn_project(hs, w_qkv[j], q_norm_g[j], k_norm_g[j])
            qs, ks_ = axial_rope(qs), axial_rope(ks_)
            k_all = jnp.concatenate([ks_, cache_k[:, j]], axis=1)
            v_all = jnp.concatenate([vs, cache_v[:, j]], axis=1)
            ms = blocked_attention(qs, k_all, v_all) @ w_o[j]
            new_k.append(kp)
            new_v.append(vp)
        xp = layer_norm(DEEPNORM_ALPHA * xp + g1p * mp, ln_g[layer, 0], ln_b[layer, 0])
        xs = layer_norm(DEEPNORM_ALPHA * xs + g1s * ms, ln_g[layer, 0], ln_b[layer, 0])
        fp = swiglu(modulate(xp, sh2p, sc2p), w_ffn_in[layer], w_ffn_out[layer])
        fs = swiglu(modulate(xs, sh2s, sc2s), w_ffn_in[layer], w_ffn_out[layer])
        xp = layer_norm(DEEPNORM_ALPHA * xp + g2p * fp, ln_g[layer, 1], ln_b[layer, 1])
        xs = layer_norm(DEEPNORM_ALPHA * xs + g2s * fs, ln_g[layer, 1], ln_b[layer, 1])
    y_prompt, y_sample = xp, xs
    new_cache_k = jnp.stack(new_k, axis=1)
    new_cache_v = jnp.stack(new_v, axis=1)
    new_state_s5 = jnp.stack(new_s, axis=1)
    return (y_prompt, y_sample, new_cache_k, new_cache_v, new_state_s5)
```

```cpp
#include <hip/hip_runtime.h>
#include <hip/hip_cooperative_groups.h>
#include <cstdio>
#include <cstdint>
namespace cg = cooperative_groups;

#define DEVI __device__ __forceinline__
#define LAS __attribute__((address_space(3)))
typedef unsigned short bf16_t;
typedef short bf16x8 __attribute__((ext_vector_type(8)));
typedef float f32x4 __attribute__((ext_vector_type(4)));
typedef float f32x2 __attribute__((ext_vector_type(2)));
typedef unsigned u32x4 __attribute__((ext_vector_type(4)));
typedef unsigned u32x2 __attribute__((ext_vector_type(2)));

constexpr int DM = 1024, NROW = 8192, NPR = 4096, DFF = 2816;
constexpr float ALPHA = 1.681792830507429f;
constexpr float LN_EPS = 1e-6f, RMS_EPS = 1e-6f;
constexpr float SM_C = 0.08838834764831845f * 1.4426950408889634f;

constexpr size_t OUT_Y = 0, OUT_K = 8388608, OUT_V = 10485760, OUT_S = 12582912;

constexpr size_t al256(size_t x) { return (x + 255) & ~(size_t)255; }
constexpr size_t WS_BAR = 0;
constexpr size_t WS_WT_S5IN = 16384;
constexpr size_t WS_WT_GLU = WS_WT_S5IN + 2ull * 1024 * 1024 * 2;
constexpr size_t WS_WT_S5OUT = WS_WT_GLU + 2ull * 2048 * 1024 * 2;
constexpr size_t WS_WT_QKV = WS_WT_S5OUT + 2ull * 1024 * 1024 * 2;
constexpr size_t WS_WT_O = WS_WT_QKV + 2ull * 1536 * 1024 * 2;
constexpr size_t WS_WT_FFNIN = WS_WT_O + 2ull * 1024 * 1024 * 2;
constexpr size_t WS_WT_FFNOUT = WS_WT_FFNIN + 4ull * 5632 * 1024 * 2;
constexpr size_t WS_MG = WS_WT_FFNOUT + 4ull * 1024 * 2816 * 2;
constexpr size_t WS_VG = WS_MG + 2ull * 64 * 512 * 256 * 2;
constexpr size_t WS_LAM16 = WS_VG + 2ull * 64 * 256 * 256 * 2;
constexpr size_t WS_MOD = WS_LAM16 + 2ull * 2 * 64 * 64 * 2 * 4;
constexpr size_t WS_ROPE = WS_MOD + al256(4ull * 5 * 6144 * 4);
constexpr size_t WS_KS = WS_ROPE + 64ull * 32 * 2 * 4;
constexpr size_t KS_LAYER = 4ull * 2 * 1536 * 128 * 2;
constexpr size_t WS_VTS = WS_KS + 2 * KS_LAYER;
constexpr size_t WS_KP = WS_VTS + 2 * KS_LAYER;
constexpr size_t WS_VTP = WS_KP + 16ull * 2 * 256 * 128 * 2;
constexpr size_t WS_X = WS_VTP + 16ull * 2 * 256 * 128 * 2;
constexpr size_t WS_T = WS_X + (size_t)NROW * DM * 4;
constexpr size_t WS_H = WS_T + (size_t)NROW * DM * 4;
constexpr size_t WS_BUFA = WS_H + (size_t)NROW * DM * 2;
constexpr size_t WS_BUFB = WS_BUFA + (size_t)NROW * DM * 2;
constexpr size_t WS_ACT = WS_BUFB + (size_t)NROW * DM * 2;
constexpr size_t WS_SL = WS_ACT + (size_t)NROW * DFF * 2;
constexpr size_t WS_PART = WS_SL + (size_t)NROW * DM * 4;
constexpr size_t WS_END = WS_PART + 8 * (size_t)NROW * 16 * 2 * 4;

constexpr int NTHR = 512;
constexpr int LROW = 144;
constexpr int A_TILE_B = 256 * LROW, B_TILE_B = 128 * LROW, STAGE_B = A_TILE_B + B_TILE_B;
constexpr int LDS_RED = 3 * (256 * 128 + 128 * 128);
constexpr int LDS_XB = LDS_RED + 4096;
constexpr int LDS_BYTES = LDS_XB + 64;

struct Params {
    const float* in[28];
    float* out;
    unsigned char* ws;
    int ph_lo, ph_hi;
};
typedef const __attribute__((address_space(4))) Params* PP;

typedef __bf16 bf16v2 __attribute__((ext_vector_type(2)));
DEVI unsigned cvt_pk(float lo, float hi) { f32x2 v = {lo, hi}; bf16v2 b = __builtin_convertvector(v, bf16v2); return __builtin_bit_cast(unsigned, b); }
DEVI u32x2 pack4(f32x4 v) { u32x2 r; r.x = cvt_pk(v.x, v.y); r.y = cvt_pk(v.z, v.w); return r; }
DEVI float sigmoidf_(float x) { return 1.f / (1.f + __expf(-x)); }
DEVI float siluf_(float x) { return x / (1.f + __expf(-x)); }
DEVI float gelu_tanh(float y) { const float a = 0.7978845608028654f * (y + 0.044715f * y * y * y); const float th = 1.f - 2.f / (__expf(2.f * a) + 1.f); return 0.5f * y * (1.f + th); }

#define XB_TMO      128
#define XB_XCNT(j)  (256  + 64 * (j))
#define XB_XSUB(j)  (1280 + 64 * (j))
#define XB_XGEN(j)  (2304 + 64 * (j))
#define XB_TOP      3328
#define XB_TOPGEN   3392
#define XCD_BAR_WORDS 3456
#define XB_SPIN_CAP (1u << 22)
#define WAITV(n) asm volatile("s_waitcnt vmcnt(" #n ")" ::: "memory")
DEVI unsigned xb_ld(unsigned* p)              { return __hip_atomic_load(p, __ATOMIC_RELAXED, __HIP_MEMORY_SCOPE_AGENT); }
DEVI unsigned xb_add(unsigned* p, unsigned v) { return __hip_atomic_fetch_add(p, v, __ATOMIC_RELAXED, __HIP_MEMORY_SCOPE_AGENT); }
DEVI unsigned xb_xcc_id() { return (unsigned)__builtin_amdgcn_s_getreg((3 << 11) | 20) & 0xFu; }
#define XB_SPIN(cond, bar) do { unsigned _sp = 0; while (cond) { __builtin_amdgcn_s_sleep(1); \
    if ((++_sp & 255u) == 0u) { if (xb_ld(&(bar)[XB_TMO])) break; if (_sp > XB_SPIN_CAP) { atomicAdd(&(bar)[XB_TMO], 1u); break; } } } } while (0)
struct XcdBarrier { unsigned* bar; unsigned x; volatile LAS unsigned* st; };
DEVI XcdBarrier xcd_barrier_post(unsigned* bar, volatile LAS unsigned* st) {
    XcdBarrier b; b.bar = bar; b.x = xb_xcc_id(); b.st = st;
    if (threadIdx.x == 0) (void)xb_add(&bar[XB_XCNT(b.x)], 1u);
    return b;
}
DEVI void xcd_barrier_complete(unsigned* bar, unsigned x, unsigned& nloc, unsigned& nx) {
    const unsigned G = gridDim.x * gridDim.y * gridDim.z;
    unsigned sum, cnt, mine, sp = 0u;
    for (;;) {
        sum = 0u; cnt = 0u; mine = 0u;
#pragma unroll
        for (unsigned j = 0; j < 16; ++j) { const unsigned c = xb_ld(&bar[XB_XCNT(j)]); sum += c; cnt += (c > 0u) ? 1u : 0u; mine = (j == x) ? c : mine; }
        if (sum == G) break;
        __builtin_amdgcn_s_sleep(1);
        if ((++sp & 255u) == 0u) { if (xb_ld(&bar[XB_TMO])) break; if (sp > XB_SPIN_CAP) { atomicAdd(&bar[XB_TMO], 1u); break; } }
    }
    nloc = mine > 0u ? mine : 1u; nx = cnt > 0u ? cnt : 1u;
}
DEVI void xcd_barrier(const XcdBarrier& b) {
    asm volatile("s_waitcnt vmcnt(0)" ::: "memory");
    __syncthreads();
    if (threadIdx.x == 0) {
        unsigned* bar = b.bar;
        __builtin_amdgcn_s_waitcnt(0);
        unsigned nloc = b.st[0], nx = b.st[1];
        if (nloc == 0u) { xcd_barrier_complete(bar, b.x, nloc, nx); b.st[0] = nloc; b.st[1] = nx; }
        const unsigned old = xb_add(&bar[XB_XSUB(b.x)], 1u);
        const unsigned gen = old / nloc;
        if (old + 1u == (gen + 1u) * nloc) {
            __builtin_amdgcn_fence(__ATOMIC_RELEASE, "agent");
            asm volatile("s_waitcnt vmcnt(0)" ::: "memory");
            const unsigned og = xb_add(&bar[XB_TOP], 1u);
            const unsigned tg = og / nx;
            if (og + 1u == (tg + 1u) * nx) xb_add(&bar[XB_TOPGEN], 1u);
            else XB_SPIN(xb_ld(&bar[XB_TOPGEN]) == tg, bar);
            __builtin_amdgcn_fence(__ATOMIC_ACQUIRE, "agent");
            xb_add(&bar[XB_XGEN(b.x)], 1u);
            asm volatile("s_waitcnt vmcnt(0)" ::: "memory");
        } else {
            XB_SPIN(xb_ld(&bar[XB_XGEN(b.x)]) == gen, bar);
            __builtin_amdgcn_fence(__ATOMIC_ACQUIRE, "agent");
            asm volatile("s_waitcnt vmcnt(0)" ::: "memory");
        }
    }
    __syncthreads();
}

DEVI int tid_() { int t = threadIdx.x; asm volatile("" : "+v"(t)); return t; }
DEVI int bid_() { int b = blockIdx.x; asm volatile("" : "+s"(b)); return b; }
#ifndef PF_DIST
#define PF_DIST 2
#endif
constexpr int GA_B = 256 * 128, GB_B = 128 * 128, GSTAGE = GA_B + GB_B, GNST = 3;
template <class Epi>
DEVI void gemm_tile(const bf16_t* __restrict__ A, size_t lda, const bf16_t* __restrict__ Bt, size_t ldb, int K, unsigned char* lds, Epi epi, int koff = 0) {
    const int tid = tid_(), lane = tid & 63, w = tid >> 6, wr = w >> 1, wc = w & 1, fr = lane & 15, fq = lane >> 4;
    f32x4 acc[4][4];
#pragma unroll
    for (int i = 0; i < 4; ++i)
#pragma unroll
        for (int n = 0; n < 4; ++n) acc[i][n] = (f32x4){0.f, 0.f, 0.f, 0.f};
    const int lr8 = lane >> 3, pch = lane & 7;
    const bf16_t* ga[4]; const bf16_t* gb[2];
#pragma unroll
    for (int i = 0; i < 4; ++i) { const int row = (i * 8 + w) * 8 + lr8; ga[i] = A + (size_t)row * lda + ((pch ^ ((row >> 1) & 7)) * 8); }
#pragma unroll
    for (int i = 0; i < 2; ++i) { const int row = (i * 8 + w) * 8 + lr8; gb[i] = Bt + (size_t)row * ldb + ((pch ^ ((row >> 1) & 7)) * 8); }
    const int dofs = w * 1024 + lane * 16;
    const int nk = K >> 6;
    const unsigned ldsbase = (unsigned)(uintptr_t)(LAS unsigned char*)lds;
    const int sx = fr >> 1;
    const int aofs0 = (wr * 64 + fr) * 128 + ((fq ^ sx) * 16), aofs1 = (wr * 64 + fr) * 128 + (((4 + fq) ^ sx) * 16);
    const int bofs0 = GA_B + (wc * 64 + fr) * 128 + ((fq ^ sx) * 16), bofs1 = GA_B + (wc * 64 + fr) * 128 + (((4 + fq) ^ sx) * 16);
#define GEMM_ISSUE(stage, kt_) do { unsigned char* _sb = lds + (stage) * GSTAGE + dofs; int _kk = (kt_) + koff; if (_kk >= nk) _kk -= nk; const int _ko = _kk * 64; \
        _Pragma("unroll") for (int _i = 0; _i < 4; ++_i) __builtin_amdgcn_global_load_lds((const unsigned*)(ga[_i] + _ko), (LAS unsigned*)(LAS unsigned char*)(_sb + _i * 8192), 16, 0, 0); \
        _Pragma("unroll") for (int _i = 0; _i < 2; ++_i) __builtin_amdgcn_global_load_lds((const unsigned*)(gb[_i] + _ko), (LAS unsigned*)(LAS unsigned char*)(_sb + GA_B + _i * 8192), 16, 0, 0); } while (0)
    WAITV(0);
    __builtin_amdgcn_s_barrier();
    GEMM_ISSUE(0, 0);
#if PF_DIST == 2
    if (nk > 1) GEMM_ISSUE(1, 1);
#endif
    int st = 0;
    for (int kt = 0; kt < nk; ++kt) {
#if PF_DIST == 2
        if (kt + 1 < nk) WAITV(6); else WAITV(0);
#else
        WAITV(0);
#endif
        __builtin_amdgcn_s_barrier();
        const unsigned sb = ldsbase + st * GSTAGE;
        bf16x8 af[2][4], bfr[2][4];
#define DSR(dst, addr, off) asm volatile("ds_read_b128 %0, %1 offset:%2" : "=v"(dst) : "v"(addr), "n"(off))
        { const unsigned ab0 = sb + bofs0, aa0 = sb + aofs0, ab1 = sb + bofs1, aa1 = sb + aofs1;
          DSR(bfr[0][0], ab0, 0); DSR(bfr[0][1], ab0, 2048); DSR(bfr[0][2], ab0, 4096); DSR(bfr[0][3], ab0, 6144);
          DSR(af[0][0], aa0, 0); DSR(af[0][1], aa0, 2048); DSR(af[0][2], aa0, 4096); DSR(af[0][3], aa0, 6144);
          DSR(bfr[1][0], ab1, 0); DSR(bfr[1][1], ab1, 2048); DSR(bfr[1][2], ab1, 4096); DSR(bfr[1][3], ab1, 6144);
          DSR(af[1][0], aa1, 0); DSR(af[1][1], aa1, 2048); DSR(af[1][2], aa1, 4096);
          asm volatile("s_waitcnt lgkmcnt(7)" : "+v"(bfr[0][0]), "+v"(bfr[0][1]), "+v"(bfr[0][2]), "+v"(bfr[0][3]), "+v"(af[0][0]), "+v"(af[0][1]), "+v"(af[0][2]), "+v"(af[0][3]));
          DSR(af[1][3], aa1, 6144); }
        __builtin_amdgcn_s_setprio(1);
#pragma unroll
        for (int i = 0; i < 4; ++i)
#pragma unroll
            for (int n = 0; n < 4; ++n) acc[i][n] = __builtin_amdgcn_mfma_f32_16x16x32_bf16(bfr[0][n], af[0][i], acc[i][n], 0, 0, 0);
        __builtin_amdgcn_s_setprio(0);
        __builtin_amdgcn_sched_barrier(0);
#if PF_DIST == 2
        if (kt + 2 < nk) { const int s2 = st >= 1 ? st - 1 : 2; GEMM_ISSUE(s2, kt + 2); }
#else
        if (kt + 1 < nk) { const int s2 = st == 2 ? 0 : st + 1; GEMM_ISSUE(s2, kt + 1); }
#endif
        __builtin_amdgcn_sched_barrier(0);
        asm volatile("s_waitcnt lgkmcnt(0)" : "+v"(bfr[1][0]), "+v"(bfr[1][1]), "+v"(bfr[1][2]), "+v"(bfr[1][3]), "+v"(af[1][0]), "+v"(af[1][1]), "+v"(af[1][2]), "+v"(af[1][3]));
        __builtin_amdgcn_s_setprio(1);
#pragma unroll
        for (int i = 0; i < 4; ++i)
#pragma unroll
            for (int n = 0; n < 4; ++n) acc[i][n] = __builtin_amdgcn_mfma_f32_16x16x32_bf16(bfr[1][n], af[1][i], acc[i][n], 0, 0, 0);
        __builtin_amdgcn_s_setprio(0);
        st = st == 2 ? 0 : st + 1;
    }
    epi(acc, wr, wc, fr, fq);
}

constexpr int H_HALF = 256 * 64, HSTAGE = 2 * H_HALF;
template <class Epi>
DEVI void gemm_tile256(const bf16_t* __restrict__ A, size_t lda, const bf16_t* __restrict__ Bt, size_t ldb, int K, unsigned char* lds, Epi epi) {
    const int tid = tid_(), lane = tid & 63, w = tid >> 6, wr = w >> 2, wc = w & 3, fr = lane & 15, fq = lane >> 4;
    f32x4 acc[8][4];
#pragma unroll
    for (int i = 0; i < 8; ++i)
#pragma unroll
        for (int n = 0; n < 4; ++n) acc[i][n] = (f32x4){0.f, 0.f, 0.f, 0.f};
    const int lr4 = lane >> 2, pch = lane & 3;
    const bf16_t* ga[2]; const bf16_t* gb[2];
#pragma unroll
    for (int i = 0; i < 2; ++i) { const int row = (i * 8 + w) * 16 + lr4; const int lch = pch ^ ((0x1320 >> (((row >> 2) & 3) * 4)) & 3); ga[i] = A + (size_t)row * lda + lch * 8; gb[i] = Bt + (size_t)row * ldb + lch * 8; }
    const int dofs = w * 1024 + lane * 16;
    const int nk = K >> 5;
    const unsigned ldsbase = (unsigned)(uintptr_t)(LAS unsigned char*)lds;
    const int pcs = (fq ^ ((0x1320 >> (((fr >> 2) & 3) * 4)) & 3)) * 16;
    const int aofs = (wr * 128 + fr) * 64 + pcs, bofs = H_HALF + (wc * 64 + fr) * 64 + pcs;
#define H_ISSUE(stage, kt_) do { unsigned char* _sb = lds + (stage) * HSTAGE + dofs; const int _ko = (kt_) * 32; \
        _Pragma("unroll") for (int _i = 0; _i < 2; ++_i) __builtin_amdgcn_global_load_lds((const unsigned*)(ga[_i] + _ko), (LAS unsigned*)(LAS unsigned char*)(_sb + _i * 8192), 16, 0, 0); \
        _Pragma("unroll") for (int _i = 0; _i < 2; ++_i) __builtin_amdgcn_global_load_lds((const unsigned*)(gb[_i] + _ko), (LAS unsigned*)(LAS unsigned char*)(_sb + H_HALF + _i * 8192), 16, 0, 0); } while (0)
#define DSR2(dst, addr, off) asm volatile("ds_read_b128 %0, %1 offset:%2" : "=v"(dst) : "v"(addr), "n"(off))
    const int wu = __builtin_amdgcn_readfirstlane(w);
    bf16x8 af[8], bfr[4];
#define H_READS(stg) do { const unsigned sa = ldsbase + (stg) * HSTAGE + aofs, sb = ldsbase + (stg) * HSTAGE + bofs; \
        DSR2(bfr[0], sb, 0); DSR2(bfr[1], sb, 1024); DSR2(bfr[2], sb, 2048); DSR2(bfr[3], sb, 3072); \
        DSR2(af[0], sa, 0); DSR2(af[1], sa, 1024); DSR2(af[2], sa, 2048); DSR2(af[3], sa, 3072); \
        DSR2(af[4], sa, 4096); DSR2(af[5], sa, 5120); DSR2(af[6], sa, 6144); DSR2(af[7], sa, 7168); } while (0)
#define H_WAIT_LO(n_) asm volatile("s_waitcnt lgkmcnt(" #n_ ")" : "+v"(bfr[0]), "+v"(bfr[1]), "+v"(bfr[2]), "+v"(bfr[3]), "+v"(af[0]), "+v"(af[1]), "+v"(af[2]), "+v"(af[3]))
#define H_WAIT_HI() asm volatile("s_waitcnt lgkmcnt(0)" : "+v"(af[4]), "+v"(af[5]), "+v"(af[6]), "+v"(af[7]))
#define H_MMA2(i0) do { __builtin_amdgcn_s_setprio(1); \
        _Pragma("unroll") for (int i = (i0); i < (i0) + 2; ++i) _Pragma("unroll") for (int n = 0; n < 4; ++n) acc[i][n] = __builtin_amdgcn_mfma_f32_16x16x32_bf16(bfr[n], af[i], acc[i][n], 0, 0, 0); \
        __builtin_amdgcn_s_setprio(0); __builtin_amdgcn_sched_barrier(0); } while (0)
#define H_PIECE(stage, kt_, j_) do { if ((kt_) < nk) { unsigned char* _sb = lds + (stage) * HSTAGE + dofs; const int _ko = (kt_) * 32; \
        if ((j_) < 2) __builtin_amdgcn_global_load_lds((const unsigned*)(ga[(j_) & 1] + _ko), (LAS unsigned*)(LAS unsigned char*)(_sb + ((j_) & 1) * 8192), 16, 0, 0); \
        else __builtin_amdgcn_global_load_lds((const unsigned*)(gb[(j_) & 1] + _ko), (LAS unsigned*)(LAS unsigned char*)(_sb + H_HALF + ((j_) & 1) * 8192), 16, 0, 0); } \
        __builtin_amdgcn_sched_barrier(0); } while (0)
#define H_SCHED() __builtin_amdgcn_sched_barrier(0)
    WAITV(0);
    __builtin_amdgcn_s_barrier();
    H_ISSUE(0, 0); H_ISSUE(1, 1); H_ISSUE(2, 2);
    if (wu < 4) {
        for (int kt = 0; kt < nk; ++kt) {
            if (kt + 2 < nk) WAITV(8); else if (kt + 1 < nk) WAITV(4); else WAITV(0);
            __builtin_amdgcn_s_barrier();
            const int s3 = (kt + 3) & 3;
            H_READS(kt & 3); H_SCHED();
            H_WAIT_LO(4);
            H_MMA2(0); H_PIECE(s3, kt + 3, 0);
            H_MMA2(2); H_PIECE(s3, kt + 3, 1);
            H_WAIT_HI();
            H_MMA2(4); H_PIECE(s3, kt + 3, 2);
            H_MMA2(6); H_PIECE(s3, kt + 3, 3);
        }
    } else {
        for (int kt = 0; kt < nk; ++kt) {
            if (kt + 2 < nk) WAITV(8); else if (kt + 1 < nk) WAITV(4); else WAITV(0);
            __builtin_amdgcn_s_barrier();
            const int s3 = (kt + 3) & 3;
            if (kt > 0) {
                H_MMA2(0); H_PIECE(s3, kt + 3, 0);
                H_MMA2(2); H_PIECE(s3, kt + 3, 1);
                H_MMA2(4); H_PIECE(s3, kt + 3, 2);
                H_MMA2(6); H_PIECE(s3, kt + 3, 3);
            } else { H_PIECE(s3, kt + 3, 0); H_PIECE(s3, kt + 3, 1); H_PIECE(s3, kt + 3, 2); H_PIECE(s3, kt + 3, 3); }
            H_READS(kt & 3); H_SCHED();
            H_WAIT_LO(0); H_WAIT_HI();
            H_SCHED();
        }
        H_MMA2(0); H_MMA2(2); H_MMA2(4); H_MMA2(6);
    }
    epi(acc, wr, wc, fr, fq);
}

DEVI int p8_lds_byte(int r, int c) { const int st = (r >> 4) * 2 + (c >> 5), rr = r & 15, cc = c & 31, ob = rr * 64 + cc * 2; return st * 1024 + (ob ^ (((ob >> 9) & 1) << 5)); }
DEVI void p8_stage_rc(int b, int& R, int& C) { const int st = b / 1024, sb = b % 1024, swz = sb ^ (((sb >> 9) & 1) << 5); R = (st >> 1) * 16 + swz / 64; C = (st & 1) * 32 + (swz % 64) / 2; }
template <bool SWAP = true, class Epi>
DEVI void gemm_tile8p(const bf16_t* __restrict__ A, const bf16_t* __restrict__ Bt, int K, unsigned char* lds, Epi epi) {
    constexpr int HTB = 128 * 64 * 2;
    const int tid = tid_(), lane = tid & 63, wid = __builtin_amdgcn_readfirstlane(tid >> 6), wr = wid >> 2, wc = wid & 3, fr = lane & 15, fq = lane >> 4;
    f32x4 acc[2][2][4][2];
#pragma unroll
    for (int a_ = 0; a_ < 2; ++a_)
#pragma unroll
        for (int b_ = 0; b_ < 2; ++b_)
#pragma unroll
            for (int m = 0; m < 4; ++m)
#pragma unroll
                for (int n = 0; n < 2; ++n) acc[a_][b_][m][n] = (f32x4){0.f, 0.f, 0.f, 0.f};
    bf16x8 At[4][2], B0[2][2], B1[2][2];
    unsigned voff[2];
#pragma unroll
    for (int i = 0; i < 2; ++i) { int R, C; p8_stage_rc(tid * 16 + i * 8192, R, C); voff[i] = (unsigned)(R * K + C); }
    const int aoff = p8_lds_byte(wr * 64 + fr, fq * 8), boff = p8_lds_byte(wc * 32 + fr, fq * 8);
    const size_t hstep = (size_t)128 * K;
    const int nt = K >> 6;
#define P8_SA(b, h) (((b) * 2 + (h)) * HTB)
#define P8_SB(b, h) ((4 + (b) * 2 + (h)) * HTB)
#define P8_STAGE(bufoff, gbase, kt_) do { _Pragma("unroll") for (int _i = 0; _i < 2; ++_i) \
        __builtin_amdgcn_global_load_lds((const unsigned*)((gbase) + voff[_i] + (size_t)(kt_) * 64), (LAS unsigned*)(LAS unsigned char*)(lds + (bufoff) + tid * 16 + _i * 8192), 16, 0, 0); } while (0)
#define P8_LDA(dst, b, h) do { _Pragma("unroll") for (int m = 0; m < 4; ++m) _Pragma("unroll") for (int k = 0; k < 2; ++k) dst[m][k] = *(const bf16x8*)(lds + P8_SA(b, h) + aoff + m * 2048 + k * 1024); } while (0)
#define P8_LDB(dst, b, h) do { _Pragma("unroll") for (int n = 0; n < 2; ++n) _Pragma("unroll") for (int k = 0; k < 2; ++k) dst[n][k] = *(const bf16x8*)(lds + P8_SB(b, h) + boff + n * 2048 + k * 1024); } while (0)
#define P8_MMA(ai, bj, At_, Bt_) do { __builtin_amdgcn_s_setprio(1); _Pragma("unroll") for (int m = 0; m < 4; ++m) _Pragma("unroll") for (int n = 0; n < 2; ++n) _Pragma("unroll") for (int k = 0; k < 2; ++k) \
        acc[ai][bj][m][n] = SWAP ? __builtin_amdgcn_mfma_f32_16x16x32_bf16(Bt_[n][k], At_[m][k], acc[ai][bj][m][n], 0, 0, 0) : __builtin_amdgcn_mfma_f32_16x16x32_bf16(At_[m][k], Bt_[n][k], acc[ai][bj][m][n], 0, 0, 0); __builtin_amdgcn_s_setprio(0); } while (0)
#define P8_WAIT_L(n) asm volatile("s_waitcnt lgkmcnt(" #n ")" ::: "memory")
#define P8_BAR __builtin_amdgcn_s_barrier()
#define P8_SCHED __builtin_amdgcn_sched_barrier(0)
    const bf16_t* cA = A; const bf16_t* cB = Bt;
    WAITV(0);
    P8_BAR;
    P8_STAGE(P8_SB(0, 0), cB, 0); P8_STAGE(P8_SA(0, 0), cA, 0); P8_STAGE(P8_SB(0, 1), cB + hstep, 0); P8_STAGE(P8_SA(0, 1), cA + hstep, 0);
    if (wr == 1) P8_BAR;
    WAITV(4); P8_BAR;
    P8_STAGE(P8_SB(1, 0), cB, 1); P8_STAGE(P8_SA(1, 0), cA, 1); P8_STAGE(P8_SB(1, 1), cB + hstep, 1);
    WAITV(6); P8_BAR;
    for (int t = 0; t < nt - 2; t += 2) {
        P8_LDB(B0, 0, 0); P8_SCHED; P8_LDA(At, 0, 0); P8_STAGE(P8_SA(1, 1), cA + hstep, t + 1);
        P8_WAIT_L(8); P8_BAR; P8_WAIT_L(0); P8_MMA(0, 0, At, B0); P8_BAR; P8_SCHED;
        P8_LDB(B1, 0, 1); P8_STAGE(P8_SB(0, 0), cB, t + 2);
        P8_BAR; P8_WAIT_L(0); P8_MMA(0, 1, At, B1); P8_BAR;
        P8_LDA(At, 0, 1); P8_STAGE(P8_SA(0, 0), cA, t + 2);
        P8_BAR; P8_WAIT_L(0); P8_MMA(1, 0, At, B0); P8_BAR; P8_SCHED;
        P8_STAGE(P8_SB(0, 1), cB + hstep, t + 2);
        WAITV(6); P8_BAR; P8_MMA(1, 1, At, B1); P8_BAR;
        P8_LDB(B0, 1, 0); P8_SCHED; P8_LDA(At, 1, 0); P8_STAGE(P8_SA(0, 1), cA + hstep, t + 2);
        P8_WAIT_L(8); P8_BAR; P8_WAIT_L(0); P8_MMA(0, 0, At, B0); P8_BAR; P8_SCHED;
        P8_LDB(B1, 1, 1); P8_STAGE(P8_SB(1, 0), cB, t + 3);
        P8_BAR; P8_WAIT_L(0); P8_MMA(0, 1, At, B1); P8_BAR;
        P8_LDA(At, 1, 1); P8_STAGE(P8_SA(1, 0), cA, t + 3);
        P8_BAR; P8_WAIT_L(0); P8_MMA(1, 0, At, B0); P8_BAR; P8_SCHED;
        P8_STAGE(P8_SB(1, 1), cB + hstep, t + 3);
        WAITV(6); P8_BAR; P8_MMA(1, 1, At, B1); P8_BAR;
    }
    { P8_LDB(B0, 0, 0); P8_LDA(At, 0, 0); P8_STAGE(P8_SA(1, 1), cA + hstep, nt - 1);
      P8_BAR; P8_WAIT_L(0); P8_MMA(0, 0, At, B0); P8_BAR;
      P8_LDB(B1, 0, 1); P8_BAR; P8_WAIT_L(0); P8_MMA(0, 1, At, B1); P8_BAR;
      P8_LDA(At, 0, 1); WAITV(4); P8_BAR; P8_WAIT_L(0); P8_MMA(1, 0, At, B0); P8_MMA(1, 1, At, B1); P8_BAR; }
    { P8_LDB(B0, 1, 0); P8_LDA(At, 1, 0); WAITV(2); P8_BAR; P8_WAIT_L(0); P8_MMA(0, 0, At, B0); P8_BAR;
      P8_LDB(B1, 1, 1); WAITV(0); P8_BAR; P8_WAIT_L(0); P8_MMA(0, 1, At, B1); P8_BAR;
      P8_LDA(At, 1, 1); P8_BAR; P8_WAIT_L(0); P8_MMA(1, 0, At, B0); P8_MMA(1, 1, At, B1); P8_BAR; }
    if (wr == 0) P8_BAR;
    epi(acc, wr, wc, fr, fq);
}

struct WS {
    unsigned char* b;
    DEVI bf16_t* wt_s5in(int j) const { return (bf16_t*)(b + WS_WT_S5IN) + (size_t)j * 1024 * 1024; }
    DEVI bf16_t* wt_glu(int j) const { return (bf16_t*)(b + WS_WT_GLU) + (size_t)j * 2048 * 1024; }
    DEVI bf16_t* wt_s5out(int j) const { return (bf16_t*)(b + WS_WT_S5OUT) + (size_t)j * 1024 * 1024; }
    DEVI bf16_t* wt_qkv(int j) const { return (bf16_t*)(b + WS_WT_QKV) + (size_t)j * 1536 * 1024; }
    DEVI bf16_t* wt_o(int j) const { return (bf16_t*)(b + WS_WT_O) + (size_t)j * 1024 * 1024; }
    DEVI bf16_t* wt_ffnin(int l) const { return (bf16_t*)(b + WS_WT_FFNIN) + (size_t)l * 5632 * 1024; }
    DEVI bf16_t* wt_ffnout(int l) const { return (bf16_t*)(b + WS_WT_FFNOUT) + (size_t)l * 1024 * 2816; }
    DEVI bf16_t* mg(int j, int g) const { return (bf16_t*)(b + WS_MG) + ((size_t)(j * 64 + g) * 512) * 256; }
    DEVI bf16_t* vg(int j, int g) const { return (bf16_t*)(b + WS_VG) + ((size_t)(j * 64 + g) * 256) * 256; }
    DEVI float* lam16() const { return (float*)(b + WS_LAM16); }
    DEVI float* mod(int layer, int cond, int chunk) const { return (float*)(b + WS_MOD) + ((size_t)(layer * 5 + cond) * 6144 + chunk * 1024); }
    DEVI float* rope() const { return (float*)(b + WS_ROPE); }
    DEVI bf16_t* ks(int j) const { return (bf16_t*)(b + WS_KS + j * KS_LAYER); }
    DEVI bf16_t* vts(int j) const { return (bf16_t*)(b + WS_VTS + j * KS_LAYER); }
    DEVI bf16_t* kp() const { return (bf16_t*)(b + WS_KP); }
    DEVI bf16_t* vtp() const { return (bf16_t*)(b + WS_VTP); }
    DEVI float* X() const { return (float*)(b + WS_X); }
    DEVI float* T() const { return (float*)(b + WS_T); }
    DEVI bf16_t* H() const { return (bf16_t*)(b + WS_H); }
    DEVI bf16_t* bufa() const { return (bf16_t*)(b + WS_BUFA); }
    DEVI bf16_t* bufb() const { return (bf16_t*)(b + WS_BUFB); }
    DEVI bf16_t* act() const { return (bf16_t*)(b + WS_ACT); }
    DEVI float* sl() const { return (float*)(b + WS_SL); }
    DEVI float* part() const { return (float*)(b + WS_PART); }
};
DEVI int cond_of_row(int row) { return row < NPR ? 0 : 1 + ((row - NPR) >> 10); }

DEVI void s5_mats_item(PP p, const WS& ws, int item, unsigned char* lds) {
    const int j = item >> 6, g = item & 63, tid = tid_();
    float* lamp = (float*)lds;
    float* bbar = lamp + 2 * 64 * 17 * 2;
    float* ktab = bbar + 2 * 64 * 16 * 2;
    if (tid < 128) {
        const int dir = tid >> 6, pp = tid & 63;
        const int gi = (j * 2 + dir) * 64 + g, idx = gi * 64 + pp;
        const float are = p->in[12][idx], aim = p->in[13][idx], dt = expf(p->in[14][gi]);
        const float mag = expf(dt * are);
        float sn, cs; sincosf(dt * aim, &sn, &cs);
        const float lr = mag * cs, li = mag * sn;
        const float den = are * are + aim * aim, nr = lr - 1.f;
        const float kre = (nr * are + li * aim) / den, kim = (li * are - nr * aim) / den;
        float pr = 1.f, pi = 0.f;
        float* lp = lamp + (dir * 64 + pp) * 34;
        for (int e = 0; e <= 16; ++e) { lp[2 * e] = pr; lp[2 * e + 1] = pi; const float t = pr * lr - pi * li; pi = pr * li + pi * lr; pr = t; }
        float* l16 = ws.lam16() + (size_t)idx * 2; l16[0] = lp[32]; l16[1] = lp[33];
        const float* bre = p->in[15] + (size_t)idx * 16; const float* bim = p->in[16] + (size_t)idx * 16;
        float* bb = bbar + (dir * 64 + pp) * 32;
        for (int h = 0; h < 16; ++h) { const float br = bre[h], bi = bim[h]; bb[h] = kre * br - kim * bi; bb[16 + h] = kre * bi + kim * br; }
    }
    __syncthreads();
    {
        const int dir = tid >> 8, tau = (tid >> 4) & 15, h = tid & 15;
        const float* cre = p->in[17] + ((size_t)((j * 2 + dir) * 64 + g) * 16 + h) * 64;
        const float* cim = p->in[18] + ((size_t)((j * 2 + dir) * 64 + g) * 16 + h) * 64;
        f32x4 a4[4];
#pragma unroll
        for (int q = 0; q < 4; ++q) a4[q] = (f32x4){0.f, 0.f, 0.f, 0.f};
        for (int pp = 0; pp < 64; ++pp) {
            const float cr = cre[pp], ci = cim[pp];
            const float lr = lamp[(dir * 64 + pp) * 34 + 2 * tau], li = lamp[(dir * 64 + pp) * 34 + 2 * tau + 1];
            const float qr = cr * lr - ci * li, qi = cr * li + ci * lr;
            const f32x4* br4 = (const f32x4*)(bbar + (dir * 64 + pp) * 32);
#pragma unroll
            for (int q = 0; q < 4; ++q) a4[q] += br4[q] * qr - br4[4 + q] * qi;
        }
        float* kt = ktab + ((dir * 16 + tau) * 16 + h) * 16;
#pragma unroll
        for (int q = 0; q < 4; ++q) *(f32x4*)(kt + 4 * q) = a4[q];
    }
    __syncthreads();
    bf16_t* Mg = ws.mg(j, g);
    bf16_t* Vg = ws.vg(j, g);
    const float* dsk = p->in[19] + j * 1024 + g * 16;
    for (int i8 = tid; i8 < 8192; i8 += NTHR) {
        const int m = i8 >> 5, k8 = (i8 & 31) * 8;
        {
            const int t = m >> 4, h = m & 15, t2 = k8 >> 4, h0 = k8 & 15;
            float v[8];
#pragma unroll
            for (int e = 0; e < 8; ++e) {
                float x = 0.f;
                if (t2 <= t) x += ktab[((0 * 16 + (t - t2)) * 16 + h) * 16 + h0 + e];
                if (t2 >= t) x += ktab[((1 * 16 + (t2 - t)) * 16 + h) * 16 + h0 + e];
                if (t2 == t && h0 + e == h) x += dsk[h];
                v[e] = x;
            }
            u32x4 o; o.x = cvt_pk(v[0], v[1]); o.y = cvt_pk(v[2], v[3]); o.z = cvt_pk(v[4], v[5]); o.w = cvt_pk(v[6], v[7]);
            *(u32x4*)(Mg + (size_t)m * 256 + k8) = o;
        }
        {
            const int dir = m >> 7, ri = (m >> 6) & 1, pp = m & 63, t2 = k8 >> 4, h0 = k8 & 15;
            const int e = dir == 0 ? 15 - t2 : t2;
            const float lr = lamp[(dir * 64 + pp) * 34 + 2 * e], li = lamp[(dir * 64 + pp) * 34 + 2 * e + 1];
            const float* bb = bbar + (dir * 64 + pp) * 32;
            float v[8];
#pragma unroll
            for (int q = 0; q < 8; ++q) { const float br = bb[h0 + q], bi = bb[16 + h0 + q]; v[q] = ri == 0 ? lr * br - li * bi : lr * bi + li * br; }
            u32x4 o; o.x = cvt_pk(v[0], v[1]); o.y = cvt_pk(v[2], v[3]); o.z = cvt_pk(v[4], v[5]); o.w = cvt_pk(v[6], v[7]);
            *(u32x4*)(Mg + (size_t)(256 + m) * 256 + k8) = o;
        }
        {
            const int t = m >> 4, h = m & 15, dir = k8 >> 7, ri = (k8 >> 6) & 1, p0 = k8 & 63;
            const int e = dir == 0 ? t + 1 : 16 - t;
            const float* cre = p->in[17] + ((size_t)((j * 2 + dir) * 64 + g) * 16 + h) * 64 + p0;
            const float* cim = p->in[18] + ((size_t)((j * 2 + dir) * 64 + g) * 16 + h) * 64 + p0;
            float v[8];
#pragma unroll
            for (int q = 0; q < 8; ++q) {
                const float cr = cre[q], ci = cim[q];
                const float lr = lamp[(dir * 64 + p0 + q) * 34 + 2 * e], li = lamp[(dir * 64 + p0 + q) * 34 + 2 * e + 1];
                v[q] = ri == 0 ? (cr * lr - ci * li) : -(cr * li + ci * lr);
            }
            u32x4 o; o.x = cvt_pk(v[0], v[1]); o.y = cvt_pk(v[2], v[3]); o.z = cvt_pk(v[4], v[5]); o.w = cvt_pk(v[6], v[7]);
            *(u32x4*)(Vg + (size_t)m * 256 + k8) = o;
        }
    }
    __syncthreads();
}

DEVI void adaln_item(PP p, const WS& ws, int item, unsigned char* lds) {
    const int layer = item / 96, cgp = item % 96, tid = tid_();
    float* sil = (float*)lds;
    float* red = sil + 5 * 1024;
    for (int i = tid; i < 5120; i += NTHR) { const int c = i >> 10, k = i & 1023; const float v = c == 0 ? p->in[6][k] : p->in[2][(c - 1) * 1024 + k]; sil[i] = siluf_(v); }
    __syncthreads();
    const int c4 = tid & 15, kr = tid >> 4;
    f32x4 a[5];
#pragma unroll
    for (int c = 0; c < 5; ++c) a[c] = (f32x4){0.f, 0.f, 0.f, 0.f};
    const float* wb = p->in[7] + (size_t)layer * 1024 * 6144 + cgp * 64 + c4 * 4;
    for (int k0 = kr; k0 < 1024; k0 += 256) {
        f32x4 w4[8];
#pragma unroll
        for (int u = 0; u < 8; ++u) w4[u] = *(const f32x4*)(wb + (size_t)(k0 + 32 * u) * 6144);
#pragma unroll
        for (int u = 0; u < 8; ++u)
#pragma unroll
            for (int c = 0; c < 5; ++c) a[c] += w4[u] * sil[c * 1024 + k0 + 32 * u];
    }
#pragma unroll
    for (int c = 0; c < 5; ++c) *(f32x4*)(red + (kr * 5 + c) * 64 + c4 * 4) = a[c];
    __syncthreads();
    if (tid < 320) {
        const int c = tid >> 6, col = tid & 63;
        float s = p->in[8][layer * 6144 + cgp * 64 + col];
        for (int r = 0; r < 32; ++r) s += red[(r * 5 + c) * 64 + col];
        ((float*)(ws.b + WS_MOD))[(size_t)(layer * 5 + c) * 6144 + cgp * 64 + col] = s;
    }
    if (item < 32) {
        WAITV(0);
        __syncthreads();
        if (tid == 0) { __builtin_amdgcn_fence(__ATOMIC_RELEASE, "agent"); WAITV(0); xb_add((unsigned*)(ws.b + WS_BAR) + 3713, 1u); }
    }
    __syncthreads();
}

struct WtD { const float* src; bf16_t* dst; int K, N, half, tile; };
constexpr int WT_L0_END = 784, WT_A_END = 1296, WT_B_END = 1744, WT_C_END = 2256, WT_D_END = 2768, WT_TOT = 2944;
DEVI WtD wt_make(PP p, const WS& ws, int kind, int l, int tile) {
    WtD d; d.tile = tile;
    if (kind == 0) { d.src = p->in[26] + (size_t)l * 1024 * 5632; d.dst = ws.wt_ffnin(l); d.K = 1024; d.N = 5632; d.half = 2816; }
    else if (kind == 1) { d.src = p->in[27] + (size_t)l * 2816 * 1024; d.dst = ws.wt_ffnout(l); d.K = 2816; d.N = 1024; d.half = 0; }
    else if (kind == 2) { d.src = p->in[20] + (size_t)l * 1024 * 2048; d.dst = ws.wt_glu(l); d.K = 1024; d.N = 2048; d.half = 1024; }
    else if (kind == 3) { d.src = p->in[22] + (size_t)l * 1024 * 1536; d.dst = ws.wt_qkv(l); d.K = 1024; d.N = 1536; d.half = -1; }
    else if (kind == 4) { d.src = p->in[11] + (size_t)l * 1024 * 1024; d.dst = ws.wt_s5in(l); d.K = 1024; d.N = 1024; d.half = 0; }
    else if (kind == 5) { d.src = p->in[21] + (size_t)l * 1024 * 1024; d.dst = ws.wt_s5out(l); d.K = 1024; d.N = 1024; d.half = 0; }
    else { d.src = p->in[25] + (size_t)l * 1024 * 1024; d.dst = ws.wt_o(l); d.K = 1024; d.N = 1024; d.half = 0; }
    return d;
}
DEVI WtD wt_decode(PP p, const WS& ws, int t) {
    if (t < 352) return wt_make(p, ws, 0, 0, t);
    if (t < 528) return wt_make(p, ws, 1, 0, t - 352);
    if (t < 656) return wt_make(p, ws, 2, 0, t - 528);
    if (t < 720) return wt_make(p, ws, 4, 0, t - 656);
    if (t < 784) return wt_make(p, ws, 5, 0, t - 720);
    if (t < 880) return wt_make(p, ws, 3, 0, t - 784);
    if (t < 944) return wt_make(p, ws, 6, 0, t - 880);
    if (t < 1296) return wt_make(p, ws, 0, 1, t - 944);
    if (t < 1472) return wt_make(p, ws, 1, 1, t - 1296);
    if (t < 1568) return wt_make(p, ws, 0, 2, 256 + (t - 1472));
    if (t < 1744) return wt_make(p, ws, 1, 2, t - 1568);
    if (t < 1808) return wt_make(p, ws, 4, 1, t - 1744);
    if (t < 1936) return wt_make(p, ws, 2, 1, t - 1808);
    if (t < 2000) return wt_make(p, ws, 5, 1, t - 1936);
    if (t < 2256) return wt_make(p, ws, 0, 2, t - 2000);
    if (t < 2352) return wt_make(p, ws, 3, 1, t - 2256);
    if (t < 2416) return wt_make(p, ws, 6, 1, t - 2352);
    if (t < 2768) return wt_make(p, ws, 0, 3, t - 2416);
    return wt_make(p, ws, 1, 3, t - 2768);
}
DEVI void wt_load(const WtD& d, int tid, f32x4 (&v)[8]) {
    const int ntn = d.N >> 6, k0 = (d.tile / ntn) * 256, n0 = (d.tile % ntn) * 64, r = tid >> 4, c4 = (tid & 15) * 4;
#pragma unroll
    for (int i = 0; i < 8; ++i) v[i] = *(const f32x4*)(d.src + (size_t)(k0 + r + 32 * i) * d.N + n0 + c4);
}
DEVI void wt_all(PP p, const WS& ws, int t0, int tstep, int tot, unsigned char* lds) {
    float* sc = (float*)lds;
    const int tid = tid_();
    if (t0 >= tot) return;
    WtD cur = wt_decode(p, ws, t0);
    f32x4 v[8];
    wt_load(cur, tid, v);
    for (int t = t0; t < tot; t += tstep) {
        const bool has = t + tstep < tot;
        {
            const int r = tid >> 4, c4 = (tid & 15) * 4;
#pragma unroll
            for (int i = 0; i < 8; ++i) { float* q = sc + (r + 32 * i) * 65 + c4; q[0] = v[i].x; q[1] = v[i].y; q[2] = v[i].z; q[3] = v[i].w; }
        }
        __syncthreads();
        WtD nxt = cur;
        if (has) { nxt = wt_decode(p, ws, t + tstep); wt_load(nxt, tid, v); }
        {
            const int ntn = cur.N >> 6, k0 = (cur.tile / ntn) * 256, n0 = (cur.tile % ntn) * 64;
            const int nn = tid >> 3, kq = tid & 7;
            int n = n0 + nn, rho = n;
            if (cur.half > 0) { const int which = n >= cur.half ? 1 : 0, jj = n - which * cur.half; rho = (jj >> 7) * 256 + which * 128 + (jj & 127); }
            else if (cur.half < 0) { const int d = n & 127, wcp = ((d >> 6) << 1) | ((d >> 4) & 1); rho = (n & ~127) + wcp * 32 + ((d >> 5) & 1) * 16 + (d & 15); }
#pragma unroll
            for (int ii = 0; ii < 4; ++ii) {
                const int k8 = (kq + 8 * ii) * 8;
                const float* q = sc + k8 * 65 + nn;
                u32x4 o; o.x = cvt_pk(q[0], q[65]); o.y = cvt_pk(q[130], q[195]); o.z = cvt_pk(q[260], q[325]); o.w = cvt_pk(q[390], q[455]);
                *(u32x4*)(cur.dst + (size_t)rho * cur.K + k0 + k8) = o;
            }
        }
        __syncthreads();
        cur = nxt;
    }
}

DEVI void prep_b(PP p, const WS& ws) {
    const int gt = bid_() * NTHR + tid_(), gn = gridDim.x * NTHR;
    for (int i = gt; i < NROW * (DM / 8); i += gn) {
        const int row = i >> 7, c8 = (i & 127) * 8;
        const float* x = row < NPR ? p->in[0] + (size_t)row * DM : p->in[1] + (size_t)(row - NPR) * DM;
        const int cond = cond_of_row(row);
        const float* sh = ws.mod(0, cond, 0); const float* sc = ws.mod(0, cond, 1);
        const f32x4 x0 = *(const f32x4*)(x + c8), x1 = *(const f32x4*)(x + c8 + 4);
        const f32x4 s0 = *(const f32x4*)(sc + c8), s1 = *(const f32x4*)(sc + c8 + 4);
        const f32x4 h0 = *(const f32x4*)(sh + c8), h1 = *(const f32x4*)(sh + c8 + 4);
        const f32x4 r0 = x0 * (s0 + 1.f) + h0, r1 = x1 * (s1 + 1.f) + h1;
        u32x4 o; o.x = cvt_pk(r0.x, r0.y); o.y = cvt_pk(r0.z, r0.w); o.z = cvt_pk(r1.x, r1.y); o.w = cvt_pk(r1.z, r1.w);
        *(u32x4*)(ws.H() + (size_t)row * DM + c8) = o;
    }
}

DEVI void prep_a(PP p, const WS& ws, unsigned char* lds) {
    const int bid = bid_(), nb = gridDim.x, tid = tid_();
    if (nb == 256) {
        if (bid < 128) s5_mats_item(p, ws, bid, lds);
        else {
            for (int it = bid - 128; it < 192; it += 128) adaln_item(p, ws, it, lds);
            wt_all(p, ws, bid - 128, 128, WT_L0_END, lds);
        }
    } else {
        for (int it = bid; it < 128; it += nb) s5_mats_item(p, ws, it, lds);
        for (int it = nb - 1 - bid; it < 384; it += nb) adaln_item(p, ws, it, lds);
        wt_all(p, ws, bid, nb, WT_TOT, lds);
    }
    const int gt = bid * NTHR + tid, gn = nb * NTHR;
    for (int i = gt; i < 2 * 4 * 512 * 2 * 32; i += gn) {
        const int d4 = (i & 31) * 4, kvh = (i >> 5) & 1, past = (i >> 6) & 511, j = (i >> 15) & 1, b = i >> 16;
        const f32x4 v = *(const f32x4*)(p->in[3] + ((((size_t)b * 2 + j) * 512 + past) * 2 + kvh) * 128 + d4);
        *(u32x2*)(ws.ks(j) + ((size_t)(b * 2 + kvh) * 1536 + 1024 + past) * 128 + d4) = pack4(v);
    }
    for (int i = gt; i < 2 * 4 * 2 * 64 * 128; i += gn) {
        const int d = i & 127, p8 = (i >> 7) & 63, kvh = (i >> 13) & 1, b = (i >> 14) & 3, j = i >> 16;
        const float* s = p->in[4] + ((((size_t)b * 2 + j) * 512 + p8 * 8) * 2 + kvh) * 128 + d;
        u32x4 o; o.x = cvt_pk(s[0], s[256]); o.y = cvt_pk(s[512], s[768]); o.z = cvt_pk(s[1024], s[1280]); o.w = cvt_pk(s[1536], s[1792]);
        *(u32x4*)(ws.vts(j) + ((size_t)(b * 2 + kvh) * 128 + d) * 1536 + 1024 + p8 * 8) = o;
    }
    for (int i = gt; i < 2048; i += gn) {
        const int pos = i >> 5, fi = i & 31;
        const float inv = exp2f(-(float)fi * (13.287712379549449f / 32.f));
        float sn, cs; sincosf((float)pos * inv, &sn, &cs);
        ws.rope()[2 * i] = cs; ws.rope()[2 * i + 1] = sn;
    }
    if (tid == 0) {
        unsigned* cw = (unsigned*)(ws.b + WS_BAR) + 3713; unsigned sp = 0;
        while (xb_ld(cw) < 32u) { __builtin_amdgcn_s_sleep(2); if (++sp > (1u << 22)) break; }
        __builtin_amdgcn_fence(__ATOMIC_ACQUIRE, "agent");
        WAITV(0);
    }
    __syncthreads();
    prep_b(p, ws);
}

DEVI void ln_phase(PP p, const WS& ws, int layer, int which) {
    const int lane = tid_() & 63, gw = bid_() * 8 + (tid_() >> 6), nw = gridDim.x * 8;
    const float* gam = p->in[9] + (layer * 2 + which) * DM; const float* bet = p->in[10] + (layer * 2 + which) * DM;
    const bool last = (layer == 3 && which == 1);
    const int ml = which == 0 ? layer : layer + 1, ms = which == 0 ? 3 : 0;
    float* Xo = last ? p->out + OUT_Y : ws.X();
    for (int row = gw; row < NROW; row += nw) {
        const float* t = ws.T() + (size_t)row * DM;
        f32x4 v[4]; float s = 0.f;
#pragma unroll
        for (int q = 0; q < 4; ++q) { v[q] = *(const f32x4*)(t + q * 256 + lane * 4); s += (v[q].x + v[q].y) + (v[q].z + v[q].w); }
#pragma unroll
        for (int o = 1; o < 64; o <<= 1) s += __shfl_xor(s, o);
        const float mean = s * (1.f / DM); float s2 = 0.f;
#pragma unroll
        for (int q = 0; q < 4; ++q) { v[q] = v[q] - mean; s2 += (v[q].x * v[q].x + v[q].y * v[q].y) + (v[q].z * v[q].z + v[q].w * v[q].w); }
#pragma unroll
        for (int o = 1; o < 64; o <<= 1) s2 += __shfl_xor(s2, o);
        const float rstd = 1.f / sqrtf(s2 * (1.f / DM) + LN_EPS);
        const int cond = cond_of_row(row);
#pragma unroll
        for (int q = 0; q < 4; ++q) {
            const int c = q * 256 + lane * 4;
            const f32x4 y = v[q] * rstd * *(const f32x4*)(gam + c) + *(const f32x4*)(bet + c);
            *(f32x4*)(Xo + (size_t)row * DM + c) = y;
            if (!last) {
                const f32x4 sh = *(const f32x4*)(ws.mod(ml, cond, ms) + c), sc = *(const f32x4*)(ws.mod(ml, cond, ms + 1) + c);
                *(u32x2*)(ws.H() + (size_t)row * DM + c) = pack4(y * (sc + 1.f) + sh);
            }
        }
    }
}

DEVI void out_ln_gemm_phase(PP p, const WS& ws, const bf16_t* A, int K, const bf16_t* Wt, int layer, int which, const float* xlo, const float* xhi, bool xf32, unsigned char* lds) {
    const int gchunk = which == 0 ? 2 : 5;
    const bool last = (layer == 3 && which == 1);
    const int ml = which == 0 ? layer : layer + 1, ms = which == 0 ? 3 : 0;
    const float* gam = p->in[9] + (layer * 2 + which) * DM; const float* bet = p->in[10] + (layer * 2 + which) * DM;
    float* Xo = p->out + OUT_Y;
    bf16_t* Xb = (bf16_t*)ws.X();
    float* part = ws.part() + (size_t)(layer * 2 + which) * NROW * 32;
    unsigned* cnt = (unsigned*)(ws.b + WS_BAR) + 3456 + (layer * 2 + which) * 32;
    for (int t = bid_(); t < 256; t += gridDim.x) {
        const int tm = t & 31, tn = t >> 5;
        const int cond = tm < 16 ? 0 : 1 + ((tm - 16) >> 2);
        const float* gate = ws.mod(layer, cond, gchunk);
        gemm_tile(A + (size_t)tm * 256 * K, K, Wt + (size_t)tn * 128 * K, K, K, lds,
            [&](f32x4 (&acc)[4][4], int wr, int wc, int fr, int fq) {
                const int colb = tn * 128 + wc * 64 + fq * 4;
                const int tid = (wr * 2 + wc) * 64 + fq * 16 + fr;
                {
                    f32x4 gv[4];
#pragma unroll
                    for (int n = 0; n < 4; ++n) gv[n] = *(const f32x4*)(gate + colb + n * 16);
                    f32x4 xv[4][4];
                    if (xf32) {
#pragma unroll
                        for (int i = 0; i < 4; ++i) {
                            const int row = tm * 256 + wr * 64 + i * 16 + fr;
                            const float* xp = row < NPR ? xlo + (size_t)row * DM : xhi + (size_t)(row - NPR) * DM;
#pragma unroll
                            for (int n = 0; n < 4; ++n) xv[i][n] = *(const f32x4*)(xp + colb + n * 16);
                        }
                    } else {
                        u32x2 xu[4][4];
#pragma unroll
                        for (int i = 0; i < 4; ++i) {
                            const bf16_t* xq = Xb + (size_t)(tm * 256 + wr * 64 + i * 16 + fr) * DM + colb;
#pragma unroll
                            for (int n = 0; n < 4; ++n) xu[i][n] = *(const u32x2*)(xq + n * 16);
                        }
#pragma unroll
                        for (int i = 0; i < 4; ++i)
#pragma unroll
                            for (int n = 0; n < 4; ++n) { const u32x2 u = xu[i][n]; xv[i][n].x = __uint_as_float(u.x << 16); xv[i][n].y = __uint_as_float(u.x & 0xffff0000u); xv[i][n].z = __uint_as_float(u.y << 16); xv[i][n].w = __uint_as_float(u.y & 0xffff0000u); }
                    }
#pragma unroll
                    for (int i = 0; i < 4; ++i) {
                        float s1 = 0.f, s2 = 0.f;
#pragma unroll
                        for (int n = 0; n < 4; ++n) {
                            const f32x4 tv = xv[i][n] * ALPHA + gv[n] * acc[i][n];
                            acc[i][n] = tv;
                            s1 += (tv.x + tv.y) + (tv.z + tv.w);
                            s2 += (tv.x * tv.x + tv.y * tv.y) + (tv.z * tv.z + tv.w * tv.w);
                        }
                        s1 += __shfl_xor(s1, 16); s1 += __shfl_xor(s1, 32);
                        s2 += __shfl_xor(s2, 16); s2 += __shfl_xor(s2, 32);
                        if (fq == 0) { float* rp = (float*)(lds + LDS_RED) + (wc * 256 + wr * 64 + i * 16 + fr) * 2; rp[0] = s1; rp[1] = s2; }
                    }
                }
                __syncthreads();
                if (tid < 256) {
                    const float* rp = (const float*)(lds + LDS_RED);
                    const float v1 = rp[tid * 2] + rp[(256 + tid) * 2], v2 = rp[tid * 2 + 1] + rp[(256 + tid) * 2 + 1];
                    __hip_atomic_store((unsigned long long*)(part + ((size_t)(tm * 8 + tn) * 256 + tid) * 2), (unsigned long long)__float_as_uint(v1) | ((unsigned long long)__float_as_uint(v2) << 32), __ATOMIC_RELAXED, __HIP_MEMORY_SCOPE_AGENT);
                }
                WAITV(0);
                __syncthreads();
                if (tid == 0) {
                    xb_add(&cnt[tm], 1u);
                    unsigned sp = 0;
                    while (xb_ld(&cnt[tm]) < 8u) { __builtin_amdgcn_s_sleep(1); if (++sp > (1u << 24)) break; }
                    __builtin_amdgcn_fence(__ATOMIC_ACQUIRE, "agent");
                    WAITV(0);
                }
                __syncthreads();
                float* stats = (float*)(lds + LDS_RED);
                if (tid < 256) {
                    const float* pp = part + ((size_t)(tm * 8) * 256 + tid) * 2;
                    float s1 = 0.f, s2 = 0.f;
                    f32x2 pv[8];
#pragma unroll
                    for (int q = 0; q < 8; ++q) pv[q] = *(const f32x2*)(pp + q * 512);
#pragma unroll
                    for (int q = 0; q < 8; ++q) { s1 += pv[q].x; s2 += pv[q].y; }
                    const float mean = s1 * (1.f / DM);
                    const float var = fmaxf(s2 * (1.f / DM) - mean * mean, 0.f);
                    stats[2 * tid] = mean; stats[2 * tid + 1] = 1.f / sqrtf(var + LN_EPS);
                }
                __syncthreads();
                const float* shp = ws.mod(ml & 3, cond, ms); const float* scp = ws.mod(ml & 3, cond, ms + 1);
#pragma unroll
                for (int n = 0; n < 4; ++n) {
                    const int c = colb + n * 16;
                    const f32x4 g4 = *(const f32x4*)(gam + c), b4 = *(const f32x4*)(bet + c);
                    f32x4 sh4 = (f32x4){0.f, 0.f, 0.f, 0.f}, sc4 = sh4;
                    if (!last) { sh4 = *(const f32x4*)(shp + c); sc4 = *(const f32x4*)(scp + c); }
#pragma unroll
                    for (int i = 0; i < 4; ++i) {
                        const int rl = wr * 64 + i * 16 + fr, row = tm * 256 + rl;
                        const float mean = stats[2 * rl], rstd = stats[2 * rl + 1];
                        const f32x4 y = (acc[i][n] - mean) * rstd * g4 + b4;
                        if (last) *(f32x4*)(Xo + (size_t)row * DM + c) = y;
                        else { *(u32x2*)(Xb + (size_t)row * DM + c) = pack4(y); *(u32x2*)(ws.H() + (size_t)row * DM + c) = pack4(y * (sc4 + 1.f) + sh4); }
                    }
                }
            }, (tm * 5 + tn) % (K >> 6));
    }
}

DEVI void ffn_in_phase(PP p, const WS& ws, int layer, unsigned char* lds) {
    const bf16_t* A = ws.H(); const bf16_t* Wt = ws.wt_ffnin(layer); bf16_t* ACT = ws.act();
    for (int t = bid_(); t < 32 * 22; t += gridDim.x) {
        const int tm = t & 31, tn = t >> 5;
        gemm_tile8p(A + (size_t)tm * 256 * DM, Wt + (size_t)tn * 256 * DM, DM, lds,
            [&](f32x4 (&acc)[2][2][4][2], int wr, int wc, int fr, int fq) {
#pragma unroll
                for (int ai = 0; ai < 2; ++ai)
#pragma unroll
                    for (int m = 0; m < 4; ++m) {
                        const int row = tm * 256 + ai * 128 + wr * 64 + m * 16 + fr;
#pragma unroll
                        for (int n = 0; n < 2; ++n) {
                            const f32x4 g = acc[ai][0][m][n], u = acc[ai][1][m][n];
                            f32x4 r; r.x = siluf_(g.x) * u.x; r.y = siluf_(g.y) * u.y; r.z = siluf_(g.z) * u.z; r.w = siluf_(g.w) * u.w;
                            *(u32x2*)(ACT + (size_t)row * DFF + tn * 128 + wc * 32 + n * 16 + fq * 4) = pack4(r);
                        }
                    }
            });
    }
    if (gridDim.x == 256 && bid_() >= 192 && layer < 3) {
        const int lo = layer == 0 ? WT_L0_END : layer == 1 ? WT_B_END : WT_C_END, hi = layer == 0 ? WT_A_END : layer == 1 ? WT_C_END : WT_D_END;
        wt_all(p, ws, lo + (bid_() - 192), 64, hi, lds);
    }
}

DEVI void glu_phase(const WS& ws, int j, unsigned char* lds) {
    const bf16_t* A = ws.bufa(); const bf16_t* Wt = ws.wt_glu(j); bf16_t* O = ws.bufb();
    for (int t = bid_(); t < 32 * 8; t += gridDim.x) {
        const int tm = t & 31, tn = t >> 5;
        gemm_tile8p(A + (size_t)tm * 256 * DM, Wt + (size_t)tn * 256 * DM, DM, lds,
            [&](f32x4 (&acc)[2][2][4][2], int wr, int wc, int fr, int fq) {
#pragma unroll
                for (int ai = 0; ai < 2; ++ai)
#pragma unroll
                    for (int m = 0; m < 4; ++m) {
                        const int row = tm * 256 + ai * 128 + wr * 64 + m * 16 + fr;
#pragma unroll
                        for (int n = 0; n < 2; ++n) {
                            const f32x4 v = acc[ai][0][m][n], g = acc[ai][1][m][n];
                            f32x4 r; r.x = v.x * sigmoidf_(g.x); r.y = v.y * sigmoidf_(g.y); r.z = v.z * sigmoidf_(g.z); r.w = v.w * sigmoidf_(g.w);
                            *(u32x2*)(O + (size_t)row * DM + tn * 128 + wc * 32 + n * 16 + fq * 4) = pack4(r);
                        }
                    }
            });
    }
}

DEVI void s5_in_phase(const WS& ws, int j, unsigned char* lds) {
    const bf16_t* A = ws.H(); const bf16_t* Wt = ws.wt_s5in(j); bf16_t* Uc = ws.act();
    for (int t = bid_(); t < 256; t += gridDim.x) {
        const int tm = t & 31, tn = t >> 5;
        gemm_tile(A + (size_t)tm * 256 * DM, DM, Wt + (size_t)tn * 128 * DM, DM, DM, lds,
            [&](f32x4 (&acc)[4][4], int wr, int wc, int fr, int fq) {
#pragma unroll
                for (int i = 0; i < 4; ++i) {
                    const int chunk = tm * 16 + wr * 4 + i;
#pragma unroll
                    for (int n = 0; n < 4; ++n) {
                        const int g = tn * 8 + wc * 4 + n;
                        *(u32x2*)(Uc + ((size_t)chunk * 64 + g) * 256 + fr * 16 + fq * 4) = pack4(acc[i][n]);
                    }
                }
            }, (tm * 5 + tn) & 15);
    }
}

DEVI void s5_chunk_phase(PP p, const WS& ws, int j, unsigned char* lds) {
    const bf16_t* Uc = ws.act(); bf16_t* Yi = (bf16_t*)ws.T(); bf16_t* Ss = ws.bufb();
    for (int it0 = bid_(); it0 < 512; it0 += gridDim.x) {
        const int it = it0 < 256 ? it0 : (it0 ^ 2);
        const int g = it >> 3, ct = (it >> 2) & 1, mt = it & 3;
        gemm_tile(Uc + ((size_t)ct * 256 * 64 + g) * 256, 16384, ws.mg(j, g) + (size_t)mt * 128 * 256, 256, 256, lds,
            [&](f32x4 (&acc)[4][4], int wr, int wc, int fr, int fq) {
                if (mt < 2) {
#pragma unroll
                    for (int i = 0; i < 4; ++i) {
                        const int chunk = ct * 256 + wr * 64 + i * 16 + fr;
#pragma unroll
                        for (int n = 0; n < 4; ++n) { const int tt = mt * 8 + wc * 4 + n; *(u32x2*)(Yi + (size_t)(chunk * 16 + tt) * DM + g * 16 + fq * 4) = pack4(acc[i][n]); }
                    }
                } else {
                    const int dir = mt - 2, tid = (wr * 2 + wc) * 64 + fq * 16 + fr;
                    float* sl = (float*)lds;
                    __syncthreads();
#pragma unroll
                    for (int i = 0; i < 4; ++i)
#pragma unroll
                        for (int n = 0; n < 4; ++n) *(f32x4*)(sl + (wr * 64 + i * 16 + fr) * 128 + wc * 64 + n * 16 + fq * 4) = acc[i][n];
                    __syncthreads();
                    const int nchain = ct == 0 ? 1024 : 256, n = ct == 0 ? 16 : 64;
                    for (int c = tid; c < nchain; c += NTHR) {
                        const int b = c >> 6, pp = c & 63, base = b * n;
                        const float* l16 = ws.lam16() + ((size_t)((j * 2 + dir) * 64 + g) * 64 + pp) * 2;
                        const float lr = l16[0], li = l16[1];
                        float sr = 0.f, si = 0.f;
                        const size_t so = ((((size_t)(b * 2 + j) * 2 + dir) * 2 + 0) * 64 + g) * 64 + pp;
                        if (ct == 1) { sr = p->in[5][so]; si = p->in[5][so + 4096]; }
                        for (int q = 0; q < n; ++q) {
                            const int lc = dir == 0 ? base + q : base + n - 1 - q;
                            const size_t o = ((size_t)(ct * 256 + lc) * 64 + g) * 256 + dir * 128 + pp;
                            Ss[o] = (bf16_t)(cvt_pk(sr, sr) & 0xffffu); Ss[o + 64] = (bf16_t)(cvt_pk(si, si) & 0xffffu);
                            const float ar = sl[lc * 128 + pp], ai = sl[lc * 128 + 64 + pp];
                            const float nr = lr * sr - li * si + ar; si = lr * si + li * sr + ai; sr = nr;
                        }
                        if (ct == 0) { p->out[OUT_S + so] = sr; p->out[OUT_S + so + 4096] = si; }
                    }
                }
            });
    }
}

DEVI void s5_y_phase(const WS& ws, int j, unsigned char* lds) {
    const bf16_t* Ss = ws.bufb(); const bf16_t* Yi = (const bf16_t*)ws.T(); bf16_t* Z = ws.bufa();
    for (int it = bid_(); it < 256; it += gridDim.x) {
        const int g = it >> 2, ct = (it >> 1) & 1, mt = it & 1;
        gemm_tile(Ss + ((size_t)ct * 256 * 64 + g) * 256, 16384, ws.vg(j, g) + (size_t)mt * 128 * 256, 256, 256, lds,
            [&](f32x4 (&acc)[4][4], int wr, int wc, int fr, int fq) {
#pragma unroll
                for (int i = 0; i < 4; ++i) {
                    const int chunk = ct * 256 + wr * 64 + i * 16 + fr;
#pragma unroll
                    for (int n = 0; n < 4; ++n) {
                        const int tt = mt * 8 + wc * 4 + n;
                        const size_t o = (size_t)(chunk * 16 + tt) * DM + g * 16 + fq * 4;
                        const u32x2 yu = *(const u32x2*)(Yi + o);
                        f32x4 y = acc[i][n]; y.x += __uint_as_float(yu.x << 16); y.y += __uint_as_float(yu.x & 0xffff0000u); y.z += __uint_as_float(yu.y << 16); y.w += __uint_as_float(yu.y & 0xffff0000u);
                        f32x4 z; z.x = gelu_tanh(y.x); z.y = gelu_tanh(y.y); z.z = gelu_tanh(y.z); z.w = gelu_tanh(y.w);
                        *(u32x2*)(Z + o) = pack4(z);
                    }
                }
            });
    }
}

DEVI void qkv_phase(PP p, const WS& ws, int j, unsigned char* lds) {
    const bf16_t* A = ws.H(); const bf16_t* Wt = ws.wt_qkv(j);
    for (int t = bid_(); t < 32 * 6; t += gridDim.x) {
        const int tm = t & 31, tn = t >> 5;
        if (tn == 5) {
            gemm_tile8p<false>(A + (size_t)tm * 256 * DM, Wt + (size_t)tn * 256 * DM, DM, lds,
                [&](f32x4 (&acc)[2][2][4][2], int wr, int wc, int fr, int fq) {
                    const bool sample = tm >= 16;
                    const int b = sample ? (tm - 16) >> 2 : tm;
                    const int lq = sample ? ((tm - 16) & 3) * 256 : 0, skv = sample ? 1536 : 256;
#pragma unroll
                    for (int bj = 0; bj < 2; ++bj) {
                        bf16_t* vt = (sample ? ws.vts(j) : ws.vtp()) + (size_t)(b * 2 + bj) * 128 * skv;
#pragma unroll
                        for (int n = 0; n < 2; ++n) {
                            const int d = (wc >> 1) * 64 + n * 32 + (wc & 1) * 16 + fr;
#pragma unroll
                            for (int ai = 0; ai < 2; ++ai)
#pragma unroll
                                for (int m = 0; m < 4; ++m) {
                                    const int l = lq + ai * 128 + wr * 64 + m * 16 + fq * 4;
                                    *(u32x2*)(vt + (size_t)d * skv + l) = pack4(acc[ai][bj][m][n]);
                                    if (!sample) { float* o = p->out + OUT_V + ((((size_t)b * 2 + j) * 256 + l) * 2 + bj) * 128 + d; o[0] = acc[ai][bj][m][n].x; o[256] = acc[ai][bj][m][n].y; o[512] = acc[ai][bj][m][n].z; o[768] = acc[ai][bj][m][n].w; }
                                }
                        }
                    }
                });
            continue;
        }
        gemm_tile8p(A + (size_t)tm * 256 * DM, Wt + (size_t)tn * 256 * DM, DM, lds,
            [&](f32x4 (&acc)[2][2][4][2], int wr, int wc, int fr, int fq) {
                const bool sample = tm >= 16;
                const int b = sample ? (tm - 16) >> 2 : tm;
                const int lq = sample ? ((tm - 16) & 3) * 256 : 0;
                const int d0 = (wc >> 1) * 64 + (wc & 1) * 16 + fq * 4;
                {
                    float* red = (float*)(lds + 131072);
#pragma unroll
                    for (int ai = 0; ai < 2; ++ai)
#pragma unroll
                        for (int bj = 0; bj < 2; ++bj)
#pragma unroll
                            for (int m = 0; m < 4; ++m) {
                                const f32x4 u = acc[ai][bj][m][0], v = acc[ai][bj][m][1];
                                float ssq = (u.x * u.x + u.y * u.y) + (u.z * u.z + u.w * u.w) + (v.x * v.x + v.y * v.y) + (v.z * v.z + v.w * v.w);
                                ssq += __shfl_xor(ssq, 16); ssq += __shfl_xor(ssq, 32);
                                if (fq == 0) red[((((ai * 2 + bj) * 2 + wr) * 4 + m) * 16 + fr) * 4 + wc] = ssq;
                            }
                    __syncthreads();
                    const float* gain = (tn < 4 ? p->in[23] : p->in[24]) + j * 128;
                    const f32x4 g0 = *(const f32x4*)(gain + d0), g1 = *(const f32x4*)(gain + d0 + 32);
                    const float* rope = ws.rope();
#pragma unroll
                    for (int ai = 0; ai < 2; ++ai)
#pragma unroll
                        for (int m = 0; m < 4; ++m) {
                            const int rl = ai * 128 + wr * 64 + m * 16 + fr, row = tm * 256 + rl, l = lq + rl;
                            f32x4 r0 = (f32x4){1.f, 0.f, 1.f, 0.f}, r1 = r0;
                            if (sample) { const int pos = (wc >> 1) == 0 ? (l >> 6) : (l & 63); const float* rp = rope + (pos * 32 + (wc & 1) * 16 + fq * 4) * 2; r0 = *(const f32x4*)rp; r1 = *(const f32x4*)(rp + 4); }
#pragma unroll
                            for (int bj = 0; bj < 2; ++bj) {
                                const f32x4 q4 = *(const f32x4*)(red + ((((ai * 2 + bj) * 2 + wr) * 4 + m) * 16 + fr) * 4);
                                const float rstd = 1.f / sqrtf(((q4.x + q4.y) + (q4.z + q4.w)) * (1.f / 128.f) + RMS_EPS);
                                const f32x4 x1 = acc[ai][bj][m][0] * rstd * g0, x2 = acc[ai][bj][m][1] * rstd * g1;
                                f32x4 y1, y2;
                                y1.x = x1.x * r0.x - x2.x * r0.y; y2.x = x2.x * r0.x + x1.x * r0.y;
                                y1.y = x1.y * r0.z - x2.y * r0.w; y2.y = x2.y * r0.z + x1.y * r0.w;
                                y1.z = x1.z * r1.x - x2.z * r1.y; y2.z = x2.z * r1.x + x1.z * r1.y;
                                y1.w = x1.w * r1.z - x2.w * r1.w; y2.w = x2.w * r1.z + x1.w * r1.w;
                                if (tn < 4) {
                                    bf16_t* qp = ws.bufa() + (size_t)row * DM + (tn * 2 + bj) * 128 + d0;
                                    *(u32x2*)qp = pack4(y1); *(u32x2*)(qp + 32) = pack4(y2);
                                } else {
                                    const int kvh = bj;
                                    bf16_t* kp = sample ? ws.ks(j) + ((size_t)(b * 2 + kvh) * 1536 + l) * 128 + d0 : ws.kp() + ((size_t)(b * 2 + kvh) * 256 + l) * 128 + d0;
                                    *(u32x2*)kp = pack4(y1); *(u32x2*)(kp + 32) = pack4(y2);
                                    if (!sample) { float* o = p->out + OUT_K + ((((size_t)b * 2 + j) * 256 + l) * 2 + kvh) * 128 + d0; *(f32x4*)o = y1; *(f32x4*)(o + 32) = y2; }
                                }
                            }
                        }
                }
            });
    }    if (gridDim.x == 256 && bid_() >= 192) {
        const int lo = j == 0 ? WT_A_END : WT_D_END, hi = j == 0 ? WT_B_END : WT_TOT, ib = bid_() - 192;
        if (j == 0) {
            for (int q = ib; q < 128; q += 64) adaln_item(p, ws, 192 + q, lds);
        } else {
            adaln_item(p, ws, 320 + ib, lds);
        }
        wt_all(p, ws, lo + ib, 64, hi, lds);
    }
}

constexpr int AT_KROW = 288, AT_VROW = 288, AT_KB = 64 * AT_KROW, AT_VB = 128 * AT_VROW, AT_STAGE = AT_KB + AT_VB;
DEVI void attn_phase(const WS& ws, int j, unsigned char* lds) {
    const int tid = tid_(), lane = tid & 63, w = tid >> 6, fr = lane & 15, fq = lane >> 4;
    const bf16_t* Q = ws.bufa(); bf16_t* AO = ws.bufb();
    for (int it = bid_(); it < 512; it += gridDim.x) {
        int b, h, qb, skv, row0; const bf16_t *Kb, *Vb;
        if (it < 256) { b = it >> 6; h = (it >> 3) & 7; qb = it & 7; skv = 1536; row0 = NPR + b * 1024 + qb * 128;
            Kb = ws.ks(j) + (size_t)(b * 2 + (h >> 2)) * 1536 * 128; Vb = ws.vts(j) + (size_t)(b * 2 + (h >> 2)) * 128 * 1536; }
        else { const int i2 = it - 256; b = i2 >> 4; h = (i2 >> 1) & 7; qb = i2 & 1; skv = 256; row0 = b * 256 + qb * 128;
            Kb = ws.kp() + (size_t)(b * 2 + (h >> 2)) * 256 * 128; Vb = ws.vtp() + (size_t)(b * 2 + (h >> 2)) * 128 * 256; }
        const int qrow = row0 + w * 16 + fr;
        bf16x8 qf[4];
#pragma unroll
        for (int s = 0; s < 4; ++s) qf[s] = *(const bf16x8*)(Q + (size_t)qrow * DM + h * 128 + s * 32 + fq * 8);
        f32x4 o[8];
#pragma unroll
        for (int m = 0; m < 8; ++m) o[m] = (f32x4){0.f, 0.f, 0.f, 0.f};
        float mrun = -1e30f, lrun = 0.f;
        const int kr0 = tid >> 4, kc = tid & 15;
        const int vr0 = tid >> 3, vc = tid & 7;
        const int vs = vc >> 2, vu = vc & 3;
        const int vslot_lo = vs * 32 + (2 * (vu & 1)) * 8 + (vu >> 1) * 4, vslot_hi = vslot_lo + 8;
        const bf16_t* gk = Kb + (size_t)kr0 * 128 + kc * 8;
        const bf16_t* gv = Vb + (size_t)vr0 * skv + vc * 8;
        u32x4 rk[2], rv[2];
        const int nt = skv >> 6;
        rk[0] = *(const u32x4*)(gk); rk[1] = *(const u32x4*)(gk + 32 * 128);
        rv[0] = *(const u32x4*)(gv); rv[1] = *(const u32x4*)(gv + (size_t)64 * skv);
        {
            unsigned char* sk = lds; unsigned char* sv = lds + AT_KB;
            *(u32x4*)(sk + kr0 * AT_KROW + kc * 16) = rk[0]; *(u32x4*)(sk + (kr0 + 32) * AT_KROW + kc * 16) = rk[1];
#pragma unroll
            for (int q = 0; q < 2; ++q) {
                unsigned char* r = sv + (vr0 + 64 * q) * AT_VROW;
                u32x2 lo; lo.x = rv[q].x; lo.y = rv[q].y; u32x2 hi; hi.x = rv[q].z; hi.y = rv[q].w;
                *(u32x2*)(r + vslot_lo * 2) = lo; *(u32x2*)(r + vslot_hi * 2) = hi;
            }
        }
        __syncthreads();
        for (int kt = 0; kt < nt; ++kt) {
            const bool more = kt + 1 < nt;
            if (more) {
                const int k0 = (kt + 1) * 64;
                rk[0] = *(const u32x4*)(gk + (size_t)k0 * 128); rk[1] = *(const u32x4*)(gk + (size_t)(k0 + 32) * 128);
                rv[0] = *(const u32x4*)(gv + k0); rv[1] = *(const u32x4*)(gv + (size_t)64 * skv + k0);
            }
            const unsigned char* sk = lds + (kt & 1) * AT_STAGE; const unsigned char* sv = sk + AT_KB;
            f32x4 sc[4];
#pragma unroll
            for (int t = 0; t < 4; ++t) {
                sc[t] = (f32x4){0.f, 0.f, 0.f, 0.f};
#pragma unroll
                for (int s = 0; s < 4; ++s) {
                    const bf16x8 kf = *(const bf16x8*)(sk + (t * 16 + fr) * AT_KROW + s * 64 + fq * 16);
                    sc[t] = __builtin_amdgcn_mfma_f32_16x16x32_bf16(kf, qf[s], sc[t], 0, 0, 0);
                }
            }
            bf16x8 vfr[8][2];
#pragma unroll
            for (int m = 0; m < 8; ++m)
#pragma unroll
                for (int s = 0; s < 2; ++s) vfr[m][s] = *(const bf16x8*)(sv + (m * 16 + fr) * AT_VROW + s * 64 + fq * 16);
            float mx = sc[0].x;
#pragma unroll
            for (int t = 0; t < 4; ++t) mx = fmaxf(fmaxf(fmaxf(mx, sc[t].x), fmaxf(sc[t].y, sc[t].z)), sc[t].w);
            mx = fmaxf(mx, __shfl_xor(mx, 16)); mx = fmaxf(mx, __shfl_xor(mx, 32));
            const float mnew = fmaxf(mrun, mx);
            const float alpha = __builtin_amdgcn_exp2f((mrun - mnew) * SM_C);
            mrun = mnew;
            const float mb = -mnew * SM_C;
            float ls = 0.f;
#pragma unroll
            for (int t = 0; t < 4; ++t) {
                sc[t].x = __builtin_amdgcn_exp2f(sc[t].x * SM_C + mb); sc[t].y = __builtin_amdgcn_exp2f(sc[t].y * SM_C + mb);
                sc[t].z = __builtin_amdgcn_exp2f(sc[t].z * SM_C + mb); sc[t].w = __builtin_amdgcn_exp2f(sc[t].w * SM_C + mb);
                ls += (sc[t].x + sc[t].y) + (sc[t].z + sc[t].w);
            }
            lrun = lrun * alpha + ls;
#pragma unroll
            for (int m = 0; m < 8; ++m) o[m] = o[m] * alpha;
            bf16x8 pf[2];
#pragma unroll
            for (int s = 0; s < 2; ++s) {
                u32x4 u; u.x = cvt_pk(sc[2 * s].x, sc[2 * s].y); u.y = cvt_pk(sc[2 * s].z, sc[2 * s].w);
                u.z = cvt_pk(sc[2 * s + 1].x, sc[2 * s + 1].y); u.w = cvt_pk(sc[2 * s + 1].z, sc[2 * s + 1].w);
                pf[s] = __builtin_bit_cast(bf16x8, u);
            }
#pragma unroll
            for (int m = 0; m < 8; ++m)
#pragma unroll
                for (int s = 0; s < 2; ++s) o[m] = __builtin_amdgcn_mfma_f32_16x16x32_bf16(vfr[m][s], pf[s], o[m], 0, 0, 0);
            if (more) {
                unsigned char* wk = lds + ((kt + 1) & 1) * AT_STAGE; unsigned char* wv = wk + AT_KB;
                *(u32x4*)(wk + kr0 * AT_KROW + kc * 16) = rk[0]; *(u32x4*)(wk + (kr0 + 32) * AT_KROW + kc * 16) = rk[1];
#pragma unroll
                for (int q = 0; q < 2; ++q) {
                    unsigned char* r = wv + (vr0 + 64 * q) * AT_VROW;
                    u32x2 lo; lo.x = rv[q].x; lo.y = rv[q].y; u32x2 hi; hi.x = rv[q].z; hi.y = rv[q].w;
                    *(u32x2*)(r + vslot_lo * 2) = lo; *(u32x2*)(r + vslot_hi * 2) = hi;
                }
            }
            __syncthreads();
        }
        float l = lrun; l += __shfl_xor(l, 16); l += __shfl_xor(l, 32);
        const float inv = 1.f / l;
#pragma unroll
        for (int m = 0; m < 8; ++m) *(u32x2*)(AO + (size_t)qrow * DM + h * 128 + m * 16 + fq * 4) = pack4(o[m] * inv);
    }
}

constexpr int N_PHASES = 1 + 7 + 5 + 7 + 5;
#ifndef REP_FFNIN
#define REP_FFNIN 1
#endif
#ifndef REP_ATTN
#define REP_ATTN 1
#endif
#ifndef REP_PREP
#define REP_PREP 1
#endif
#ifndef DBG_N
#define DBG_N 1000
#endif
DEVI void run_phase(PP p, const WS& ws, int ph, unsigned char* lds) {
    if (ph == 0) { for (int rep = 0; rep < REP_PREP; ++rep) prep_a(p, ws, lds); return; }
    int r = ph - 1, layer = 0;
    if (r >= 7) { r -= 7; layer = 1; if (r >= 5) { r -= 5; layer = 2; if (r >= 7) { r -= 7; layer = 3; } } }
    const int j = layer >> 1;
    const bool s5 = (layer & 1) == 0;
    const float* xlo = layer == 0 ? p->in[0] : ws.X();
    const float* xhi = layer == 0 ? p->in[1] : ws.X() + (size_t)NPR * DM;
    int k = r;
    if (s5) {
        if (r == 0) { s5_in_phase(ws, j, lds); return; }
        if (r == 1) { s5_chunk_phase(p, ws, j, lds); return; }
        if (r == 2) { s5_y_phase(ws, j, lds); return; }
        if (r == 3) { glu_phase(ws, j, lds); return; }
        k = r - 4;
        if (k == 0) { out_ln_gemm_phase(p, ws, ws.bufb(), DM, ws.wt_s5out(j), layer, 0, xlo, xhi, layer == 0, lds); return; }
    } else {
        if (r == 0) { qkv_phase(p, ws, j, lds); return; }
        if (r == 1) { for (int rep = 0; rep < REP_ATTN; ++rep) attn_phase(ws, j, lds); return; }
        k = r - 2;
        if (k == 0) { out_ln_gemm_phase(p, ws, ws.bufb(), DM, ws.wt_o(j), layer, 0, xlo, xhi, layer == 0, lds); return; }
    }
    if (k == 1) { for (int rep = 0; rep < REP_FFNIN; ++rep) ffn_in_phase(p, ws, layer, lds); return; }
    out_ln_gemm_phase(p, ws, ws.act(), DFF, ws.wt_ffnout(layer), layer, 1, xlo, xhi, false, lds);
}

__global__ void __launch_bounds__(NTHR) mega(Params p_) {
    extern __shared__ __attribute__((aligned(16))) unsigned char lds[];
    volatile LAS unsigned* xbw = (volatile LAS unsigned*)(LAS unsigned char*)(lds + LDS_XB);
    if (threadIdx.x < 4) xbw[threadIdx.x] = 0u;
    __syncthreads();
    const int ph_lo = p_.ph_lo, ph_hi = p_.ph_hi;
    XcdBarrier xb = xcd_barrier_post((unsigned*)(p_.ws + WS_BAR), xbw);
    for (int ph = ph_lo; ph < ph_hi; ++ph) {
        {
            PP p = (PP)__builtin_amdgcn_kernarg_segment_ptr();
            asm volatile("" : "+s"(p));
            WS ws; ws.b = p->ws;
            run_phase(p, ws, ph, lds);
#ifdef DBG_TWICE
            if (ph == 2) { xcd_barrier(xb); run_phase(p, ws, ph, lds); }
#endif
        }
        if (ph + 1 < ph_hi) {
#if USE_CG
            cg::this_grid().sync();
#else
            if (ph_hi < 0) cg::this_grid().sync();
            xcd_barrier(xb);
#endif
        }
    }
}

extern "C" void kernel_launch(void* const* d_in, const int* in_sizes, int n_in, void* d_out, int out_size, void* d_ws, size_t ws_size, hipStream_t stream) {
    static int grid = 0;
    if (grid == 0) {
        if (n_in != 28 || ws_size < WS_END) { fprintf(stderr, "kernel_launch: unexpected n_in %d or ws_size %zu (< %zu)\n", n_in, ws_size, (size_t)WS_END); grid = -1; return; }
        int dev = 0, cus = 0, per_cu = 0;
        (void)hipGetDevice(&dev);
        (void)hipDeviceGetAttribute(&cus, hipDeviceAttributeMultiprocessorCount, dev);
        (void)hipFuncSetAttribute((const void*)mega, hipFuncAttributeMaxDynamicSharedMemorySize, LDS_BYTES);
        (void)hipOccupancyMaxActiveBlocksPerMultiprocessor(&per_cu, (const void*)mega, NTHR, LDS_BYTES);
        (void)hipGetLastError();
        if (per_cu < 1) per_cu = 1;
        grid = cus * 1;
    }
    if (grid < 0) return;
    (void)hipMemsetAsync((unsigned char*)d_ws + WS_BAR, 0, 16384, stream);
    Params p{};
    for (int i = 0; i < 28; ++i) p.in[i] = (const float*)d_in[i];
    p.out = (float*)d_out; p.ws = (unsigned char*)d_ws; p.ph_lo = 0; p.ph_hi = N_PHASES;
    void* args[] = {&p};
    hipError_t e = hipLaunchCooperativeKernel((const void*)mega, dim3(grid), dim3(NTHR), args, LDS_BYTES, stream);
    if (e != hipSuccess) fprintf(stderr, "cooperative launch failed: %s (grid %d)\n", hipGetErrorString(e), grid);
}
```

```cpp
#include <hip/hip_runtime.h>
#include <hip/hip_cooperative_groups.h>
#include <cstdio>
#include <cstdint>
namespace cg = cooperative_groups;

#define DEVI __device__ __forceinline__
#define LAS __attribute__((address_space(3)))
typedef unsigned short bf16_t;
typedef short bf16x8 __attribute__((ext_vector_type(8)));
typedef float f32x4 __attribute__((ext_vector_type(4)));
typedef float f32x2 __attribute__((ext_vector_type(2)));
typedef unsigned u32x4 __attribute__((ext_vector_type(4)));
typedef unsigned u32x2 __attribute__((ext_vector_type(2)));

constexpr int DM = 1024, NROW = 8192, NPR = 4096, DFF = 2816;
constexpr float ALPHA = 1.681792830507429f;
constexpr float LN_EPS = 1e-6f, RMS_EPS = 1e-6f;
constexpr float SM_C = 0.08838834764831845f * 1.4426950408889634f;

constexpr size_t OUT_Y = 0, OUT_K = 8388608, OUT_V = 10485760, OUT_S = 12582912;

constexpr size_t al256(size_t x) { return (x + 255) & ~(size_t)255; }
constexpr size_t WS_BAR = 0;
constexpr size_t WS_WT_S5IN = 16384;
constexpr size_t WS_WT_GLU = WS_WT_S5IN + 2ull * 1024 * 1024 * 2;
constexpr size_t WS_WT_S5OUT = WS_WT_GLU + 2ull * 2048 * 1024 * 2;
constexpr size_t WS_WT_QKV = WS_WT_S5OUT + 2ull * 1024 * 1024 * 2;
constexpr size_t WS_WT_O = WS_WT_QKV + 2ull * 1536 * 1024 * 2;
constexpr size_t WS_WT_FFNIN = WS_WT_O + 2ull * 1024 * 1024 * 2;
constexpr size_t WS_WT_FFNOUT = WS_WT_FFNIN + 4ull * 5632 * 1024 * 2;
constexpr size_t WS_MG = WS_WT_FFNOUT + 4ull * 1024 * 2816 * 2;
constexpr size_t WS_VG = WS_MG + 2ull * 64 * 512 * 256 * 2;
constexpr size_t WS_LAM16 = WS_VG + 2ull * 64 * 256 * 256 * 2;
constexpr size_t WS_MOD = WS_LAM16 + 2ull * 2 * 64 * 64 * 2 * 4;
constexpr size_t WS_ROPE = WS_MOD + al256(4ull * 5 * 6144 * 4);
constexpr size_t WS_KS = WS_ROPE + 64ull * 32 * 2 * 4;
constexpr size_t KS_LAYER = 4ull * 2 * 1536 * 128 * 2;
constexpr size_t WS_VTS = WS_KS + 2 * KS_LAYER;
constexpr size_t WS_KP = WS_VTS + 2 * KS_LAYER;
constexpr size_t WS_VTP = WS_KP + 16ull * 2 * 256 * 128 * 2;
constexpr size_t WS_X = WS_VTP + 16ull * 2 * 256 * 128 * 2;
constexpr size_t WS_T = WS_X + (size_t)NROW * DM * 4;
constexpr size_t WS_H = WS_T + (size_t)NROW * DM * 4;
constexpr size_t WS_BUFA = WS_H + (size_t)NROW * DM * 2;
constexpr size_t WS_BUFB = WS_BUFA + (size_t)NROW * DM * 2;
constexpr size_t WS_ACT = WS_BUFB + (size_t)NROW * DM * 2;
constexpr size_t WS_SL = WS_ACT + (size_t)NROW * DFF * 2;
constexpr size_t WS_PART = WS_SL + (size_t)NROW * DM * 4;
constexpr size_t WS_END = WS_PART + 8 * (size_t)NROW * 16 * 2 * 4;

constexpr int NTHR = 512;
constexpr int LROW = 144;
constexpr int A_TILE_B = 256 * LROW, B_TILE_B = 128 * LROW, STAGE_B = A_TILE_B + B_TILE_B;
constexpr int LDS_RED = 3 * (256 * 128 + 128 * 128);
constexpr int LDS_XB = LDS_RED + 4096;
constexpr int LDS_BYTES = LDS_XB + 64;

struct Params {
    const float* in[28];
    float* out;
    unsigned char* ws;
    int ph_lo, ph_hi;
};
typedef const __attribute__((address_space(4))) Params* PP;

typedef __bf16 bf16v2 __attribute__((ext_vector_type(2)));
DEVI unsigned cvt_pk(float lo, float hi) { f32x2 v = {lo, hi}; bf16v2 b = __builtin_convertvector(v, bf16v2); return __builtin_bit_cast(unsigned, b); }
DEVI u32x2 pack4(f32x4 v) { u32x2 r; r.x = cvt_pk(v.x, v.y); r.y = cvt_pk(v.z, v.w); return r; }
DEVI float sigmoidf_(float x) { return 1.f / (1.f + __expf(-x)); }
DEVI float siluf_(float x) { return x / (1.f + __expf(-x)); }
DEVI float gelu_tanh(float y) { const float a = 0.7978845608028654f * (y + 0.044715f * y * y * y); const float th = 1.f - 2.f / (__expf(2.f * a) + 1.f); return 0.5f * y * (1.f + th); }

#define XB_TMO      128
#define XB_XCNT(j)  (256  + 64 * (j))
#define XB_XSUB(j)  (1280 + 64 * (j))
#define XB_XGEN(j)  (2304 + 64 * (j))
#define XB_TOP      3328
#define XB_TOPGEN   3392
#define XCD_BAR_WORDS 3456
#define XB_SPIN_CAP (1u << 22)
#define WAITV(n) asm volatile("s_waitcnt vmcnt(" #n ")" ::: "memory")
DEVI unsigned xb_ld(unsigned* p)              { return __hip_atomic_load(p, __ATOMIC_RELAXED, __HIP_MEMORY_SCOPE_AGENT); }
DEVI unsigned xb_add(unsigned* p, unsigned v) { return __hip_atomic_fetch_add(p, v, __ATOMIC_RELAXED, __HIP_MEMORY_SCOPE_AGENT); }
DEVI unsigned xb_xcc_id() { return (unsigned)__builtin_amdgcn_s_getreg((3 << 11) | 20) & 0xFu; }
#define XB_SPIN(cond, bar) do { unsigned _sp = 0; while (cond) { __builtin_amdgcn_s_sleep(1); \
    if ((++_sp & 255u) == 0u) { if (xb_ld(&(bar)[XB_TMO])) break; if (_sp > XB_SPIN_CAP) { atomicAdd(&(bar)[XB_TMO], 1u); break; } } } } while (0)
struct XcdBarrier { unsigned* bar; unsigned x; volatile LAS unsigned* st; };
DEVI XcdBarrier xcd_barrier_post(unsigned* bar, volatile LAS unsigned* st) {
    XcdBarrier b; b.bar = bar; b.x = xb_xcc_id(); b.st = st;
    if (threadIdx.x == 0) (void)xb_add(&bar[XB_XCNT(b.x)], 1u);
    return b;
}
DEVI void xcd_barrier_complete(unsigned* bar, unsigned x, unsigned& nloc, unsigned& nx) {
    const unsigned G = gridDim.x * gridDim.y * gridDim.z;
    unsigned sum, cnt, mine, sp = 0u;
    for (;;) {
        sum = 0u; cnt = 0u; mine = 0u;
#pragma unroll
        for (unsigned j = 0; j < 16; ++j) { const unsigned c = xb_ld(&bar[XB_XCNT(j)]); sum += c; cnt += (c > 0u) ? 1u : 0u; mine = (j == x) ? c : mine; }
        if (sum == G) break;
        __builtin_amdgcn_s_sleep(1);
        if ((++sp & 255u) == 0u) { if (xb_ld(&bar[XB_TMO])) break; if (sp > XB_SPIN_CAP) { atomicAdd(&bar[XB_TMO], 1u); break; } }
    }
    nloc = mine > 0u ? mine : 1u; nx = cnt > 0u ? cnt : 1u;
}
DEVI void xcd_barrier(const XcdBarrier& b) {
    asm volatile("s_waitcnt vmcnt(0)" ::: "memory");
    __syncthreads();
    if (threadIdx.x == 0) {
        unsigned* bar = b.bar;
        __builtin_amdgcn_s_waitcnt(0);
        unsigned nloc = b.st[0], nx = b.st[1];
        if (nloc == 0u) { xcd_barrier_complete(bar, b.x, nloc, nx); b.st[0] = nloc; b.st[1] = nx; }
        const unsigned old = xb_add(&bar[XB_XSUB(b.x)], 1u);
        const unsigned gen = old / nloc;
        if (old + 1u == (gen + 1u) * nloc) {
            __builtin_amdgcn_fence(__ATOMIC_RELEASE, "agent");
            asm volatile("s_waitcnt vmcnt(0)" ::: "memory");
            const unsigned og = xb_add(&bar[XB_TOP], 1u);
            const unsigned tg = og / nx;
            if (og + 1u == (tg + 1u) * nx) xb_add(&bar[XB_TOPGEN], 1u);
            else XB_SPIN(xb_ld(&bar[XB_TOPGEN]) == tg, bar);
            __builtin_amdgcn_fence(__ATOMIC_ACQUIRE, "agent");
            xb_add(&bar[XB_XGEN(b.x)], 1u);
            asm volatile("s_waitcnt vmcnt(0)" ::: "memory");
        } else {
            XB_SPIN(xb_ld(&bar[XB_XGEN(b.x)]) == gen, bar);
            __builtin_amdgcn_fence(__ATOMIC_ACQUIRE, "agent");
            asm volatile("s_waitcnt vmcnt(0)" ::: "memory");
        }
    }
    __syncthreads();
}

DEVI int tid_() { int t = threadIdx.x; asm volatile("" : "+v"(t)); return t; }
DEVI int bid_() { int b = blockIdx.x; asm volatile("" : "+s"(b)); return b; }
#ifndef PF_DIST
#define PF_DIST 2
#endif
constexpr int GA_B = 256 * 128, GB_B = 128 * 128, GSTAGE = GA_B + GB_B, GNST = 3;
template <class Epi>
DEVI void gemm_tile(const bf16_t* __restrict__ A, size_t lda, const bf16_t* __restrict__ Bt, size_t ldb, int K, unsigned char* lds, Epi epi, int koff = 0) {
    const int tid = tid_(), lane = tid & 63, w = tid >> 6, wr = w >> 1, wc = w & 1, fr = lane & 15, fq = lane >> 4;
    f32x4 acc[4][4];
#pragma unroll
    for (int i = 0; i < 4; ++i)
#pragma unroll
        for (int n = 0; n < 4; ++n) acc[i][n] = (f32x4){0.f, 0.f, 0.f, 0.f};
    const int lr8 = lane >> 3, pch = lane & 7;
    const bf16_t* ga[4]; const bf16_t* gb[2];
#pragma unroll
    for (int i = 0; i < 4; ++i) { const int row = (i * 8 + w) * 8 + lr8; ga[i] = A + (size_t)row * lda + ((pch ^ ((row >> 1) & 7)) * 8); }
#pragma unroll
    for (int i = 0; i < 2; ++i) { const int row = (i * 8 + w) * 8 + lr8; gb[i] = Bt + (size_t)row * ldb + ((pch ^ ((row >> 1) & 7)) * 8); }
    const int dofs = w * 1024 + lane * 16;
    const int nk = K >> 6;
    const unsigned ldsbase = (unsigned)(uintptr_t)(LAS unsigned char*)lds;
    const int sx = fr >> 1;
    const int aofs0 = (wr * 64 + fr) * 128 + ((fq ^ sx) * 16), aofs1 = (wr * 64 + fr) * 128 + (((4 + fq) ^ sx) * 16);
    const int bofs0 = GA_B + (wc * 64 + fr) * 128 + ((fq ^ sx) * 16), bofs1 = GA_B + (wc * 64 + fr) * 128 + (((4 + fq) ^ sx) * 16);
#define GEMM_ISSUE(stage, kt_) do { unsigned char* _sb = lds + (stage) * GSTAGE + dofs; int _kk = (kt_) + koff; if (_kk >= nk) _kk -= nk; const int _ko = _kk * 64; \
        _Pragma("unroll") for (int _i = 0; _i < 4; ++_i) __builtin_amdgcn_global_load_lds((const unsigned*)(ga[_i] + _ko), (LAS unsigned*)(LAS unsigned char*)(_sb + _i * 8192), 16, 0, 0); \
        _Pragma("unroll") for (int _i = 0; _i < 2; ++_i) __builtin_amdgcn_global_load_lds((const unsigned*)(gb[_i] + _ko), (LAS unsigned*)(LAS unsigned char*)(_sb + GA_B + _i * 8192), 16, 0, 0); } while (0)
    WAITV(0);
    __builtin_amdgcn_s_barrier();
    GEMM_ISSUE(0, 0);
#if PF_DIST == 2
    if (nk > 1) GEMM_ISSUE(1, 1);
#endif
    int st = 0;
    for (int kt = 0; kt < nk; ++kt) {
#if PF_DIST == 2
        if (kt + 1 < nk) WAITV(6); else WAITV(0);
#else
        WAITV(0);
#endif
        __builtin_amdgcn_s_barrier();
        const unsigned sb = ldsbase + st * GSTAGE;
        bf16x8 af[2][4], bfr[2][4];
#define DSR(dst, addr, off) asm volatile("ds_read_b128 %0, %1 offset:%2" : "=v"(dst) : "v"(addr), "n"(off))
        { const unsigned ab0 = sb + bofs0, aa0 = sb + aofs0, ab1 = sb + bofs1, aa1 = sb + aofs1;
          DSR(bfr[0][0], ab0, 0); DSR(bfr[0][1], ab0, 2048); DSR(bfr[0][2], ab0, 4096); DSR(bfr[0][3], ab0, 6144);
          DSR(af[0][0], aa0, 0); DSR(af[0][1], aa0, 2048); DSR(af[0][2], aa0, 4096); DSR(af[0][3], aa0, 6144);
          DSR(bfr[1][0], ab1, 0); DSR(bfr[1][1], ab1, 2048); DSR(bfr[1][2], ab1, 4096); DSR(bfr[1][3], ab1, 6144);
          DSR(af[1][0], aa1, 0); DSR(af[1][1], aa1, 2048); DSR(af[1][2], aa1, 4096);
          asm volatile("s_waitcnt lgkmcnt(7)" : "+v"(bfr[0][0]), "+v"(bfr[0][1]), "+v"(bfr[0][2]), "+v"(bfr[0][3]), "+v"(af[0][0]), "+v"(af[0][1]), "+v"(af[0][2]), "+v"(af[0][3]));
          DSR(af[1][3], aa1, 6144); }
        __builtin_amdgcn_s_setprio(1);
#pragma unroll
        for (int i = 0; i < 4; ++i)
#pragma unroll
            for (int n = 0; n < 4; ++n) acc[i][n] = __builtin_amdgcn_mfma_f32_16x16x32_bf16(bfr[0][n], af[0][i], acc[i][n], 0, 0, 0);
        __builtin_amdgcn_s_setprio(0);
        __builtin_amdgcn_sched_barrier(0);
#if PF_DIST == 2
        if (kt + 2 < nk) { const int s2 = st >= 1 ? st - 1 : 2; GEMM_ISSUE(s2, kt + 2); }
#else
        if (kt + 1 < nk) { const int s2 = st == 2 ? 0 : st + 1; GEMM_ISSUE(s2, kt + 1); }
#endif
        __builtin_amdgcn_sched_barrier(0);
        asm volatile("s_waitcnt lgkmcnt(0)" : "+v"(bfr[1][0]), "+v"(bfr[1][1]), "+v"(bfr[1][2]), "+v"(bfr[1][3]), "+v"(af[1][0]), "+v"(af[1][1]), "+v"(af[1][2]), "+v"(af[1][3]));
        __builtin_amdgcn_s_setprio(1);
#pragma unroll
        for (int i = 0; i < 4; ++i)
#pragma unroll
            for (int n = 0; n < 4; ++n) acc[i][n] = __builtin_amdgcn_mfma_f32_16x16x32_bf16(bfr[1][n], af[1][i], acc[i][n], 0, 0, 0);
        __builtin_amdgcn_s_setprio(0);
        st = st == 2 ? 0 : st + 1;
    }
    epi(acc, wr, wc, fr, fq);
}

constexpr int H_HALF = 256 * 64, HSTAGE = 2 * H_HALF;
template <class Epi>
DEVI void gemm_tile256(const bf16_t* __restrict__ A, size_t lda, const bf16_t* __restrict__ Bt, size_t ldb, int K, unsigned char* lds, Epi epi) {
    const int tid = tid_(), lane = tid & 63, w = tid >> 6, wr = w >> 2, wc = w & 3, fr = lane & 15, fq = lane >> 4;
    f32x4 acc[8][4];
#pragma unroll
    for (int i = 0; i < 8; ++i)
#pragma unroll
        for (int n = 0; n < 4; ++n) acc[i][n] = (f32x4){0.f, 0.f, 0.f, 0.f};
    const int lr4 = lane >> 2, pch = lane & 3;
    const bf16_t* ga[2]; const bf16_t* gb[2];
#pragma unroll
    for (int i = 0; i < 2; ++i) { const int row = (i * 8 + w) * 16 + lr4; const int lch = pch ^ ((0x1320 >> (((row >> 2) & 3) * 4)) & 3); ga[i] = A + (size_t)row * lda + lch * 8; gb[i] = Bt + (size_t)row * ldb + lch * 8; }
    const int dofs = w * 1024 + lane * 16;
    const int nk = K >> 5;
    const unsigned ldsbase = (unsigned)(uintptr_t)(LAS unsigned char*)lds;
    const int pcs = (fq ^ ((0x1320 >> (((fr >> 2) & 3) * 4)) & 3)) * 16;
    const int aofs = (wr * 128 + fr) * 64 + pcs, bofs = H_HALF + (wc * 64 + fr) * 64 + pcs;
#define H_ISSUE(stage, kt_) do { unsigned char* _sb = lds + (stage) * HSTAGE + dofs; const int _ko = (kt_) * 32; \
        _Pragma("unroll") for (int _i = 0; _i < 2; ++_i) __builtin_amdgcn_global_load_lds((const unsigned*)(ga[_i] + _ko), (LAS unsigned*)(LAS unsigned char*)(_sb + _i * 8192), 16, 0, 0); \
        _Pragma("unroll") for (int _i = 0; _i < 2; ++_i) __builtin_amdgcn_global_load_lds((const unsigned*)(gb[_i] + _ko), (LAS unsigned*)(LAS unsigned char*)(_sb + H_HALF + _i * 8192), 16, 0, 0); } while (0)
#define DSR2(dst, addr, off) asm volatile("ds_read_b128 %0, %1 offset:%2" : "=v"(dst) : "v"(addr), "n"(off))
    const int wu = __builtin_amdgcn_readfirstlane(w);
    bf16x8 af[8], bfr[4];
#define H_READS(stg) do { const unsigned sa = ldsbase + (stg) * HSTAGE + aofs, sb = ldsbase + (stg) * HSTAGE + bofs; \
        DSR2(bfr[0], sb, 0); DSR2(bfr[1], sb, 1024); DSR2(bfr[2], sb, 2048); DSR2(bfr[3], sb, 3072); \
        DSR2(af[0], sa, 0); DSR2(af[1], sa, 1024); DSR2(af[2], sa, 2048); DSR2(af[3], sa, 3072); \
        DSR2(af[4], sa, 4096); DSR2(af[5], sa, 5120); DSR2(af[6], sa, 6144); DSR2(af[7], sa, 7168); } while (0)
#define H_WAIT_LO(n_) asm volatile("s_waitcnt lgkmcnt(" #n_ ")" : "+v"(bfr[0]), "+v"(bfr[1]), "+v"(bfr[2]), "+v"(bfr[3]), "+v"(af[0]), "+v"(af[1]), "+v"(af[2]), "+v"(af[3]))
#define H_WAIT_HI() asm volatile("s_waitcnt lgkmcnt(0)" : "+v"(af[4]), "+v"(af[5]), "+v"(af[6]), "+v"(af[7]))
#define H_MMA2(i0) do { __builtin_amdgcn_s_setprio(1); \
        _Pragma("unroll") for (int i = (i0); i < (i0) + 2; ++i) _Pragma("unroll") for (int n = 0; n < 4; ++n) acc[i][n] = __builtin_amdgcn_mfma_f32_16x16x32_bf16(bfr[n], af[i], acc[i][n], 0, 0, 0); \
        __builtin_amdgcn_s_setprio(0); __builtin_amdgcn_sched_barrier(0); } while (0)
#define H_PIECE(stage, kt_, j_) do { if ((kt_) < nk) { unsigned char* _sb = lds + (stage) * HSTAGE + dofs; const int _ko = (kt_) * 32; \
        if ((j_) < 2) __builtin_amdgcn_global_load_lds((const unsigned*)(ga[(j_) & 1] + _ko), (LAS unsigned*)(LAS unsigned char*)(_sb + ((j_) & 1) * 8192), 16, 0, 0); \
        else __builtin_amdgcn_global_load_lds((const unsigned*)(gb[(j_) & 1] + _ko), (LAS unsigned*)(LAS unsigned char*)(_sb + H_HALF + ((j_) & 1) * 8192), 16, 0, 0); } \
        __builtin_amdgcn_sched_barrier(0); } while (0)
#define H_SCHED() __builtin_amdgcn_sched_barrier(0)
    WAITV(0);
    __builtin_amdgcn_s_barrier();
    H_ISSUE(0, 0); H_ISSUE(1, 1); H_ISSUE(2, 2);
    if (wu < 4) {
        for (int kt = 0; kt < nk; ++kt) {
            if (kt + 2 < nk) WAITV(8); else if (kt + 1 < nk) WAITV(4); else WAITV(0);
            __builtin_amdgcn_s_barrier();
            const int s3 = (kt + 3) & 3;
            H_READS(kt & 3); H_SCHED();
            H_WAIT_LO(4);
            H_MMA2(0); H_PIECE(s3, kt + 3, 0);
            H_MMA2(2); H_PIECE(s3, kt + 3, 1);
            H_WAIT_HI();
            H_MMA2(4); H_PIECE(s3, kt + 3, 2);
            H_MMA2(6); H_PIECE(s3, kt + 3, 3);
        }
    } else {
        for (int kt = 0; kt < nk; ++kt) {
            if (kt + 2 < nk) WAITV(8); else if (kt + 1 < nk) WAITV(4); else WAITV(0);
            __builtin_amdgcn_s_barrier();
            const int s3 = (kt + 3) & 3;
            if (kt > 0) {
                H_MMA2(0); H_PIECE(s3, kt + 3, 0);
                H_MMA2(2); H_PIECE(s3, kt + 3, 1);
                H_MMA2(4); H_PIECE(s3, kt + 3, 2);
                H_MMA2(6); H_PIECE(s3, kt + 3, 3);
            } else { H_PIECE(s3, kt + 3, 0); H_PIECE(s3, kt + 3, 1); H_PIECE(s3, kt + 3, 2); H_PIECE(s3, kt + 3, 3); }
            H_READS(kt & 3); H_SCHED();
            H_WAIT_LO(0); H_WAIT_HI();
            H_SCHED();
        }
        H_MMA2(0); H_MMA2(2); H_MMA2(4); H_MMA2(6);
    }
    epi(acc, wr, wc, fr, fq);
}

DEVI int p8_lds_byte(int r, int c) { const int st = (r >> 4) * 2 + (c >> 5), rr = r & 15, cc = c & 31, ob = rr * 64 + cc * 2; return st * 1024 + (ob ^ (((ob >> 9) & 1) << 5)); }
DEVI void p8_stage_rc(int b, int& R, int& C) { const int st = b / 1024, sb = b % 1024, swz = sb ^ (((sb >> 9) & 1) << 5); R = (st >> 1) * 16 + swz / 64; C = (st & 1) * 32 + (swz % 64) / 2; }
template <bool SWAP = true, class Epi>
DEVI void gemm_tile8p(const bf16_t* __restrict__ A, const bf16_t* __restrict__ Bt, int K, unsigned char* lds, Epi epi) {
    constexpr int HTB = 128 * 64 * 2;
    const int tid = tid_(), lane = tid & 63, wid = __builtin_amdgcn_readfirstlane(tid >> 6), wr = wid >> 2, wc = wid & 3, fr = lane & 15, fq = lane >> 4;
    f32x4 acc[2][2][4][2];
#pragma unroll
    for (int a_ = 0; a_ < 2; ++a_)
#pragma unroll
        for (int b_ = 0; b_ < 2; ++b_)
#pragma unroll
            for (int m = 0; m < 4; ++m)
#pragma unroll
                for (int n = 0; n < 2; ++n) acc[a_][b_][m][n] = (f32x4){0.f, 0.f, 0.f, 0.f};
    bf16x8 At[4][2], B0[2][2], B1[2][2];
    unsigned voff[2];
#pragma unroll
    for (int i = 0; i < 2; ++i) { int R, C; p8_stage_rc(tid * 16 + i * 8192, R, C); voff[i] = (unsigned)(R * K + C); }
    const int aoff = p8_lds_byte(wr * 64 + fr, fq * 8), boff = p8_lds_byte(wc * 32 + fr, fq * 8);
    const size_t hstep = (size_t)128 * K;
    const int nt = K >> 6;
#define P8_SA(b, h) (((b) * 2 + (h)) * HTB)
#define P8_SB(b, h) ((4 + (b) * 2 + (h)) * HTB)
#define P8_STAGE(bufoff, gbase, kt_) do { _Pragma("unroll") for (int _i = 0; _i < 2; ++_i) \
        __builtin_amdgcn_global_load_lds((const unsigned*)((gbase) + voff[_i] + (size_t)(kt_) * 64), (LAS unsigned*)(LAS unsigned char*)(lds + (bufoff) + tid * 16 + _i * 8192), 16, 0, 0); } while (0)
#define P8_LDA(dst, b, h) do { _Pragma("unroll") for (int m = 0; m < 4; ++m) _Pragma("unroll") for (int k = 0; k < 2; ++k) dst[m][k] = *(const bf16x8*)(lds + P8_SA(b, h) + aoff + m * 2048 + k * 1024); } while (0)
#define P8_LDB(dst, b, h) do { _Pragma("unroll") for (int n = 0; n < 2; ++n) _Pragma("unroll") for (int k = 0; k < 2; ++k) dst[n][k] = *(const bf16x8*)(lds + P8_SB(b, h) + boff + n * 2048 + k * 1024); } while (0)
#define P8_MMA(ai, bj, At_, Bt_) do { __builtin_amdgcn_s_setprio(1); _Pragma("unroll") for (int m = 0; m < 4; ++m) _Pragma("unroll") for (int n = 0; n < 2; ++n) _Pragma("unroll") for (int k = 0; k < 2; ++k) \
        acc[ai][bj][m][n] = SWAP ? __builtin_amdgcn_mfma_f32_16x16x32_bf16(Bt_[n][k], At_[m][k], acc[ai][bj][m][n], 0, 0, 0) : __builtin_amdgcn_mfma_f32_16x16x32_bf16(At_[m][k], Bt_[n][k], acc[ai][bj][m][n], 0, 0, 0); __builtin_amdgcn_s_setprio(0); } while (0)
#define P8_WAIT_L(n) asm volatile("s_waitcnt lgkmcnt(" #n ")" ::: "memory")
#define P8_BAR __builtin_amdgcn_s_barrier()
#define P8_SCHED __builtin_amdgcn_sched_barrier(0)
    const bf16_t* cA = A; const bf16_t* cB = Bt;
    WAITV(0);
    P8_BAR;
    P8_STAGE(P8_SB(0, 0), cB, 0); P8_STAGE(P8_SA(0, 0), cA, 0); P8_STAGE(P8_SB(0, 1), cB + hstep, 0); P8_STAGE(P8_SA(0, 1), cA + hstep, 0);
    if (wr == 1) P8_BAR;
    WAITV(4); P8_BAR;
    P8_STAGE(P8_SB(1, 0), cB, 1); P8_STAGE(P8_SA(1, 0), cA, 1); P8_STAGE(P8_SB(1, 1), cB + hstep, 1);
    WAITV(6); P8_BAR;
    for (int t = 0; t < nt - 2; t += 2) {
        P8_LDB(B0, 0, 0); P8_SCHED; P8_LDA(At, 0, 0); P8_STAGE(P8_SA(1, 1), cA + hstep, t + 1);
        P8_WAIT_L(8); P8_BAR; P8_WAIT_L(0); P8_MMA(0, 0, At, B0); P8_BAR; P8_SCHED;
        P8_LDB(B1, 0, 1); P8_STAGE(P8_SB(0, 0), cB, t + 2);
        P8_BAR; P8_WAIT_L(0); P8_MMA(0, 1, At, B1); P8_BAR;
        P8_LDA(At, 0, 1); P8_STAGE(P8_SA(0, 0), cA, t + 2);
        P8_BAR; P8_WAIT_L(0); P8_MMA(1, 0, At, B0); P8_BAR; P8_SCHED;
        P8_STAGE(P8_SB(0, 1), cB + hstep, t + 2);
        WAITV(6); P8_BAR; P8_MMA(1, 1, At, B1); P8_BAR;
        P8_LDB(B0, 1, 0); P8_SCHED; P8_LDA(At, 1, 0); P8_STAGE(P8_SA(0, 1), cA + hstep, t + 2);
        P8_WAIT_L(8); P8_BAR; P8_WAIT_L(0); P8_MMA(0, 0, At, B0); P8_BAR; P8_SCHED;
        P8_LDB(B1, 1, 1); P8_STAGE(P8_SB(1, 0), cB, t + 3);
        P8_BAR; P8_WAIT_L(0); P8_MMA(0, 1, At, B1); P8_BAR;
        P8_LDA(At, 1, 1); P8_STAGE(P8_SA(1, 0), cA, t + 3);
        P8_BAR; P8_WAIT_L(0); P8_MMA(1, 0, At, B0); P8_BAR; P8_SCHED;
        P8_STAGE(P8_SB(1, 1), cB + hstep, t + 3);
        WAITV(6); P8_BAR; P8_MMA(1, 1, At, B1); P8_BAR;
    }
    { P8_LDB(B0, 0, 0); P8_LDA(At, 0, 0); P8_STAGE(P8_SA(1, 1), cA + hstep, nt - 1);
      P8_BAR; P8_WAIT_L(0); P8_MMA(0, 0, At, B0); P8_BAR;
      P8_LDB(B1, 0, 1); P8_BAR; P8_WAIT_L(0); P8_MMA(0, 1, At, B1); P8_BAR;
      P8_LDA(At, 0, 1); WAITV(4); P8_BAR; P8_WAIT_L(0); P8_MMA(1, 0, At, B0); P8_MMA(1, 1, At, B1); P8_BAR; }
    { P8_LDB(B0, 1, 0); P8_LDA(At, 1, 0); WAITV(2); P8_BAR; P8_WAIT_L(0); P8_MMA(0, 0, At, B0); P8_BAR;
      P8_LDB(B1, 1, 1); WAITV(0); P8_BAR; P8_WAIT_L(0); P8_MMA(0, 1, At, B1); P8_BAR;
      P8_LDA(At, 1, 1); P8_BAR; P8_WAIT_L(0); P8_MMA(1, 0, At, B0); P8_MMA(1, 1, At, B1); P8_BAR; }
    if (wr == 0) P8_BAR;
    epi(acc, wr, wc, fr, fq);
}

struct WS {
    unsigned char* b;
    DEVI bf16_t* wt_s5in(int j) const { return (bf16_t*)(b + WS_WT_S5IN) + (size_t)j * 1024 * 1024; }
    DEVI bf16_t* wt_glu(int j) const { return (bf16_t*)(b + WS_WT_GLU) + (size_t)j * 2048 * 1024; }
    DEVI bf16_t* wt_s5out(int j) const { return (bf16_t*)(b + WS_WT_S5OUT) + (size_t)j * 1024 * 1024; }
    DEVI bf16_t* wt_qkv(int j) const { return (bf16_t*)(b + WS_WT_QKV) + (size_t)j * 1536 * 1024; }
    DEVI bf16_t* wt_o(int j) const { return (bf16_t*)(b + WS_WT_O) + (size_t)j * 1024 * 1024; }
    DEVI bf16_t* wt_ffnin(int l) const { return (bf16_t*)(b + WS_WT_FFNIN) + (size_t)l * 5632 * 1024; }
    DEVI bf16_t* wt_ffnout(int l) const { return (bf16_t*)(b + WS_WT_FFNOUT) + (size_t)l * 1024 * 2816; }
    DEVI bf16_t* mg(int j, int g) const { return (bf16_t*)(b + WS_MG) + ((size_t)(j * 64 + g) * 512) * 256; }
    DEVI bf16_t* vg(int j, int g) const { return (bf16_t*)(b + WS_VG) + ((size_t)(j * 64 + g) * 256) * 256; }
    DEVI float* lam16() const { return (float*)(b + WS_LAM16); }
    DEVI float* mod(int layer, int cond, int chunk) const { return (float*)(b + WS_MOD) + ((size_t)(layer * 5 + cond) * 6144 + chunk * 1024); }
    DEVI float* rope() const { return (float*)(b + WS_ROPE); }
    DEVI bf16_t* ks(int j) const { return (bf16_t*)(b + WS_KS + j * KS_LAYER); }
    DEVI bf16_t* vts(int j) const { return (bf16_t*)(b + WS_VTS + j * KS_LAYER); }
    DEVI bf16_t* kp() const { return (bf16_t*)(b + WS_KP); }
    DEVI bf16_t* vtp() const { return (bf16_t*)(b + WS_VTP); }
    DEVI float* X() const { return (float*)(b + WS_X); }
    DEVI float* T() const { return (float*)(b + WS_T); }
    DEVI bf16_t* H() const { return (bf16_t*)(b + WS_H); }
    DEVI bf16_t* bufa() const { return (bf16_t*)(b + WS_BUFA); }
    DEVI bf16_t* bufb() const { return (bf16_t*)(b + WS_BUFB); }
    DEVI bf16_t* act() const { return (bf16_t*)(b + WS_ACT); }
    DEVI float* sl() const { return (float*)(b + WS_SL); }
    DEVI float* part() const { return (float*)(b + WS_PART); }
};
DEVI int cond_of_row(int row) { return row < NPR ? 0 : 1 + ((row - NPR) >> 10); }

DEVI void s5_mats_item(PP p, const WS& ws, int item, unsigned char* lds) {
    const int j = item >> 6, g = item & 63, tid = tid_();
    float* lamp = (float*)lds;
    float* bbar = lamp + 2 * 64 * 17 * 2;
    float* ktab = bbar + 2 * 64 * 16 * 2;
    if (tid < 128) {
        const int dir = tid >> 6, pp = tid & 63;
        const int gi = (j * 2 + dir) * 64 + g, idx = gi * 64 + pp;
        const float are = p->in[12][idx], aim = p->in[13][idx], dt = expf(p->in[14][gi]);
        const float mag = expf(dt * are);
        float sn, cs; sincosf(dt * aim, &sn, &cs);
        const float lr = mag * cs, li = mag * sn;
        const float den = are * are + aim * aim, nr = lr - 1.f;
        const float kre = (nr * are + li * aim) / den, kim = (li * are - nr * aim) / den;
        float pr = 1.f, pi = 0.f;
        float* lp = lamp + (dir * 64 + pp) * 34;
        for (int e = 0; e <= 16; ++e) { lp[2 * e] = pr; lp[2 * e + 1] = pi; const float t = pr * lr - pi * li; pi = pr * li + pi * lr; pr = t; }
        float* l16 = ws.lam16() + (size_t)idx * 2; l16[0] = lp[32]; l16[1] = lp[33];
        const float* bre = p->in[15] + (size_t)idx * 16; const float* bim = p->in[16] + (size_t)idx * 16;
        float* bb = bbar + (dir * 64 + pp) * 32;
        for (int h = 0; h < 16; ++h) { const float br = bre[h], bi = bim[h]; bb[h] = kre * br - kim * bi; bb[16 + h] = kre * bi + kim * br; }
    }
    __syncthreads();
    {
        const int dir = tid >> 8, tau = (tid >> 4) & 15, h = tid & 15;
        const float* cre = p->in[17] + ((size_t)((j * 2 + dir) * 64 + g) * 16 + h) * 64;
        const float* cim = p->in[18] + ((size_t)((j * 2 + dir) * 64 + g) * 16 + h) * 64;
        f32x4 a4[4];
#pragma unroll
        for (int q = 0; q < 4; ++q) a4[q] = (f32x4){0.f, 0.f, 0.f, 0.f};
        for (int pp = 0; pp < 64; ++pp) {
            const float cr = cre[pp], ci = cim[pp];
            const float lr = lamp[(dir * 64 + pp) * 34 + 2 * tau], li = lamp[(dir * 64 + pp) * 34 + 2 * tau + 1];
            const float qr = cr * lr - ci * li, qi = cr * li + ci * lr;
            const f32x4* br4 = (const f32x4*)(bbar + (dir * 64 + pp) * 32);
#pragma unroll
            for (int q = 0; q < 4; ++q) a4[q] += br4[q] * qr - br4[4 + q] * qi;
        }
        float* kt = ktab + ((dir * 16 + tau) * 16 + h) * 16;
#pragma unroll
        for (int q = 0; q < 4; ++q) *(f32x4*)(kt + 4 * q) = a4[q];
    }
    __syncthreads();
    bf16_t* Mg = ws.mg(j, g);
    bf16_t* Vg = ws.vg(j, g);
    const float* dsk = p->in[19] + j * 1024 + g * 16;
    for (int i8 = tid; i8 < 8192; i8 += NTHR) {
        const int m = i8 >> 5, k8 = (i8 & 31) * 8;
        {
            const int t = m >> 4, h = m & 15, t2 = k8 >> 4, h0 = k8 & 15;
            float v[8];
#pragma unroll
            for (int e = 0; e < 8; ++e) {
                float x = 0.f;
                if (t2 <= t) x += ktab[((0 * 16 + (t - t2)) * 16 + h) * 16 + h0 + e];
                if (t2 >= t) x += ktab[((1 * 16 + (t2 - t)) * 16 + h) * 16 + h0 + e];
                if (t2 == t && h0 + e == h) x += dsk[h];
                v[e] = x;
            }
            u32x4 o; o.x = cvt_pk(v[0], v[1]); o.y = cvt_pk(v[2], v[3]); o.z = cvt_pk(v[4], v[5]); o.w = cvt_pk(v[6], v[7]);
            *(u32x4*)(Mg + (size_t)m * 256 + k8) = o;
        }
        {
            const int dir = m >> 7, ri = (m >> 6) & 1, pp = m & 63, t2 = k8 >> 4, h0 = k8 & 15;
            const int e = dir == 0 ? 15 - t2 : t2;
            const float lr = lamp[(dir * 64 + pp) * 34 + 2 * e], li = lamp[(dir * 64 + pp) * 34 + 2 * e + 1];
            const float* bb = bbar + (dir * 64 + pp) * 32;
            float v[8];
#pragma unroll
            for (int q = 0; q < 8; ++q) { const float br = bb[h0 + q], bi = bb[16 + h0 + q]; v[q] = ri == 0 ? lr * br - li * bi : lr * bi + li * br; }
            u32x4 o; o.x = cvt_pk(v[0], v[1]); o.y = cvt_pk(v[2], v[3]); o.z = cvt_pk(v[4], v[5]); o.w = cvt_pk(v[6], v[7]);
            *(u32x4*)(Mg + (size_t)(256 + m) * 256 + k8) = o;
        }
        {
            const int t = m >> 4, h = m & 15, dir = k8 >> 7, ri = (k8 >> 6) & 1, p0 = k8 & 63;
            const int e = dir == 0 ? t + 1 : 16 - t;
            const float* cre = p->in[17] + ((size_t)((j * 2 + dir) * 64 + g) * 16 + h) * 64 + p0;
            const float* cim = p->in[18] + ((size_t)((j * 2 + dir) * 64 + g) * 16 + h) * 64 + p0;
            float v[8];
#pragma unroll
            for (int q = 0; q < 8; ++q) {
                const float cr = cre[q], ci = cim[q];
                const float lr = lamp[(dir * 64 + p0 + q) * 34 + 2 * e], li = lamp[(dir * 64 + p0 + q) * 34 + 2 * e + 1];
                v[q] = ri == 0 ? (cr * lr - ci * li) : -(cr * li + ci * lr);
            }
            u32x4 o; o.x = cvt_pk(v[0], v[1]); o.y = cvt_pk(v[2], v[3]); o.z = cvt_pk(v[4], v[5]); o.w = cvt_pk(v[6], v[7]);
            *(u32x4*)(Vg + (size_t)m * 256 + k8) = o;
        }
    }
    __syncthreads();
}

DEVI void adaln_item(PP p, const WS& ws, int item, unsigned char* lds) {
    const int layer = item / 96, cgp = item % 96, tid = tid_();
    float* sil = (float*)lds;
    float* red = sil + 5 * 1024;
    for (int i = tid; i < 5120; i += NTHR) { const int c = i >> 10, k = i & 1023; const float v = c == 0 ? p->in[6][k] : p->in[2][(c - 1) * 1024 + k]; sil[i] = siluf_(v); }
    __syncthreads();
    const int c4 = tid & 15, kr = tid >> 4;
    f32x4 a[5];
#pragma unroll
    for (int c = 0; c < 5; ++c) a[c] = (f32x4){0.f, 0.f, 0.f, 0.f};
    const float* wb = p->in[7] + (size_t)layer * 1024 * 6144 + cgp * 64 + c4 * 4;
    for (int k0 = kr; k0 < 1024; k0 += 256) {
        f32x4 w4[8];
#pragma unroll
        for (int u = 0; u < 8; ++u) w4[u] = *(const f32x4*)(wb + (size_t)(k0 + 32 * u) * 6144);
#pragma unroll
        for (int u = 0; u < 8; ++u)
#pragma unroll
            for (int c = 0; c < 5; ++c) a[c] += w4[u] * sil[c * 1024 + k0 + 32 * u];
    }
#pragma unroll
    for (int c = 0; c < 5; ++c) *(f32x4*)(red + (kr * 5 + c) * 64 + c4 * 4) = a[c];
    __syncthreads();
    if (tid < 320) {
        const int c = tid >> 6, col = tid & 63;
        float s = p->in[8][layer * 6144 + cgp * 64 + col];
        for (int r = 0; r < 32; ++r) s += red[(r * 5 + c) * 64 + col];
        ((float*)(ws.b + WS_MOD))[(size_t)(layer * 5 + c) * 6144 + cgp * 64 + col] = s;
    }
    if (item < 32) {
        WAITV(0);
        __syncthreads();
        if (tid == 0) { __builtin_amdgcn_fence(__ATOMIC_RELEASE, "agent"); WAITV(0); xb_add((unsigned*)(ws.b + WS_BAR) + 3713, 1u); }
    }
    __syncthreads();
}

struct WtD { const float* src; bf16_t* dst; int K, N, half, tile; };
constexpr int WT_L0_END = 784, WT_A_END = 1296, WT_B_END = 1744, WT_C_END = 2256, WT_D_END = 2768, WT_TOT = 2944;
DEVI WtD wt_make(PP p, const WS& ws, int kind, int l, int tile) {
    WtD d; d.tile = tile;
    if (kind == 0) { d.src = p->in[26] + (size_t)l * 1024 * 5632; d.dst = ws.wt_ffnin(l); d.K = 1024; d.N = 5632; d.half = 2816; }
    else if (kind == 1) { d.src = p->in[27] + (size_t)l * 2816 * 1024; d.dst = ws.wt_ffnout(l); d.K = 2816; d.N = 1024; d.half = 0; }
    else if (kind == 2) { d.src = p->in[20] + (size_t)l * 1024 * 2048; d.dst = ws.wt_glu(l); d.K = 1024; d.N = 2048; d.half = 1024; }
    else if (kind == 3) { d.src = p->in[22] + (size_t)l * 1024 * 1536; d.dst = ws.wt_qkv(l); d.K = 1024; d.N = 1536; d.half = -1; }
    else if (kind == 4) { d.src = p->in[11] + (size_t)l * 1024 * 1024; d.dst = ws.wt_s5in(l); d.K = 1024; d.N = 1024; d.half = 0; }
    else if (kind == 5) { d.src = p->in[21] + (size_t)l * 1024 * 1024; d.dst = ws.wt_s5out(l); d.K = 1024; d.N = 1024; d.half = 0; }
    else { d.src = p->in[25] + (size_t)l * 1024 * 1024; d.dst = ws.wt_o(l); d.K = 1024; d.N = 1024; d.half = 0; }
    return d;
}
DEVI WtD wt_decode(PP p, const WS& ws, int t) {
    if (t < 352) return wt_make(p, ws, 0, 0, t);
    if (t < 528) return wt_make(p, ws, 1, 0, t - 352);
    if (t < 656) return wt_make(p, ws, 2, 0, t - 528);
    if (t < 720) return wt_make(p, ws, 4, 0, t - 656);
    if (t < 784) return wt_make(p, ws, 5, 0, t - 720);
    if (t < 880) return wt_make(p, ws, 3, 0, t - 784);
    if (t < 944) return wt_make(p, ws, 6, 0, t - 880);
    if (t < 1296) return wt_make(p, ws, 0, 1, t - 944);
    if (t < 1472) return wt_make(p, ws, 1, 1, t - 1296);
    if (t < 1568) return wt_make(p, ws, 0, 2, 256 + (t - 1472));
    if (t < 1744) return wt_make(p, ws, 1, 2, t - 1568);
    if (t < 1808) return wt_make(p, ws, 4, 1, t - 1744);
    if (t < 1936) return wt_make(p, ws, 2, 1, t - 1808);
    if (t < 2000) return wt_make(p, ws, 5, 1, t - 1936);
    if (t < 2256) return wt_make(p, ws, 0, 2, t - 2000);
    if (t < 2352) return wt_make(p, ws, 3, 1, t - 2256);
    if (t < 2416) return wt_make(p, ws, 6, 1, t - 2352);
    if (t < 2768) return wt_make(p, ws, 0, 3, t - 2416);
    return wt_make(p, ws, 1, 3, t - 2768);
}
DEVI void wt_load(const WtD& d, int tid, f32x4 (&v)[8]) {
    const int ntn = d.N >> 6, k0 = (d.tile / ntn) * 256, n0 = (d.tile % ntn) * 64, r = tid >> 4, c4 = (tid & 15) * 4;
#pragma unroll
    for (int i = 0; i < 8; ++i) v[i] = *(const f32x4*)(d.src + (size_t)(k0 + r + 32 * i) * d.N + n0 + c4);
}
DEVI void wt_all(PP p, const WS& ws, int t0, int tstep, int tot, unsigned char* lds) {
    float* sc = (float*)lds;
    const int tid = tid_();
    if (t0 >= tot) return;
    WtD cur = wt_decode(p, ws, t0);
    f32x4 v[8];
    wt_load(cur, tid, v);
    for (int t = t0; t < tot; t += tstep) {
        const bool has = t + tstep < tot;
        {
            const int r = tid >> 4, c4 = (tid & 15) * 4;
#pragma unroll
            for (int i = 0; i < 8; ++i) { float* q = sc + (r + 32 * i) * 65 + c4; q[0] = v[i].x; q[1] = v[i].y; q[2] = v[i].z; q[3] = v[i].w; }
        }
        __syncthreads();
        WtD nxt = cur;
        if (has) { nxt = wt_decode(p, ws, t + tstep); wt_load(nxt, tid, v); }
        {
            const int ntn = cur.N >> 6, k0 = (cur.tile / ntn) * 256, n0 = (cur.tile % ntn) * 64;
            const int nn = tid >> 3, kq = tid & 7;
            int n = n0 + nn, rho = n;
            if (cur.half > 0) { const int which = n >= cur.half ? 1 : 0, jj = n - which * cur.half; rho = (jj >> 7) * 256 + which * 128 + (jj & 127); }
            else if (cur.half < 0) { const int d = n & 127, wcp = ((d >> 6) << 1) | ((d >> 4) & 1); rho = (n & ~127) + wcp * 32 + ((d >> 5) & 1) * 16 + (d & 15); }
#pragma unroll
            for (int ii = 0; ii < 4; ++ii) {
                const int k8 = (kq + 8 * ii) * 8;
                const float* q = sc + k8 * 65 + nn;
                u32x4 o; o.x = cvt_pk(q[0], q[65]); o.y = cvt_pk(q[130], q[195]); o.z = cvt_pk(q[260], q[325]); o.w = cvt_pk(q[390], q[455]);
                *(u32x4*)(cur.dst + (size_t)rho * cur.K + k0 + k8) = o;
            }
        }
        __syncthreads();
        cur = nxt;
    }
}

DEVI void prep_b(PP p, const WS& ws) {
    const int gt = bid_() * NTHR + tid_(), gn = gridDim.x * NTHR;
    for (int i = gt; i < NROW * (DM / 8); i += gn) {
        const int row = i >> 7, c8 = (i & 127) * 8;
        const float* x = row < NPR ? p->in[0] + (size_t)row * DM : p->in[1] + (size_t)(row - NPR) * DM;
        const int cond = cond_of_row(row);
        const float* sh = ws.mod(0, cond, 0); const float* sc = ws.mod(0, cond, 1);
        const f32x4 x0 = *(const f32x4*)(x + c8), x1 = *(const f32x4*)(x + c8 + 4);
        const f32x4 s0 = *(const f32x4*)(sc + c8), s1 = *(const f32x4*)(sc + c8 + 4);
        const f32x4 h0 = *(const f32x4*)(sh + c8), h1 = *(const f32x4*)(sh + c8 + 4);
        const f32x4 r0 = x0 * (s0 + 1.f) + h0, r1 = x1 * (s1 + 1.f) + h1;
        u32x4 o; o.x = cvt_pk(r0.x, r0.y); o.y = cvt_pk(r0.z, r0.w); o.z = cvt_pk(r1.x, r1.y); o.w = cvt_pk(r1.z, r1.w);
        *(u32x4*)(ws.H() + (size_t)row * DM + c8) = o;
    }
}

DEVI void prep_a(PP p, const WS& ws, unsigned char* lds) {
    const int bid = bid_(), nb = gridDim.x, tid = tid_();
    if (nb == 256) {
        if (bid < 128) s5_mats_item(p, ws, bid, lds);
        else {
            for (int it = bid - 128; it < 192; it += 128) adaln_item(p, ws, it, lds);
            wt_all(p, ws, bid - 128, 128, WT_L0_END, lds);
        }
    } else {
        for (int it = bid; it < 128; it += nb) s5_mats_item(p, ws, it, lds);
        for (int it = nb - 1 - bid; it < 384; it += nb) adaln_item(p, ws, it, lds);
        wt_all(p, ws, bid, nb, WT_TOT, lds);
    }
    const int gt = bid * NTHR + tid, gn = nb * NTHR;
    for (int i = gt; i < 2 * 4 * 512 * 2 * 32; i += gn) {
        const int d4 = (i & 31) * 4, kvh = (i >> 5) & 1, past = (i >> 6) & 511, j = (i >> 15) & 1, b = i >> 16;
        const f32x4 v = *(const f32x4*)(p->in[3] + ((((size_t)b * 2 + j) * 512 + past) * 2 + kvh) * 128 + d4);
        *(u32x2*)(ws.ks(j) + ((size_t)(b * 2 + kvh) * 1536 + 1024 + past) * 128 + d4) = pack4(v);
    }
    for (int i = gt; i < 2 * 4 * 2 * 64 * 128; i += gn) {
        const int d = i & 127, p8 = (i >> 7) & 63, kvh = (i >> 13) & 1, b = (i >> 14) & 3, j = i >> 16;
        const float* s = p->in[4] + ((((size_t)b * 2 + j) * 512 + p8 * 8) * 2 + kvh) * 128 + d;
        u32x4 o; o.x = cvt_pk(s[0], s[256]); o.y = cvt_pk(s[512], s[768]); o.z = cvt_pk(s[1024], s[1280]); o.w = cvt_pk(s[1536], s[1792]);
        *(u32x4*)(ws.vts(j) + ((size_t)(b * 2 + kvh) * 128 + d) * 1536 + 1024 + p8 * 8) = o;
    }
    for (int i = gt; i < 2048; i += gn) {
        const int pos = i >> 5, fi = i & 31;
        const float inv = exp2f(-(float)fi * (13.287712379549449f / 32.f));
        float sn, cs; sincosf((float)pos * inv, &sn, &cs);
        ws.rope()[2 * i] = cs; ws.rope()[2 * i + 1] = sn;
    }
    if (tid == 0) {
        unsigned* cw = (unsigned*)(ws.b + WS_BAR) + 3713; unsigned sp = 0;
        while (xb_ld(cw) < 32u) { __builtin_amdgcn_s_sleep(2); if (++sp > (1u << 22)) break; }
        __builtin_amdgcn_fence(__ATOMIC_ACQUIRE, "agent");
        WAITV(0);
    }
    __syncthreads();
    prep_b(p, ws);
}

DEVI void ln_phase(PP p, const WS& ws, int layer, int which) {
    const int lane = tid_() & 63, gw = bid_() * 8 + (tid_() >> 6), nw = gridDim.x * 8;
    const float* gam = p->in[9] + (layer * 2 + which) * DM; const float* bet = p->in[10] + (layer * 2 + which) * DM;
    const bool last = (layer == 3 && which == 1);
    const int ml = which == 0 ? layer : layer + 1, ms = which == 0 ? 3 : 0;
    float* Xo = last ? p->out + OUT_Y : ws.X();
    for (int row = gw; row < NROW; row += nw) {
        const float* t = ws.T() + (size_t)row * DM;
        f32x4 v[4]; float s = 0.f;
#pragma unroll
        for (int q = 0; q < 4; ++q) { v[q] = *(const f32x4*)(t + q * 256 + lane * 4); s += (v[q].x + v[q].y) + (v[q].z + v[q].w); }
#pragma unroll
        for (int o = 1; o < 64; o <<= 1) s += __shfl_xor(s, o);
        const float mean = s * (1.f / DM); float s2 = 0.f;
#pragma unroll
        for (int q = 0; q < 4; ++q) { v[q] = v[q] - mean; s2 += (v[q].x * v[q].x + v[q].y * v[q].y) + (v[q].z * v[q].z + v[q].w * v[q].w); }
#pragma unroll
        for (int o = 1; o < 64; o <<= 1) s2 += __shfl_xor(s2, o);
        const float rstd = 1.f / sqrtf(s2 * (1.f / DM) + LN_EPS);
        const int cond = cond_of_row(row);
#pragma unroll
        for (int q = 0; q < 4; ++q) {
            const int c = q * 256 + lane * 4;
            const f32x4 y = v[q] * rstd * *(const f32x4*)(gam + c) + *(const f32x4*)(bet + c);
            *(f32x4*)(Xo + (size_t)row * DM + c) = y;
            if (!last) {
                const f32x4 sh = *(const f32x4*)(ws.mod(ml, cond, ms) + c), sc = *(const f32x4*)(ws.mod(ml, cond, ms + 1) + c);
                *(u32x2*)(ws.H() + (size_t)row * DM + c) = pack4(y * (sc + 1.f) + sh);
            }
        }
    }
}

DEVI void out_ln_gemm_phase(PP p, const WS& ws, const bf16_t* A, int K, const bf16_t* Wt, int layer, int which, const float* xlo, const float* xhi, bool xf32, unsigned char* lds) {
    const int gchunk = which == 0 ? 2 : 5;
    const bool last = (layer == 3 && which == 1);
    const int ml = which == 0 ? layer : layer + 1, ms = which == 0 ? 3 : 0;
    const float* gam = p->in[9] + (layer * 2 + which) * DM; const float* bet = p->in[10] + (layer * 2 + which) * DM;
    float* Xo = p->out + OUT_Y;
    bf16_t* Xb = (bf16_t*)ws.X();
    float* part = ws.part() + (size_t)(layer * 2 + which) * NROW * 32;
    unsigned* cnt = (unsigned*)(ws.b + WS_BAR) + 3456 + (layer * 2 + which) * 32;
    for (int t = bid_(); t < 256; t += gridDim.x) {
        const int tm = t & 31, tn = t >> 5;
        const int cond = tm < 16 ? 0 : 1 + ((tm - 16) >> 2);
        const float* gate = ws.mod(layer, cond, gchunk);
        gemm_tile(A + (size_t)tm * 256 * K, K, Wt + (size_t)tn * 128 * K, K, K, lds,
            [&](f32x4 (&acc)[4][4], int wr, int wc, int fr, int fq) {
                const int colb = tn * 128 + wc * 64 + fq * 4;
                const int tid = (wr * 2 + wc) * 64 + fq * 16 + fr;
                {
                    f32x4 gv[4];
#pragma unroll
                    for (int n = 0; n < 4; ++n) gv[n] = *(const f32x4*)(gate + colb + n * 16);
#pragma unroll
                    for (int i = 0; i < 4; ++i) {
                        const int row = tm * 256 + wr * 64 + i * 16 + fr;
                        const float* xp = row < NPR ? xlo + (size_t)row * DM : xhi + (size_t)(row - NPR) * DM;
                        const bf16_t* xq = Xb + (size_t)row * DM;
                        float s1 = 0.f, s2 = 0.f;
#pragma unroll
                        for (int n = 0; n < 4; ++n) {
                            f32x4 xv;
                            if (xf32) xv = *(const f32x4*)(xp + colb + n * 16);
                            else { const u32x2 u = *(const u32x2*)(xq + colb + n * 16); xv.x = __uint_as_float(u.x << 16); xv.y = __uint_as_float(u.x & 0xffff0000u); xv.z = __uint_as_float(u.y << 16); xv.w = __uint_as_float(u.y & 0xffff0000u); }
                            const f32x4 tv = xv * ALPHA + gv[n] * acc[i][n];
                            acc[i][n] = tv;
                            s1 += (tv.x + tv.y) + (tv.z + tv.w);
                            s2 += (tv.x * tv.x + tv.y * tv.y) + (tv.z * tv.z + tv.w * tv.w);
                        }
                        s1 += __shfl_xor(s1, 16); s1 += __shfl_xor(s1, 32);
                        s2 += __shfl_xor(s2, 16); s2 += __shfl_xor(s2, 32);
                        if (fq == 0) { float* rp = (float*)(lds + LDS_RED) + (wc * 256 + wr * 64 + i * 16 + fr) * 2; rp[0] = s1; rp[1] = s2; }
                    }
                }
                __syncthreads();
                if (tid < 256) {
                    const float* rp = (const float*)(lds + LDS_RED);
                    const float v1 = rp[tid * 2] + rp[(256 + tid) * 2], v2 = rp[tid * 2 + 1] + rp[(256 + tid) * 2 + 1];
                    __hip_atomic_store((unsigned long long*)(part + ((size_t)(tm * 8 + tn) * 256 + tid) * 2), (unsigned long long)__float_as_uint(v1) | ((unsigned long long)__float_as_uint(v2) << 32), __ATOMIC_RELAXED, __HIP_MEMORY_SCOPE_AGENT);
                }
                WAITV(0);
                __syncthreads();
                if (tid == 0) {
                    xb_add(&cnt[tm], 1u);
                    unsigned sp = 0;
                    while (xb_ld(&cnt[tm]) < 8u) { __builtin_amdgcn_s_sleep(1); if (++sp > (1u << 24)) break; }
                    __builtin_amdgcn_fence(__ATOMIC_ACQUIRE, "agent");
                    WAITV(0);
                }
                __syncthreads();
                float* stats = (float*)(lds + LDS_RED);
                if (tid < 256) {
                    const float* pp = part + ((size_t)(tm * 8) * 256 + tid) * 2;
                    float s1 = 0.f, s2 = 0.f;
                    f32x2 pv[8];
#pragma unroll
                    for (int q = 0; q < 8; ++q) pv[q] = *(const f32x2*)(pp + q * 512);
#pragma unroll
                    for (int q = 0; q < 8; ++q) { s1 += pv[q].x; s2 += pv[q].y; }
                    const float mean = s1 * (1.f / DM);
                    const float var = fmaxf(s2 * (1.f / DM) - mean * mean, 0.f);
                    stats[2 * tid] = mean; stats[2 * tid + 1] = 1.f / sqrtf(var + LN_EPS);
                }
                __syncthreads();
                const float* shp = ws.mod(ml & 3, cond, ms); const float* scp = ws.mod(ml & 3, cond, ms + 1);
#pragma unroll
                for (int n = 0; n < 4; ++n) {
                    const int c = colb + n * 16;
                    const f32x4 g4 = *(const f32x4*)(gam + c), b4 = *(const f32x4*)(bet + c);
                    f32x4 sh4 = (f32x4){0.f, 0.f, 0.f, 0.f}, sc4 = sh4;
                    if (!last) { sh4 = *(const f32x4*)(shp + c); sc4 = *(const f32x4*)(scp + c); }
#pragma unroll
                    for (int i = 0; i < 4; ++i) {
                        const int rl = wr * 64 + i * 16 + fr, row = tm * 256 + rl;
                        const float mean = stats[2 * rl], rstd = stats[2 * rl + 1];
                        const f32x4 y = (acc[i][n] - mean) * rstd * g4 + b4;
                        if (last) __builtin_nontemporal_store(y, (f32x4*)(Xo + (size_t)row * DM + c));
                        else { *(u32x2*)(Xb + (size_t)row * DM + c) = pack4(y); *(u32x2*)(ws.H() + (size_t)row * DM + c) = pack4(y * (sc4 + 1.f) + sh4); }
                    }
                }
            }, (tm * 5 + tn) % (K >> 6));
    }
}

DEVI void ffn_in_phase(PP p, const WS& ws, int layer, unsigned char* lds) {
    const bf16_t* A = ws.H(); const bf16_t* Wt = ws.wt_ffnin(layer); bf16_t* ACT = ws.act();
    for (int t = bid_(); t < 32 * 22; t += gridDim.x) {
        const int tm = t & 31, tn = t >> 5;
        gemm_tile8p(A + (size_t)tm * 256 * DM, Wt + (size_t)tn * 256 * DM, DM, lds,
            [&](f32x4 (&acc)[2][2][4][2], int wr, int wc, int fr, int fq) {
#pragma unroll
                for (int ai = 0; ai < 2; ++ai)
#pragma unroll
                    for (int m = 0; m < 4; ++m) {
                        const int row = tm * 256 + ai * 128 + wr * 64 + m * 16 + fr;
#pragma unroll
                        for (int n = 0; n < 2; ++n) {
                            const f32x4 g = acc[ai][0][m][n], u = acc[ai][1][m][n];
                            f32x4 r; r.x = siluf_(g.x) * u.x; r.y = siluf_(g.y) * u.y; r.z = siluf_(g.z) * u.z; r.w = siluf_(g.w) * u.w;
                            *(u32x2*)(ACT + (size_t)row * DFF + tn * 128 + wc * 32 + n * 16 + fq * 4) = pack4(r);
                        }
                    }
            });
    }
    if (gridDim.x == 256 && bid_() >= 192 && layer < 3) {
        const int lo = layer == 0 ? WT_L0_END : layer == 1 ? WT_B_END : WT_C_END, hi = layer == 0 ? WT_A_END : layer == 1 ? WT_C_END : WT_D_END;
        wt_all(p, ws, lo + (bid_() - 192), 64, hi, lds);
    }
}

DEVI void glu_phase(const WS& ws, int j, unsigned char* lds) {
    const bf16_t* A = ws.bufa(); const bf16_t* Wt = ws.wt_glu(j); bf16_t* O = ws.bufb();
    for (int t = bid_(); t < 32 * 8; t += gridDim.x) {
        const int tm = t & 31, tn = t >> 5;
        gemm_tile8p(A + (size_t)tm * 256 * DM, Wt + (size_t)tn * 256 * DM, DM, lds,
            [&](f32x4 (&acc)[2][2][4][2], int wr, int wc, int fr, int fq) {
#pragma unroll
                for (int ai = 0; ai < 2; ++ai)
#pragma unroll
                    for (int m = 0; m < 4; ++m) {
                        const int row = tm * 256 + ai * 128 + wr * 64 + m * 16 + fr;
#pragma unroll
                        for (int n = 0; n < 2; ++n) {
                            const f32x4 v = acc[ai][0][m][n], g = acc[ai][1][m][n];
                            f32x4 r; r.x = v.x * sigmoidf_(g.x); r.y = v.y * sigmoidf_(g.y); r.z = v.z * sigmoidf_(g.z); r.w = v.w * sigmoidf_(g.w);
                            *(u32x2*)(O + (size_t)row * DM + tn * 128 + wc * 32 + n * 16 + fq * 4) = pack4(r);
                        }
                    }
            });
    }
}

DEVI void s5_in_phase(const WS& ws, int j, unsigned char* lds) {
    const bf16_t* A = ws.H(); const bf16_t* Wt = ws.wt_s5in(j); bf16_t* Uc = ws.act();
    for (int t = bid_(); t < 256; t += gridDim.x) {
        const int tm = t & 31, tn = t >> 5;
        gemm_tile(A + (size_t)tm * 256 * DM, DM, Wt + (size_t)tn * 128 * DM, DM, DM, lds,
            [&](f32x4 (&acc)[4][4], int wr, int wc, int fr, int fq) {
#pragma unroll
                for (int i = 0; i < 4; ++i) {
                    const int chunk = tm * 16 + wr * 4 + i;
#pragma unroll
                    for (int n = 0; n < 4; ++n) {
                        const int g = tn * 8 + wc * 4 + n;
                        *(u32x2*)(Uc + ((size_t)chunk * 64 + g) * 256 + fr * 16 + fq * 4) = pack4(acc[i][n]);
                    }
                }
            }, (tm * 5 + tn) & 15);
    }
}

DEVI void s5_chunk_phase(PP p, const WS& ws, int j, unsigned char* lds) {
    const bf16_t* Uc = ws.act(); bf16_t* Yi = (bf16_t*)ws.T(); bf16_t* Ss = ws.bufb();
    for (int it0 = bid_(); it0 < 512; it0 += gridDim.x) {
        const int it = it0 < 256 ? it0 : (it0 ^ 2);
        const int g = it >> 3, ct = (it >> 2) & 1, mt = it & 3;
        gemm_tile(Uc + ((size_t)ct * 256 * 64 + g) * 256, 16384, ws.mg(j, g) + (size_t)mt * 128 * 256, 256, 256, lds,
            [&](f32x4 (&acc)[4][4], int wr, int wc, int fr, int fq) {
                if (mt < 2) {
#pragma unroll
                    for (int i = 0; i < 4; ++i) {
                        const int chunk = ct * 256 + wr * 64 + i * 16 + fr;
#pragma unroll
                        for (int n = 0; n < 4; ++n) { const int tt = mt * 8 + wc * 4 + n; *(u32x2*)(Yi + (size_t)(chunk * 16 + tt) * DM + g * 16 + fq * 4) = pack4(acc[i][n]); }
                    }
                } else {
                    const int dir = mt - 2, tid = (wr * 2 + wc) * 64 + fq * 16 + fr;
                    float* sl = (float*)lds;
                    __syncthreads();
#pragma unroll
                    for (int i = 0; i < 4; ++i)
#pragma unroll
                        for (int n = 0; n < 4; ++n) *(f32x4*)(sl + (wr * 64 + i * 16 + fr) * 128 + wc * 64 + n * 16 + fq * 4) = acc[i][n];
                    __syncthreads();
                    const int nchain = ct == 0 ? 1024 : 256, n = ct == 0 ? 16 : 64;
                    for (int c = tid; c < nchain; c += NTHR) {
                        const int b = c >> 6, pp = c & 63, base = b * n;
                        const float* l16 = ws.lam16() + ((size_t)((j * 2 + dir) * 64 + g) * 64 + pp) * 2;
                        const float lr = l16[0], li = l16[1];
                        float sr = 0.f, si = 0.f;
                        const size_t so = ((((size_t)(b * 2 + j) * 2 + dir) * 2 + 0) * 64 + g) * 64 + pp;
                        if (ct == 1) { sr = p->in[5][so]; si = p->in[5][so + 4096]; }
                        for (int q = 0; q < n; ++q) {
                            const int lc = dir == 0 ? base + q : base + n - 1 - q;
                            const size_t o = ((size_t)(ct * 256 + lc) * 64 + g) * 256 + dir * 128 + pp;
                            Ss[o] = (bf16_t)(cvt_pk(sr, sr) & 0xffffu); Ss[o + 64] = (bf16_t)(cvt_pk(si, si) & 0xffffu);
                            const float ar = sl[lc * 128 + pp], ai = sl[lc * 128 + 64 + pp];
                            const float nr = lr * sr - li * si + ar; si = lr * si + li * sr + ai; sr = nr;
                        }
                        if (ct == 0) { p->out[OUT_S + so] = sr; p->out[OUT_S + so + 4096] = si; }
                    }
                }
            });
    }
}

DEVI void s5_y_phase(const WS& ws, int j, unsigned char* lds) {
    const bf16_t* Ss = ws.bufb(); const bf16_t* Yi = (const bf16_t*)ws.T(); bf16_t* Z = ws.bufa();
    for (int it = bid_(); it < 256; it += gridDim.x) {
        const int g = it >> 2, ct = (it >> 1) & 1, mt = it & 1;
        gemm_tile(Ss + ((size_t)ct * 256 * 64 + g) * 256, 16384, ws.vg(j, g) + (size_t)mt * 128 * 256, 256, 256, lds,
            [&](f32x4 (&acc)[4][4], int wr, int wc, int fr, int fq) {
#pragma unroll
                for (int i = 0; i < 4; ++i) {
                    const int chunk = ct * 256 + wr * 64 + i * 16 + fr;
#pragma unroll
                    for (int n = 0; n < 4; ++n) {
                        const int tt = mt * 8 + wc * 4 + n;
                        const size_t o = (size_t)(chunk * 16 + tt) * DM + g * 16 + fq * 4;
                        const u32x2 yu = *(const u32x2*)(Yi + o);
                        f32x4 y = acc[i][n]; y.x += __uint_as_float(yu.x << 16); y.y += __uint_as_float(yu.x & 0xffff0000u); y.z += __uint_as_float(yu.y << 16); y.w += __uint_as_float(yu.y & 0xffff0000u);
                        f32x4 z; z.x = gelu_tanh(y.x); z.y = gelu_tanh(y.y); z.z = gelu_tanh(y.z); z.w = gelu_tanh(y.w);
                        *(u32x2*)(Z + o) = pack4(z);
                    }
                }
            });
    }
}

DEVI void qkv_phase(PP p, const WS& ws, int j, unsigned char* lds) {
    const bf16_t* A = ws.H(); const bf16_t* Wt = ws.wt_qkv(j);
    for (int t = bid_(); t < 32 * 6; t += gridDim.x) {
        const int tm = t & 31, tn = t >> 5;
        if (tn == 5) {
            gemm_tile8p<false>(A + (size_t)tm * 256 * DM, Wt + (size_t)tn * 256 * DM, DM, lds,
                [&](f32x4 (&acc)[2][2][4][2], int wr, int wc, int fr, int fq) {
                    const bool sample = tm >= 16;
                    const int b = sample ? (tm - 16) >> 2 : tm;
                    const int lq = sample ? ((tm - 16) & 3) * 256 : 0, skv = sample ? 1536 : 256;
#pragma unroll
                    for (int bj = 0; bj < 2; ++bj) {
                        bf16_t* vt = (sample ? ws.vts(j) : ws.vtp()) + (size_t)(b * 2 + bj) * 128 * skv;
#pragma unroll
                        for (int n = 0; n < 2; ++n) {
                            const int d = (wc >> 1) * 64 + n * 32 + (wc & 1) * 16 + fr;
#pragma unroll
                            for (int ai = 0; ai < 2; ++ai)
#pragma unroll
                                for (int m = 0; m < 4; ++m) {
                                    const int l = lq + ai * 128 + wr * 64 + m * 16 + fq * 4;
                                    *(u32x2*)(vt + (size_t)d * skv + l) = pack4(acc[ai][bj][m][n]);
                                    if (!sample) { float* o = p->out + OUT_V + ((((size_t)b * 2 + j) * 256 + l) * 2 + bj) * 128 + d; o[0] = acc[ai][bj][m][n].x; o[256] = acc[ai][bj][m][n].y; o[512] = acc[ai][bj][m][n].z; o[768] = acc[ai][bj][m][n].w; }
                                }
                        }
                    }
                });
            continue;
        }
        gemm_tile8p(A + (size_t)tm * 256 * DM, Wt + (size_t)tn * 256 * DM, DM, lds,
            [&](f32x4 (&acc)[2][2][4][2], int wr, int wc, int fr, int fq) {
                const bool sample = tm >= 16;
                const int b = sample ? (tm - 16) >> 2 : tm;
                const int lq = sample ? ((tm - 16) & 3) * 256 : 0;
                const int d0 = (wc >> 1) * 64 + (wc & 1) * 16 + fq * 4;
                {
                    float* red = (float*)(lds + 131072);
#pragma unroll
                    for (int ai = 0; ai < 2; ++ai)
#pragma unroll
                        for (int bj = 0; bj < 2; ++bj)
#pragma unroll
                            for (int m = 0; m < 4; ++m) {
                                const f32x4 u = acc[ai][bj][m][0], v = acc[ai][bj][m][1];
                                float ssq = (u.x * u.x + u.y * u.y) + (u.z * u.z + u.w * u.w) + (v.x * v.x + v.y * v.y) + (v.z * v.z + v.w * v.w);
                                ssq += __shfl_xor(ssq, 16); ssq += __shfl_xor(ssq, 32);
                                if (fq == 0) red[((((ai * 2 + bj) * 2 + wr) * 4 + m) * 16 + fr) * 4 + wc] = ssq;
                            }
                    __syncthreads();
                    const float* gain = (tn < 4 ? p->in[23] : p->in[24]) + j * 128;
                    const f32x4 g0 = *(const f32x4*)(gain + d0), g1 = *(const f32x4*)(gain + d0 + 32);
                    const float* rope = ws.rope();
#pragma unroll
                    for (int ai = 0; ai < 2; ++ai)
#pragma unroll
                        for (int m = 0; m < 4; ++m) {
                            const int rl = ai * 128 + wr * 64 + m * 16 + fr, row = tm * 256 + rl, l = lq + rl;
                            f32x4 r0 = (f32x4){1.f, 0.f, 1.f, 0.f}, r1 = r0;
                            if (sample) { const int pos = (wc >> 1) == 0 ? (l >> 6) : (l & 63); const float* rp = rope + (pos * 32 + (wc & 1) * 16 + fq * 4) * 2; r0 = *(const f32x4*)rp; r1 = *(const f32x4*)(rp + 4); }
#pragma unroll
                            for (int bj = 0; bj < 2; ++bj) {
                                const f32x4 q4 = *(const f32x4*)(red + ((((ai * 2 + bj) * 2 + wr) * 4 + m) * 16 + fr) * 4);
                                const float rstd = 1.f / sqrtf(((q4.x + q4.y) + (q4.z + q4.w)) * (1.f / 128.f) + RMS_EPS);
                                const f32x4 x1 = acc[ai][bj][m][0] * rstd * g0, x2 = acc[ai][bj][m][1] * rstd * g1;
                                f32x4 y1, y2;
                                y1.x = x1.x * r0.x - x2.x * r0.y; y2.x = x2.x * r0.x + x1.x * r0.y;
                                y1.y = x1.y * r0.z - x2.y * r0.w; y2.y = x2.y * r0.z + x1.y * r0.w;
                                y1.z = x1.z * r1.x - x2.z * r1.y; y2.z = x2.z * r1.x + x1.z * r1.y;
                                y1.w = x1.w * r1.z - x2.w * r1.w; y2.w = x2.w * r1.z + x1.w * r1.w;
                                if (tn < 4) {
                                    bf16_t* qp = ws.bufa() + (size_t)row * DM + (tn * 2 + bj) * 128 + d0;
                                    *(u32x2*)qp = pack4(y1); *(u32x2*)(qp + 32) = pack4(y2);
                                } else {
                                    const int kvh = bj;
                                    bf16_t* kp = sample ? ws.ks(j) + ((size_t)(b * 2 + kvh) * 1536 + l) * 128 + d0 : ws.kp() + ((size_t)(b * 2 + kvh) * 256 + l) * 128 + d0;
                                    *(u32x2*)kp = pack4(y1); *(u32x2*)(kp + 32) = pack4(y2);
                                    if (!sample) { float* o = p->out + OUT_K + ((((size_t)b * 2 + j) * 256 + l) * 2 + kvh) * 128 + d0; __builtin_nontemporal_store(y1, (f32x4*)o); __builtin_nontemporal_store(y2, (f32x4*)(o + 32)); }
                                }
                            }
                        }
                }
            });
    }    if (gridDim.x == 256 && bid_() >= 192) {
        const int lo = j == 0 ? WT_A_END : WT_D_END, hi = j == 0 ? WT_B_END : WT_TOT, ib = bid_() - 192;
        if (j == 0) {
            for (int q = ib; q < 128; q += 64) adaln_item(p, ws, 192 + q, lds);
        } else {
            adaln_item(p, ws, 320 + ib, lds);
        }
        wt_all(p, ws, lo + ib, 64, hi, lds);
    }
}

constexpr int AT_KROW = 288, AT_VROW = 288, AT_KB = 64 * AT_KROW, AT_VB = 128 * AT_VROW, AT_STAGE = AT_KB + AT_VB;
DEVI void attn_phase(const WS& ws, int j, unsigned char* lds) {
    const int tid = tid_(), lane = tid & 63, w = tid >> 6, fr = lane & 15, fq = lane >> 4;
    const bf16_t* Q = ws.bufa(); bf16_t* AO = ws.bufb();
    for (int it = bid_(); it < 512; it += gridDim.x) {
        int b, h, qb, skv, row0; const bf16_t *Kb, *Vb;
        if (it < 256) { b = it >> 6; h = (it >> 3) & 7; qb = it & 7; skv = 1536; row0 = NPR + b * 1024 + qb * 128;
            Kb = ws.ks(j) + (size_t)(b * 2 + (h >> 2)) * 1536 * 128; Vb = ws.vts(j) + (size_t)(b * 2 + (h >> 2)) * 128 * 1536; }
        else { const int i2 = it - 256; b = i2 >> 4; h = (i2 >> 1) & 7; qb = i2 & 1; skv = 256; row0 = b * 256 + qb * 128;
            Kb = ws.kp() + (size_t)(b * 2 + (h >> 2)) * 256 * 128; Vb = ws.vtp() + (size_t)(b * 2 + (h >> 2)) * 128 * 256; }
        const int qrow = row0 + w * 16 + fr;
        bf16x8 qf[4];
#pragma unroll
        for (int s = 0; s < 4; ++s) qf[s] = *(const bf16x8*)(Q + (size_t)qrow * DM + h * 128 + s * 32 + fq * 8);
        f32x4 o[8];
#pragma unroll
        for (int m = 0; m < 8; ++m) o[m] = (f32x4){0.f, 0.f, 0.f, 0.f};
        float mrun = -1e30f, lrun = 0.f;
        const int kr0 = tid >> 4, kc = tid & 15;
        const int vr0 = tid >> 3, vc = tid & 7;
        const int vs = vc >> 2, vu = vc & 3;
        const int vslot_lo = vs * 32 + (2 * (vu & 1)) * 8 + (vu >> 1) * 4, vslot_hi = vslot_lo + 8;
        const bf16_t* gk = Kb + (size_t)kr0 * 128 + kc * 8;
        const bf16_t* gv = Vb + (size_t)vr0 * skv + vc * 8;
        u32x4 rk[2], rv[2];
        const int nt = skv >> 6;
        rk[0] = *(const u32x4*)(gk); rk[1] = *(const u32x4*)(gk + 32 * 128);
        rv[0] = *(const u32x4*)(gv); rv[1] = *(const u32x4*)(gv + (size_t)64 * skv);
        {
            unsigned char* sk = lds; unsigned char* sv = lds + AT_KB;
            *(u32x4*)(sk + kr0 * AT_KROW + kc * 16) = rk[0]; *(u32x4*)(sk + (kr0 + 32) * AT_KROW + kc * 16) = rk[1];
#pragma unroll
            for (int q = 0; q < 2; ++q) {
                unsigned char* r = sv + (vr0 + 64 * q) * AT_VROW;
                u32x2 lo; lo.x = rv[q].x; lo.y = rv[q].y; u32x2 hi; hi.x = rv[q].z; hi.y = rv[q].w;
                *(u32x2*)(r + vslot_lo * 2) = lo; *(u32x2*)(r + vslot_hi * 2) = hi;
            }
        }
        __syncthreads();
        for (int kt = 0; kt < nt; ++kt) {
            const bool more = kt + 1 < nt;
            if (more) {
                const int k0 = (kt + 1) * 64;
                rk[0] = *(const u32x4*)(gk + (size_t)k0 * 128); rk[1] = *(const u32x4*)(gk + (size_t)(k0 + 32) * 128);
                rv[0] = *(const u32x4*)(gv + k0); rv[1] = *(const u32x4*)(gv + (size_t)64 * skv + k0);
            }
            const unsigned char* sk = lds + (kt & 1) * AT_STAGE; const unsigned char* sv = sk + AT_KB;
            f32x4 sc[4];
#pragma unroll
            for (int t = 0; t < 4; ++t) {
                sc[t] = (f32x4){0.f, 0.f, 0.f, 0.f};
#pragma unroll
                for (int s = 0; s < 4; ++s) {
                    const bf16x8 kf = *(const bf16x8*)(sk + (t * 16 + fr) * AT_KROW + s * 64 + fq * 16);
                    sc[t] = __builtin_amdgcn_mfma_f32_16x16x32_bf16(kf, qf[s], sc[t], 0, 0, 0);
                }
            }
            bf16x8 vfr[8][2];
#pragma unroll
            for (int m = 0; m < 8; ++m)
#pragma unroll
                for (int s = 0; s < 2; ++s) vfr[m][s] = *(const bf16x8*)(sv + (m * 16 + fr) * AT_VROW + s * 64 + fq * 16);
            float mx = sc[0].x;
#pragma unroll
            for (int t = 0; t < 4; ++t) mx = fmaxf(fmaxf(fmaxf(mx, sc[t].x), fmaxf(sc[t].y, sc[t].z)), sc[t].w);
            mx = fmaxf(mx, __shfl_xor(mx, 16)); mx = fmaxf(mx, __shfl_xor(mx, 32));
            const float mnew = fmaxf(mrun, mx);
            const float alpha = __builtin_amdgcn_exp2f((mrun - mnew) * SM_C);
            mrun = mnew;
            const float mb = -mnew * SM_C;
            float ls = 0.f;
#pragma unroll
            for (int t = 0; t < 4; ++t) {
                sc[t].x = __builtin_amdgcn_exp2f(sc[t].x * SM_C + mb); sc[t].y = __builtin_amdgcn_exp2f(sc[t].y * SM_C + mb);
                sc[t].z = __builtin_amdgcn_exp2f(sc[t].z * SM_C + mb); sc[t].w = __builtin_amdgcn_exp2f(sc[t].w * SM_C + mb);
                ls += (sc[t].x + sc[t].y) + (sc[t].z + sc[t].w);
            }
            lrun = lrun * alpha + ls;
#pragma unroll
            for (int m = 0; m < 8; ++m) o[m] = o[m] * alpha;
            bf16x8 pf[2];
#pragma unroll
            for (int s = 0; s < 2; ++s) {
                u32x4 u; u.x = cvt_pk(sc[2 * s].x, sc[2 * s].y); u.y = cvt_pk(sc[2 * s].z, sc[2 * s].w);
                u.z = cvt_pk(sc[2 * s + 1].x, sc[2 * s + 1].y); u.w = cvt_pk(sc[2 * s + 1].z, sc[2 * s + 1].w);
                pf[s] = __builtin_bit_cast(bf16x8, u);
            }
#pragma unroll
            for (int m = 0; m < 8; ++m)
#pragma unroll
                for (int s = 0; s < 2; ++s) o[m] = __builtin_amdgcn_mfma_f32_16x16x32_bf16(vfr[m][s], pf[s], o[m], 0, 0, 0);
            if (more) {
                unsigned char* wk = lds + ((kt + 1) & 1) * AT_STAGE; unsigned char* wv = wk + AT_KB;
                *(u32x4*)(wk + kr0 * AT_KROW + kc * 16) = rk[0]; *(u32x4*)(wk + (kr0 + 32) * AT_KROW + kc * 16) = rk[1];
#pragma unroll
                for (int q = 0; q < 2; ++q) {
                    unsigned char* r = wv + (vr0 + 64 * q) * AT_VROW;
                    u32x2 lo; lo.x = rv[q].x; lo.y = rv[q].y; u32x2 hi; hi.x = rv[q].z; hi.y = rv[q].w;
                    *(u32x2*)(r + vslot_lo * 2) = lo; *(u32x2*)(r + vslot_hi * 2) = hi;
                }
            }
            __syncthreads();
        }
        float l = lrun; l += __shfl_xor(l, 16); l += __shfl_xor(l, 32);
        const float inv = 1.f / l;
#pragma unroll
        for (int m = 0; m < 8; ++m) *(u32x2*)(AO + (size_t)qrow * DM + h * 128 + m * 16 + fq * 4) = pack4(o[m] * inv);
    }
}

constexpr int N_PHASES = 1 + 7 + 5 + 7 + 5;
#ifndef REP_FFNIN
#define REP_FFNIN 1
#endif
#ifndef REP_ATTN
#define REP_ATTN 1
#endif
#ifndef REP_PREP
#define REP_PREP 1
#endif
#ifndef DBG_N
#define DBG_N 1000
#endif
DEVI void run_phase(PP p, const WS& ws, int ph, unsigned char* lds) {
    if (ph == 0) { for (int rep = 0; rep < REP_PREP; ++rep) prep_a(p, ws, lds); return; }
    int r = ph - 1, layer = 0;
    if (r >= 7) { r -= 7; layer = 1; if (r >= 5) { r -= 5; layer = 2; if (r >= 7) { r -= 7; layer = 3; } } }
    const int j = layer >> 1;
    const bool s5 = (layer & 1) == 0;
    const float* xlo = layer == 0 ? p->in[0] : ws.X();
    const float* xhi = layer == 0 ? p->in[1] : ws.X() + (size_t)NPR * DM;
    int k = r;
    if (s5) {
        if (r == 0) { s5_in_phase(ws, j, lds); return; }
        if (r == 1) { s5_chunk_phase(p, ws, j, lds); return; }
        if (r == 2) { s5_y_phase(ws, j, lds); return; }
        if (r == 3) { glu_phase(ws, j, lds); return; }
        k = r - 4;
        if (k == 0) { out_ln_gemm_phase(p, ws, ws.bufb(), DM, ws.wt_s5out(j), layer, 0, xlo, xhi, layer == 0, lds); return; }
    } else {
        if (r == 0) { qkv_phase(p, ws, j, lds); return; }
        if (r == 1) { for (int rep = 0; rep < REP_ATTN; ++rep) attn_phase(ws, j, lds); return; }
        k = r - 2;
        if (k == 0) { out_ln_gemm_phase(p, ws, ws.bufb(), DM, ws.wt_o(j), layer, 0, xlo, xhi, layer == 0, lds); return; }
    }
    if (k == 1) { for (int rep = 0; rep < REP_FFNIN; ++rep) ffn_in_phase(p, ws, layer, lds); return; }
    out_ln_gemm_phase(p, ws, ws.act(), DFF, ws.wt_ffnout(layer), layer, 1, xlo, xhi, false, lds);
}

__global__ void __launch_bounds__(NTHR) mega(Params p_) {
    extern __shared__ __attribute__((aligned(16))) unsigned char lds[];
    volatile LAS unsigned* xbw = (volatile LAS unsigned*)(LAS unsigned char*)(lds + LDS_XB);
    if (threadIdx.x < 4) xbw[threadIdx.x] = 0u;
    __syncthreads();
    const int ph_lo = p_.ph_lo, ph_hi = p_.ph_hi;
    XcdBarrier xb = xcd_barrier_post((unsigned*)(p_.ws + WS_BAR), xbw);
    for (int ph = ph_lo; ph < ph_hi; ++ph) {
        {
            PP p = (PP)__builtin_amdgcn_kernarg_segment_ptr();
            asm volatile("" : "+s"(p));
            WS ws; ws.b = p->ws;
            run_phase(p, ws, ph, lds);
#ifdef DBG_TWICE
            if (ph == 2) { xcd_barrier(xb); run_phase(p, ws, ph, lds); }
#endif
        }
        if (ph + 1 < ph_hi) {
#if USE_CG
            cg::this_grid().sync();
#else
            if (ph_hi < 0) cg::this_grid().sync();
            xcd_barrier(xb);
#endif
        }
    }
}

extern "C" void kernel_launch(void* const* d_in, const int* in_sizes, int n_in, void* d_out, int out_size, void* d_ws, size_t ws_size, hipStream_t stream) {
    static int grid = 0;
    if (grid == 0) {
        if (n_in != 28 || ws_size < WS_END) { fprintf(stderr, "kernel_launch: unexpected n_in %d or ws_size %zu (< %zu)\n", n_in, ws_size, (size_t)WS_END); grid = -1; return; }
        int dev = 0, cus = 0, per_cu = 0;
        (void)hipGetDevice(&dev);
        (void)hipDeviceGetAttribute(&cus, hipDeviceAttributeMultiprocessorCount, dev);
        (void)hipFuncSetAttribute((const void*)mega, hipFuncAttributeMaxDynamicSharedMemorySize, LDS_BYTES);
        (void)hipOccupancyMaxActiveBlocksPerMultiprocessor(&per_cu, (const void*)mega, NTHR, LDS_BYTES);
        (void)hipGetLastError();
        if (per_cu < 1) per_cu = 1;
        grid = cus * 1;
    }
    if (grid < 0) return;
    (void)hipMemsetAsync((unsigned char*)d_ws + WS_BAR, 0, 16384, stream);
    Params p{};
    for (int i = 0; i < 28; ++i) p.in[i] = (const float*)d_in[i];
    p.out = (float*)d_out; p.ws = (unsigned char*)d_ws; p.ph_lo = 0; p.ph_hi = N_PHASES;
    void* args[] = {&p};
    hipError_t e = hipLaunchCooperativeKernel((const void*)mega, dim3(grid), dim3(NTHR), args, LDS_BYTES, stream);
    if (e != hipSuccess) fprintf(stderr, "cooperative launch failed: %s (grid %d)\n", hipGetErrorString(e), grid);
}
```

```cpp
#include <hip/hip_runtime.h>
#include <hip/hip_cooperative_groups.h>
#include <cstdio>
#include <cstdint>
namespace cg = cooperative_groups;

#define DEVI __device__ __forceinline__
#define LAS __attribute__((address_space(3)))
typedef unsigned short bf16_t;
typedef short bf16x8 __attribute__((ext_vector_type(8)));
typedef float f32x4 __attribute__((ext_vector_type(4)));
typedef float f32x2 __attribute__((ext_vector_type(2)));
typedef unsigned u32x4 __attribute__((ext_vector_type(4)));
typedef unsigned u32x2 __attribute__((ext_vector_type(2)));

constexpr int DM = 1024, NROW = 8192, NPR = 4096, DFF = 2816;
constexpr float ALPHA = 1.681792830507429f;
constexpr float LN_EPS = 1e-6f, RMS_EPS = 1e-6f;
constexpr float SM_C = 0.08838834764831845f * 1.4426950408889634f;

constexpr size_t OUT_Y = 0, OUT_K = 8388608, OUT_V = 10485760, OUT_S = 12582912;

constexpr size_t al256(size_t x) { return (x + 255) & ~(size_t)255; }
constexpr size_t WS_BAR = 0;
constexpr size_t WS_WT_S5IN = 16384;
constexpr size_t WS_WT_GLU = WS_WT_S5IN + 2ull * 1024 * 1024 * 2;
constexpr size_t WS_WT_S5OUT = WS_WT_GLU + 2ull * 2048 * 1024 * 2;
constexpr size_t WS_WT_QKV = WS_WT_S5OUT + 2ull * 1024 * 1024 * 2;
constexpr size_t WS_WT_O = WS_WT_QKV + 2ull * 1536 * 1024 * 2;
constexpr size_t WS_WT_FFNIN = WS_WT_O + 2ull * 1024 * 1024 * 2;
constexpr size_t WS_WT_FFNOUT = WS_WT_FFNIN + 4ull * 5632 * 1024 * 2;
constexpr size_t WS_MG = WS_WT_FFNOUT + 4ull * 1024 * 2816 * 2;
constexpr size_t WS_VG = WS_MG + 2ull * 64 * 512 * 256 * 2;
constexpr size_t WS_LAM16 = WS_VG + 2ull * 64 * 256 * 256 * 2;
constexpr size_t WS_MOD = WS_LAM16 + 2ull * 2 * 64 * 64 * 2 * 4;
constexpr size_t WS_ROPE = WS_MOD + al256(4ull * 5 * 6144 * 4);
constexpr size_t WS_KS = WS_ROPE + 64ull * 32 * 2 * 4;
constexpr size_t KS_LAYER = 4ull * 2 * 1536 * 128 * 2;
constexpr size_t WS_VTS = WS_KS + 2 * KS_LAYER;
constexpr size_t WS_KP = WS_VTS + 2 * KS_LAYER;
constexpr size_t WS_VTP = WS_KP + 16ull * 2 * 256 * 128 * 2;
constexpr size_t WS_X = WS_VTP + 16ull * 2 * 256 * 128 * 2;
constexpr size_t WS_T = WS_X + (size_t)NROW * DM * 4;
constexpr size_t WS_H = WS_T + (size_t)NROW * DM * 4;
constexpr size_t WS_BUFA = WS_H + (size_t)NROW * DM * 2;
constexpr size_t WS_BUFB = WS_BUFA + (size_t)NROW * DM * 2;
constexpr size_t WS_ACT = WS_BUFB + (size_t)NROW * DM * 2;
constexpr size_t WS_SL = WS_ACT + (size_t)NROW * DFF * 2;
constexpr size_t WS_PART = WS_SL + (size_t)NROW * DM * 4;
constexpr size_t WS_END = WS_PART + 8 * (size_t)NROW * 16 * 2 * 4;

constexpr int NTHR = 512;
constexpr int LROW = 144;
constexpr int A_TILE_B = 256 * LROW, B_TILE_B = 128 * LROW, STAGE_B = A_TILE_B + B_TILE_B;
constexpr int LDS_RED = 3 * (256 * 128 + 128 * 128);
constexpr int LDS_XB = LDS_RED + 4096;
constexpr int LDS_BYTES = LDS_XB + 64;

struct Params {
    const float* in[28];
    float* out;
    unsigned char* ws;
    int ph_lo, ph_hi;
};
typedef const __attribute__((address_space(4))) Params* PP;

typedef __bf16 bf16v2 __attribute__((ext_vector_type(2)));
DEVI unsigned cvt_pk(float lo, float hi) { f32x2 v = {lo, hi}; bf16v2 b = __builtin_convertvector(v, bf16v2); return __builtin_bit_cast(unsigned, b); }
DEVI u32x2 pack4(f32x4 v) { u32x2 r; r.x = cvt_pk(v.x, v.y); r.y = cvt_pk(v.z, v.w); return r; }
DEVI float sigmoidf_(float x) { return 1.f / (1.f + __expf(-x)); }
DEVI float siluf_(float x) { return x / (1.f + __expf(-x)); }
DEVI float gelu_tanh(float y) { const float a = 0.7978845608028654f * (y + 0.044715f * y * y * y); const float th = 1.f - 2.f / (__expf(2.f * a) + 1.f); return 0.5f * y * (1.f + th); }

#define XB_TMO      128
#define XB_XCNT(j)  (256  + 64 * (j))
#define XB_XSUB(j)  (1280 + 64 * (j))
#define XB_XGEN(j)  (2304 + 64 * (j))
#define XB_TOP      3328
#define XB_TOPGEN   3392
#define XCD_BAR_WORDS 3456
#define XB_SPIN_CAP (1u << 22)
#define WAITV(n) asm volatile("s_waitcnt vmcnt(" #n ")" ::: "memory")
DEVI unsigned xb_ld(unsigned* p)              { return __hip_atomic_load(p, __ATOMIC_RELAXED, __HIP_MEMORY_SCOPE_AGENT); }
DEVI unsigned xb_add(unsigned* p, unsigned v) { return __hip_atomic_fetch_add(p, v, __ATOMIC_RELAXED, __HIP_MEMORY_SCOPE_AGENT); }
DEVI unsigned xb_xcc_id() { return (unsigned)__builtin_amdgcn_s_getreg((3 << 11) | 20) & 0xFu; }
#define XB_SPIN(cond, bar) do { unsigned _sp = 0; while (cond) { __builtin_amdgcn_s_sleep(1); \
    if ((++_sp & 255u) == 0u) { if (xb_ld(&(bar)[XB_TMO])) break; if (_sp > XB_SPIN_CAP) { atomicAdd(&(bar)[XB_TMO], 1u); break; } } } } while (0)
struct XcdBarrier { unsigned* bar; unsigned x; volatile LAS unsigned* st; };
DEVI XcdBarrier xcd_barrier_post(unsigned* bar, volatile LAS unsigned* st) {
    XcdBarrier b; b.bar = bar; b.x = xb_xcc_id(); b.st = st;
    if (threadIdx.x == 0) (void)xb_add(&bar[XB_XCNT(b.x)], 1u);
    return b;
}
DEVI void xcd_barrier_complete(unsigned* bar, unsigned x, unsigned& nloc, unsigned& nx) {
    const unsigned G = gridDim.x * gridDim.y * gridDim.z;
    unsigned sum, cnt, mine, sp = 0u;
    for (;;) {
        sum = 0u; cnt = 0u; mine = 0u;
#pragma unroll
        for (unsigned j = 0; j < 16; ++j) { const unsigned c = xb_ld(&bar[XB_XCNT(j)]); sum += c; cnt += (c > 0u) ? 1u : 0u; mine = (j == x) ? c : mine; }
        if (sum == G) break;
        __builtin_amdgcn_s_sleep(1);
        if ((++sp & 255u) == 0u) { if (xb_ld(&bar[XB_TMO])) break; if (sp > XB_SPIN_CAP) { atomicAdd(&bar[XB_TMO], 1u); break; } }
    }
    nloc = mine > 0u ? mine : 1u; nx = cnt > 0u ? cnt : 1u;
}
DEVI void xcd_barrier(const XcdBarrier& b) {
    asm volatile("s_waitcnt vmcnt(0)" ::: "memory");
    __syncthreads();
    if (threadIdx.x == 0) {
        unsigned* bar = b.bar;
        __builtin_amdgcn_s_waitcnt(0);
        unsigned nloc = b.st[0], nx = b.st[1];
        if (nloc == 0u) { xcd_barrier_complete(bar, b.x, nloc, nx); b.st[0] = nloc; b.st[1] = nx; }
        const unsigned old = xb_add(&bar[XB_XSUB(b.x)], 1u);
        const unsigned gen = old / nloc;
        if (old + 1u == (gen + 1u) * nloc) {
            __builtin_amdgcn_fence(__ATOMIC_RELEASE, "agent");
            asm volatile("s_waitcnt vmcnt(0)" ::: "memory");
            const unsigned og = xb_add(&bar[XB_TOP], 1u);
            const unsigned tg = og / nx;
            if (og + 1u == (tg + 1u) * nx) xb_add(&bar[XB_TOPGEN], 1u);
            else XB_SPIN(xb_ld(&bar[XB_TOPGEN]) == tg, bar);
            __builtin_amdgcn_fence(__ATOMIC_ACQUIRE, "agent");
            xb_add(&bar[XB_XGEN(b.x)], 1u);
            asm volatile("s_waitcnt vmcnt(0)" ::: "memory");
        } else {
            XB_SPIN(xb_ld(&bar[XB_XGEN(b.x)]) == gen, bar);
            __builtin_amdgcn_fence(__ATOMIC_ACQUIRE, "agent");
            asm volatile("s_waitcnt vmcnt(0)" ::: "memory");
        }
    }
    __syncthreads();
}

DEVI int tid_() { int t = threadIdx.x; asm volatile("" : "+v"(t)); return t; }
DEVI int bid_() { int b = blockIdx.x; asm volatile("" : "+s"(b)); return b; }
#ifndef PF_DIST
#define PF_DIST 2
#endif
constexpr int GA_B = 256 * 128, GB_B = 128 * 128, GSTAGE = GA_B + GB_B, GNST = 3;
template <class Epi>
DEVI void gemm_tile(const bf16_t* __restrict__ A, size_t lda, const bf16_t* __restrict__ Bt, size_t ldb, int K, unsigned char* lds, Epi epi, int koff = 0) {
    const int tid = tid_(), lane = tid & 63, w = tid >> 6, wr = w >> 1, wc = w & 1, fr = lane & 15, fq = lane >> 4;
    f32x4 acc[4][4];
#pragma unroll
    for (int i = 0; i < 4; ++i)
#pragma unroll
        for (int n = 0; n < 4; ++n) acc[i][n] = (f32x4){0.f, 0.f, 0.f, 0.f};
    const int lr8 = lane >> 3, pch = lane & 7;
    const bf16_t* ga[4]; const bf16_t* gb[2];
#pragma unroll
    for (int i = 0; i < 4; ++i) { const int row = (i * 8 + w) * 8 + lr8; ga[i] = A + (size_t)row * lda + ((pch ^ ((row >> 1) & 7)) * 8); }
#pragma unroll
    for (int i = 0; i < 2; ++i) { const int row = (i * 8 + w) * 8 + lr8; gb[i] = Bt + (size_t)row * ldb + ((pch ^ ((row >> 1) & 7)) * 8); }
    const int dofs = w * 1024 + lane * 16;
    const int nk = K >> 6;
    const unsigned ldsbase = (unsigned)(uintptr_t)(LAS unsigned char*)lds;
    const int sx = fr >> 1;
    const int aofs0 = (wr * 64 + fr) * 128 + ((fq ^ sx) * 16), aofs1 = (wr * 64 + fr) * 128 + (((4 + fq) ^ sx) * 16);
    const int bofs0 = GA_B + (wc * 64 + fr) * 128 + ((fq ^ sx) * 16), bofs1 = GA_B + (wc * 64 + fr) * 128 + (((4 + fq) ^ sx) * 16);
#define GEMM_ISSUE(stage, kt_) do { unsigned char* _sb = lds + (stage) * GSTAGE + dofs; int _kk = (kt_) + koff; if (_kk >= nk) _kk -= nk; const int _ko = _kk * 64; \
        _Pragma("unroll") for (int _i = 0; _i < 4; ++_i) __builtin_amdgcn_global_load_lds((const unsigned*)(ga[_i] + _ko), (LAS unsigned*)(LAS unsigned char*)(_sb + _i * 8192), 16, 0, 0); \
        _Pragma("unroll") for (int _i = 0; _i < 2; ++_i) __builtin_amdgcn_global_load_lds((const unsigned*)(gb[_i] + _ko), (LAS unsigned*)(LAS unsigned char*)(_sb + GA_B + _i * 8192), 16, 0, 0); } while (0)
    WAITV(0);
    __builtin_amdgcn_s_barrier();
    GEMM_ISSUE(0, 0);
#if PF_DIST == 2
    if (nk > 1) GEMM_ISSUE(1, 1);
#endif
    int st = 0;
    for (int kt = 0; kt < nk; ++kt) {
#if PF_DIST == 2
        if (kt + 1 < nk) WAITV(6); else WAITV(0);
#else
        WAITV(0);
#endif
        __builtin_amdgcn_s_barrier();
        const unsigned sb = ldsbase + st * GSTAGE;
        bf16x8 af[2][4], bfr[2][4];
#define DSR(dst, addr, off) asm volatile("ds_read_b128 %0, %1 offset:%2" : "=v"(dst) : "v"(addr), "n"(off))
        { const unsigned ab0 = sb + bofs0, aa0 = sb + aofs0, ab1 = sb + bofs1, aa1 = sb + aofs1;
          DSR(bfr[0][0], ab0, 0); DSR(bfr[0][1], ab0, 2048); DSR(bfr[0][2], ab0, 4096); DSR(bfr[0][3], ab0, 6144);
          DSR(af[0][0], aa0, 0); DSR(af[0][1], aa0, 2048); DSR(af[0][2], aa0, 4096); DSR(af[0][3], aa0, 6144);
          DSR(bfr[1][0], ab1, 0); DSR(bfr[1][1], ab1, 2048); DSR(bfr[1][2], ab1, 4096); DSR(bfr[1][3], ab1, 6144);
          DSR(af[1][0], aa1, 0); DSR(af[1][1], aa1, 2048); DSR(af[1][2], aa1, 4096);
          asm volatile("s_waitcnt lgkmcnt(7)" : "+v"(bfr[0][0]), "+v"(bfr[0][1]), "+v"(bfr[0][2]), "+v"(bfr[0][3]), "+v"(af[0][0]), "+v"(af[0][1]), "+v"(af[0][2]), "+v"(af[0][3]));
          DSR(af[1][3], aa1, 6144); }
        __builtin_amdgcn_s_setprio(1);
#pragma unroll
        for (int i = 0; i < 4; ++i)
#pragma unroll
            for (int n = 0; n < 4; ++n) acc[i][n] = __builtin_amdgcn_mfma_f32_16x16x32_bf16(bfr[0][n], af[0][i], acc[i][n], 0, 0, 0);
        __builtin_amdgcn_s_setprio(0);
        __builtin_amdgcn_sched_barrier(0);
#if PF_DIST == 2
        if (kt + 2 < nk) { const int s2 = st >= 1 ? st - 1 : 2; GEMM_ISSUE(s2, kt + 2); }
#else
        if (kt + 1 < nk) { const int s2 = st == 2 ? 0 : st + 1; GEMM_ISSUE(s2, kt + 1); }
#endif
        __builtin_amdgcn_sched_barrier(0);
        asm volatile("s_waitcnt lgkmcnt(0)" : "+v"(bfr[1][0]), "+v"(bfr[1][1]), "+v"(bfr[1][2]), "+v"(bfr[1][3]), "+v"(af[1][0]), "+v"(af[1][1]), "+v"(af[1][2]), "+v"(af[1][3]));
        __builtin_amdgcn_s_setprio(1);
#pragma unroll
        for (int i = 0; i < 4; ++i)
#pragma unroll
            for (int n = 0; n < 4; ++n) acc[i][n] = __builtin_amdgcn_mfma_f32_16x16x32_bf16(bfr[1][n], af[1][i], acc[i][n], 0, 0, 0);
        __builtin_amdgcn_s_setprio(0);
        st = st == 2 ? 0 : st + 1;
    }
    epi(acc, wr, wc, fr, fq);
}

constexpr int H_HALF = 256 * 64, HSTAGE = 2 * H_HALF;
template <class Epi>
DEVI void gemm_tile256(const bf16_t* __restrict__ A, size_t lda, const bf16_t* __restrict__ Bt, size_t ldb, int K, unsigned char* lds, Epi epi) {
    const int tid = tid_(), lane = tid & 63, w = tid >> 6, wr = w >> 2, wc = w & 3, fr = lane & 15, fq = lane >> 4;
    f32x4 acc[8][4];
#pragma unroll
    for (int i = 0; i < 8; ++i)
#pragma unroll
        for (int n = 0; n < 4; ++n) acc[i][n] = (f32x4){0.f, 0.f, 0.f, 0.f};
    const int lr4 = lane >> 2, pch = lane & 3;
    const bf16_t* ga[2]; const bf16_t* gb[2];
#pragma unroll
    for (int i = 0; i < 2; ++i) { const int row = (i * 8 + w) * 16 + lr4; const int lch = pch ^ ((0x1320 >> (((row >> 2) & 3) * 4)) & 3); ga[i] = A + (size_t)row * lda + lch * 8; gb[i] = Bt + (size_t)row * ldb + lch * 8; }
    const int dofs = w * 1024 + lane * 16;
    const int nk = K >> 5;
    const unsigned ldsbase = (unsigned)(uintptr_t)(LAS unsigned char*)lds;
    const int pcs = (fq ^ ((0x1320 >> (((fr >> 2) & 3) * 4)) & 3)) * 16;
    const int aofs = (wr * 128 + fr) * 64 + pcs, bofs = H_HALF + (wc * 64 + fr) * 64 + pcs;
#define H_ISSUE(stage, kt_) do { unsigned char* _sb = lds + (stage) * HSTAGE + dofs; const int _ko = (kt_) * 32; \
        _Pragma("unroll") for (int _i = 0; _i < 2; ++_i) __builtin_amdgcn_global_load_lds((const unsigned*)(ga[_i] + _ko), (LAS unsigned*)(LAS unsigned char*)(_sb + _i * 8192), 16, 0, 0); \
        _Pragma("unroll") for (int _i = 0; _i < 2; ++_i) __builtin_amdgcn_global_load_lds((const unsigned*)(gb[_i] + _ko), (LAS unsigned*)(LAS unsigned char*)(_sb + H_HALF + _i * 8192), 16, 0, 0); } while (0)
#define DSR2(dst, addr, off) asm volatile("ds_read_b128 %0, %1 offset:%2" : "=v"(dst) : "v"(addr), "n"(off))
    const int wu = __builtin_amdgcn_readfirstlane(w);
    bf16x8 af[8], bfr[4];
#define H_READS(stg) do { const unsigned sa = ldsbase + (stg) * HSTAGE + aofs, sb = ldsbase + (stg) * HSTAGE + bofs; \
        DSR2(bfr[0], sb, 0); DSR2(bfr[1], sb, 1024); DSR2(bfr[2], sb, 2048); DSR2(bfr[3], sb, 3072); \
        DSR2(af[0], sa, 0); DSR2(af[1], sa, 1024); DSR2(af[2], sa, 2048); DSR2(af[3], sa, 3072); \
        DSR2(af[4], sa, 4096); DSR2(af[5], sa, 5120); DSR2(af[6], sa, 6144); DSR2(af[7], sa, 7168); } while (0)
#define H_WAIT_LO(n_) asm volatile("s_waitcnt lgkmcnt(" #n_ ")" : "+v"(bfr[0]), "+v"(bfr[1]), "+v"(bfr[2]), "+v"(bfr[3]), "+v"(af[0]), "+v"(af[1]), "+v"(af[2]), "+v"(af[3]))
#define H_WAIT_HI() asm volatile("s_waitcnt lgkmcnt(0)" : "+v"(af[4]), "+v"(af[5]), "+v"(af[6]), "+v"(af[7]))
#define H_MMA2(i0) do { __builtin_amdgcn_s_setprio(1); \
        _Pragma("unroll") for (int i = (i0); i < (i0) + 2; ++i) _Pragma("unroll") for (int n = 0; n < 4; ++n) acc[i][n] = __builtin_amdgcn_mfma_f32_16x16x32_bf16(bfr[n], af[i], acc[i][n], 0, 0, 0); \
        __builtin_amdgcn_s_setprio(0); __builtin_amdgcn_sched_barrier(0); } while (0)
#define H_PIECE(stage, kt_, j_) do { if ((kt_) < nk) { unsigned char* _sb = lds + (stage) * HSTAGE + dofs; const int _ko = (kt_) * 32; \
        if ((j_) < 2) __builtin_amdgcn_global_load_lds((const unsigned*)(ga[(j_) & 1] + _ko), (LAS unsigned*)(LAS unsigned char*)(_sb + ((j_) & 1) * 8192), 16, 0, 0); \
        else __builtin_amdgcn_global_load_lds((const unsigned*)(gb[(j_) & 1] + _ko), (LAS unsigned*)(LAS unsigned char*)(_sb + H_HALF + ((j_) & 1) * 8192), 16, 0, 0); } \
        __builtin_amdgcn_sched_barrier(0); } while (0)
#define H_SCHED() __builtin_amdgcn_sched_barrier(0)
    WAITV(0);
    __builtin_amdgcn_s_barrier();
    H_ISSUE(0, 0); H_ISSUE(1, 1); H_ISSUE(2, 2);
    if (wu < 4) {
        for (int kt = 0; kt < nk; ++kt) {
            if (kt + 2 < nk) WAITV(8); else if (kt + 1 < nk) WAITV(4); else WAITV(0);
            __builtin_amdgcn_s_barrier();
            const int s3 = (kt + 3) & 3;
            H_READS(kt & 3); H_SCHED();
            H_WAIT_LO(4);
            H_MMA2(0); H_PIECE(s3, kt + 3, 0);
            H_MMA2(2); H_PIECE(s3, kt + 3, 1);
            H_WAIT_HI();
            H_MMA2(4); H_PIECE(s3, kt + 3, 2);
            H_MMA2(6); H_PIECE(s3, kt + 3, 3);
        }
    } else {
        for (int kt = 0; kt < nk; ++kt) {
            if (kt + 2 < nk) WAITV(8); else if (kt + 1 < nk) WAITV(4); else WAITV(0);
            __builtin_amdgcn_s_barrier();
            const int s3 = (kt + 3) & 3;
            if (kt > 0) {
                H_MMA2(0); H_PIECE(s3, kt + 3, 0);
                H_MMA2(2); H_PIECE(s3, kt + 3, 1);
                H_MMA2(4); H_PIECE(s3, kt + 3, 2);
                H_MMA2(6); H_PIECE(s3, kt + 3, 3);
            } else { H_PIECE(s3, kt + 3, 0); H_PIECE(s3, kt + 3, 1); H_PIECE(s3, kt + 3, 2); H_PIECE(s3, kt + 3, 3); }
            H_READS(kt & 3); H_SCHED();
            H_WAIT_LO(0); H_WAIT_HI();
            H_SCHED();
        }
        H_MMA2(0); H_MMA2(2); H_MMA2(4); H_MMA2(6);
    }
    epi(acc, wr, wc, fr, fq);
}

DEVI int p8_lds_byte(int r, int c) { const int st = (r >> 4) * 2 + (c >> 5), rr = r & 15, cc = c & 31, ob = rr * 64 + cc * 2; return st * 1024 + (ob ^ (((ob >> 9) & 1) << 5)); }
DEVI void p8_stage_rc(int b, int& R, int& C) { const int st = b / 1024, sb = b % 1024, swz = sb ^ (((sb >> 9) & 1) << 5); R = (st >> 1) * 16 + swz / 64; C = (st & 1) * 32 + (swz % 64) / 2; }
template <bool SWAP = true, class Epi>
DEVI void gemm_tile8p(const bf16_t* __restrict__ A, const bf16_t* __restrict__ Bt, int K, unsigned char* lds, Epi epi) {
    constexpr int HTB = 128 * 64 * 2;
    const int tid = tid_(), lane = tid & 63, wid = __builtin_amdgcn_readfirstlane(tid >> 6), wr = wid >> 2, wc = wid & 3, fr = lane & 15, fq = lane >> 4;
    f32x4 acc[2][2][4][2];
#pragma unroll
    for (int a_ = 0; a_ < 2; ++a_)
#pragma unroll
        for (int b_ = 0; b_ < 2; ++b_)
#pragma unroll
            for (int m = 0; m < 4; ++m)
#pragma unroll
                for (int n = 0; n < 2; ++n) acc[a_][b_][m][n] = (f32x4){0.f, 0.f, 0.f, 0.f};
    bf16x8 At[4][2], B0[2][2], B1[2][2];
    unsigned voff[2];
#pragma unroll
    for (int i = 0; i < 2; ++i) { int R, C; p8_stage_rc(tid * 16 + i * 8192, R, C); voff[i] = (unsigned)(R * K + C); }
    const int aoff = p8_lds_byte(wr * 64 + fr, fq * 8), boff = p8_lds_byte(wc * 32 + fr, fq * 8);
    const size_t hstep = (size_t)128 * K;
    const int nt = K >> 6;
#define P8_SA(b, h) (((b) * 2 + (h)) * HTB)
#define P8_SB(b, h) ((4 + (b) * 2 + (h)) * HTB)
#define P8_STAGE(bufoff, gbase, kt_) do { _Pragma("unroll") for (int _i = 0; _i < 2; ++_i) \
        __builtin_amdgcn_global_load_lds((const unsigned*)((gbase) + voff[_i] + (size_t)(kt_) * 64), (LAS unsigned*)(LAS unsigned char*)(lds + (bufoff) + tid * 16 + _i * 8192), 16, 0, 0); } while (0)
#define P8_LDA(dst, b, h) do { _Pragma("unroll") for (int m = 0; m < 4; ++m) _Pragma("unroll") for (int k = 0; k < 2; ++k) dst[m][k] = *(const bf16x8*)(lds + P8_SA(b, h) + aoff + m * 2048 + k * 1024); } while (0)
#define P8_LDB(dst, b, h) do { _Pragma("unroll") for (int n = 0; n < 2; ++n) _Pragma("unroll") for (int k = 0; k < 2; ++k) dst[n][k] = *(const bf16x8*)(lds + P8_SB(b, h) + boff + n * 2048 + k * 1024); } while (0)
#define P8_MMA(ai, bj, At_, Bt_) do { __builtin_amdgcn_s_setprio(1); _Pragma("unroll") for (int m = 0; m < 4; ++m) _Pragma("unroll") for (int n = 0; n < 2; ++n) _Pragma("unroll") for (int k = 0; k < 2; ++k) \
        acc[ai][bj][m][n] = SWAP ? __builtin_amdgcn_mfma_f32_16x16x32_bf16(Bt_[n][k], At_[m][k], acc[ai][bj][m][n], 0, 0, 0) : __builtin_amdgcn_mfma_f32_16x16x32_bf16(At_[m][k], Bt_[n][k], acc[ai][bj][m][n], 0, 0, 0); __builtin_amdgcn_s_setprio(0); } while (0)
#define P8_WAIT_L(n) asm volatile("s_waitcnt lgkmcnt(" #n ")" ::: "memory")
#define P8_BAR __builtin_amdgcn_s_barrier()
#define P8_SCHED __builtin_amdgcn_sched_barrier(0)
    const bf16_t* cA = A; const bf16_t* cB = Bt;
    WAITV(0);
    P8_BAR;
    P8_STAGE(P8_SB(0, 0), cB, 0); P8_STAGE(P8_SA(0, 0), cA, 0); P8_STAGE(P8_SB(0, 1), cB + hstep, 0); P8_STAGE(P8_SA(0, 1), cA + hstep, 0);
    if (wr == 1) P8_BAR;
    WAITV(4); P8_BAR;
    P8_STAGE(P8_SB(1, 0), cB, 1); P8_STAGE(P8_SA(1, 0), cA, 1); P8_STAGE(P8_SB(1, 1), cB + hstep, 1);
    WAITV(6); P8_BAR;
    for (int t = 0; t < nt - 2; t += 2) {
        P8_LDB(B0, 0, 0); P8_SCHED; P8_LDA(At, 0, 0); P8_STAGE(P8_SA(1, 1), cA + hstep, t + 1);
        P8_WAIT_L(8); P8_BAR; P8_WAIT_L(0); P8_MMA(0, 0, At, B0); P8_BAR; P8_SCHED;
        P8_LDB(B1, 0, 1); P8_STAGE(P8_SB(0, 0), cB, t + 2);
        P8_BAR; P8_WAIT_L(0); P8_MMA(0, 1, At, B1); P8_BAR;
        P8_LDA(At, 0, 1); P8_STAGE(P8_SA(0, 0), cA, t + 2);
        P8_BAR; P8_WAIT_L(0); P8_MMA(1, 0, At, B0); P8_BAR; P8_SCHED;
        P8_STAGE(P8_SB(0, 1), cB + hstep, t + 2);
        WAITV(6); P8_BAR; P8_MMA(1, 1, At, B1); P8_BAR;
        P8_LDB(B0, 1, 0); P8_SCHED; P8_LDA(At, 1, 0); P8_STAGE(P8_SA(0, 1), cA + hstep, t + 2);
        P8_WAIT_L(8); P8_BAR; P8_WAIT_L(0); P8_MMA(0, 0, At, B0); P8_BAR; P8_SCHED;
        P8_LDB(B1, 1, 1); P8_STAGE(P8_SB(1, 0), cB, t + 3);
        P8_BAR; P8_WAIT_L(0); P8_MMA(0, 1, At, B1); P8_BAR;
        P8_LDA(At, 1, 1); P8_STAGE(P8_SA(1, 0), cA, t + 3);
        P8_BAR; P8_WAIT_L(0); P8_MMA(1, 0, At, B0); P8_BAR; P8_SCHED;
        P8_STAGE(P8_SB(1, 1), cB + hstep, t + 3);
        WAITV(6); P8_BAR; P8_MMA(1, 1, At, B1); P8_BAR;
    }
    { P8_LDB(B0, 0, 0); P8_LDA(At, 0, 0); P8_STAGE(P8_SA(1, 1), cA + hstep, nt - 1);
      P8_BAR; P8_WAIT_L(0); P8_MMA(0, 0, At, B0); P8_BAR;
      P8_LDB(B1, 0, 1); P8_BAR; P8_WAIT_L(0); P8_MMA(0, 1, At, B1); P8_BAR;
      P8_LDA(At, 0, 1); WAITV(4); P8_BAR; P8_WAIT_L(0); P8_MMA(1, 0, At, B0); P8_MMA(1, 1, At, B1); P8_BAR; }
    { P8_LDB(B0, 1, 0); P8_LDA(At, 1, 0); WAITV(2); P8_BAR; P8_WAIT_L(0); P8_MMA(0, 0, At, B0); P8_BAR;
      P8_LDB(B1, 1, 1); WAITV(0); P8_BAR; P8_WAIT_L(0); P8_MMA(0, 1, At, B1); P8_BAR;
      P8_LDA(At, 1, 1); P8_BAR; P8_WAIT_L(0); P8_MMA(1, 0, At, B0); P8_MMA(1, 1, At, B1); P8_BAR; }
    if (wr == 0) P8_BAR;
    epi(acc, wr, wc, fr, fq);
}

struct WS {
    unsigned char* b;
    DEVI bf16_t* wt_s5in(int j) const { return (bf16_t*)(b + WS_WT_S5IN) + (size_t)j * 1024 * 1024; }
    DEVI bf16_t* wt_glu(int j) const { return (bf16_t*)(b + WS_WT_GLU) + (size_t)j * 2048 * 1024; }
    DEVI bf16_t* wt_s5out(int j) const { return (bf16_t*)(b + WS_WT_S5OUT) + (size_t)j * 1024 * 1024; }
    DEVI bf16_t* wt_qkv(int j) const { return (bf16_t*)(b + WS_WT_QKV) + (size_t)j * 1536 * 1024; }
    DEVI bf16_t* wt_o(int j) const { return (bf16_t*)(b + WS_WT_O) + (size_t)j * 1024 * 1024; }
    DEVI bf16_t* wt_ffnin(int l) const { return (bf16_t*)(b + WS_WT_FFNIN) + (size_t)l * 5632 * 1024; }
    DEVI bf16_t* wt_ffnout(int l) const { return (bf16_t*)(b + WS_WT_FFNOUT) + (size_t)l * 1024 * 2816; }
    DEVI bf16_t* mg(int j, int g) const { return (bf16_t*)(b + WS_MG) + ((size_t)(j * 64 + g) * 512) * 256; }
    DEVI bf16_t* vg(int j, int g) const { return (bf16_t*)(b + WS_VG) + ((size_t)(j * 64 + g) * 256) * 256; }
    DEVI float* lam16() const { return (float*)(b + WS_LAM16); }
    DEVI float* mod(int layer, int cond, int chunk) const { return (float*)(b + WS_MOD) + ((size_t)(layer * 5 + cond) * 6144 + chunk * 1024); }
    DEVI float* rope() const { return (float*)(b + WS_ROPE); }
    DEVI bf16_t* ks(int j) const { return (bf16_t*)(b + WS_KS + j * KS_LAYER); }
    DEVI bf16_t* vts(int j) const { return (bf16_t*)(b + WS_VTS + j * KS_LAYER); }
    DEVI bf16_t* kp() const { return (bf16_t*)(b + WS_KP); }
    DEVI bf16_t* vtp() const { return (bf16_t*)(b + WS_VTP); }
    DEVI float* X() const { return (float*)(b + WS_X); }
    DEVI float* T() const { return (float*)(b + WS_T); }
    DEVI bf16_t* H() const { return (bf16_t*)(b + WS_H); }
    DEVI bf16_t* bufa() const { return (bf16_t*)(b + WS_BUFA); }
    DEVI bf16_t* bufb() const { return (bf16_t*)(b + WS_BUFB); }
    DEVI bf16_t* act() const { return (bf16_t*)(b + WS_ACT); }
    DEVI float* sl() const { return (float*)(b + WS_SL); }
    DEVI float* part() const { return (float*)(b + WS_PART); }
};
DEVI int cond_of_row(int row) { return row < NPR ? 0 : 1 + ((row - NPR) >> 10); }

DEVI void s5_mats_item(PP p, const WS& ws, int item, unsigned char* lds) {
    const int j = item >> 6, g = item & 63, tid = tid_();
    float* lamp = (float*)lds;
    float* bbar = lamp + 2 * 64 * 17 * 2;
    float* ktab = bbar + 2 * 64 * 16 * 2;
    if (tid < 128) {
        const int dir = tid >> 6, pp = tid & 63;
        const int gi = (j * 2 + dir) * 64 + g, idx = gi * 64 + pp;
        const float are = p->in[12][idx], aim = p->in[13][idx], dt = expf(p->in[14][gi]);
        const float mag = expf(dt * are);
        float sn, cs; sincosf(dt * aim, &sn, &cs);
        const float lr = mag * cs, li = mag * sn;
        const float den = are * are + aim * aim, nr = lr - 1.f;
        const float kre = (nr * are + li * aim) / den, kim = (li * are - nr * aim) / den;
        float pr = 1.f, pi = 0.f;
        float* lp = lamp + (dir * 64 + pp) * 34;
        for (int e = 0; e <= 16; ++e) { lp[2 * e] = pr; lp[2 * e + 1] = pi; const float t = pr * lr - pi * li; pi = pr * li + pi * lr; pr = t; }
        float* l16 = ws.lam16() + (size_t)idx * 2; l16[0] = lp[32]; l16[1] = lp[33];
        const float* bre = p->in[15] + (size_t)idx * 16; const float* bim = p->in[16] + (size_t)idx * 16;
        float* bb = bbar + (dir * 64 + pp) * 32;
        for (int h = 0; h < 16; ++h) { const float br = bre[h], bi = bim[h]; bb[h] = kre * br - kim * bi; bb[16 + h] = kre * bi + kim * br; }
    }
    __syncthreads();
    {
        const int dir = tid >> 8, tau = (tid >> 4) & 15, h = tid & 15;
        const float* cre = p->in[17] + ((size_t)((j * 2 + dir) * 64 + g) * 16 + h) * 64;
        const float* cim = p->in[18] + ((size_t)((j * 2 + dir) * 64 + g) * 16 + h) * 64;
        f32x4 a4[4];
#pragma unroll
        for (int q = 0; q < 4; ++q) a4[q] = (f32x4){0.f, 0.f, 0.f, 0.f};
        for (int pp = 0; pp < 64; ++pp) {
            const float cr = cre[pp], ci = cim[pp];
            const float lr = lamp[(dir * 64 + pp) * 34 + 2 * tau], li = lamp[(dir * 64 + pp) * 34 + 2 * tau + 1];
            const float qr = cr * lr - ci * li, qi = cr * li + ci * lr;
            const f32x4* br4 = (const f32x4*)(bbar + (dir * 64 + pp) * 32);
#pragma unroll
            for (int q = 0; q < 4; ++q) a4[q] += br4[q] * qr - br4[4 + q] * qi;
        }
        float* kt = ktab + ((dir * 16 + tau) * 16 + h) * 16;
#pragma unroll
        for (int q = 0; q < 4; ++q) *(f32x4*)(kt + 4 * q) = a4[q];
    }
    __syncthreads();
    bf16_t* Mg = ws.mg(j, g);
    bf16_t* Vg = ws.vg(j, g);
    const float* dsk = p->in[19] + j * 1024 + g * 16;
    for (int i8 = tid; i8 < 8192; i8 += NTHR) {
        const int m = i8 >> 5, k8 = (i8 & 31) * 8;
        {
            const int t = m >> 4, h = m & 15, t2 = k8 >> 4, h0 = k8 & 15;
            float v[8];
#pragma unroll
            for (int e = 0; e < 8; ++e) {
                float x = 0.f;
                if (t2 <= t) x += ktab[((0 * 16 + (t - t2)) * 16 + h) * 16 + h0 + e];
                if (t2 >= t) x += ktab[((1 * 16 + (t2 - t)) * 16 + h) * 16 + h0 + e];
                if (t2 == t && h0 + e == h) x += dsk[h];
                v[e] = x;
            }
            u32x4 o; o.x = cvt_pk(v[0], v[1]); o.y = cvt_pk(v[2], v[3]); o.z = cvt_pk(v[4], v[5]); o.w = cvt_pk(v[6], v[7]);
            *(u32x4*)(Mg + (size_t)m * 256 + k8) = o;
        }
        {
            const int dir = m >> 7, ri = (m >> 6) & 1, pp = m & 63, t2 = k8 >> 4, h0 = k8 & 15;
            const int e = dir == 0 ? 15 - t2 : t2;
            const float lr = lamp[(dir * 64 + pp) * 34 + 2 * e], li = lamp[(dir * 64 + pp) * 34 + 2 * e + 1];
            const float* bb = bbar + (dir * 64 + pp) * 32;
            float v[8];
#pragma unroll
            for (int q = 0; q < 8; ++q) { const float br = bb[h0 + q], bi = bb[16 + h0 + q]; v[q] = ri == 0 ? lr * br - li * bi : lr * bi + li * br; }
            u32x4 o; o.x = cvt_pk(v[0], v[1]); o.y = cvt_pk(v[2], v[3]); o.z = cvt_pk(v[4], v[5]); o.w = cvt_pk(v[6], v[7]);
            *(u32x4*)(Mg + (size_t)(256 + m) * 256 + k8) = o;
        }
        {
            const int t = m >> 4, h = m & 15, dir = k8 >> 7, ri = (k8 >> 6) & 1, p0 = k8 & 63;
            const int e = dir == 0 ? t + 1 : 16 - t;
            const float* cre = p->in[17] + ((size_t)((j * 2 + dir) * 64 + g) * 16 + h) * 64 + p0;
            const float* cim = p->in[18] + ((size_t)((j * 2 + dir) * 64 + g) * 16 + h) * 64 + p0;
            float v[8];
#pragma unroll
            for (int q = 0; q < 8; ++q) {
                const float cr = cre[q], ci = cim[q];
                const float lr = lamp[(dir * 64 + p0 + q) * 34 + 2 * e], li = lamp[(dir * 64 + p0 + q) * 34 + 2 * e + 1];
                v[q] = ri == 0 ? (cr * lr - ci * li) : -(cr * li + ci * lr);
            }
            u32x4 o; o.x = cvt_pk(v[0], v[1]); o.y = cvt_pk(v[2], v[3]); o.z = cvt_pk(v[4], v[5]); o.w = cvt_pk(v[6], v[7]);
            *(u32x4*)(Vg + (size_t)m * 256 + k8) = o;
        }
    }
    __syncthreads();
}

DEVI void adaln_item(PP p, const WS& ws, int item, unsigned char* lds) {
    const int layer = item / 96, cgp = item % 96, tid = tid_();
    float* sil = (float*)lds;
    float* red = sil + 5 * 1024;
    for (int i = tid; i < 5120; i += NTHR) { const int c = i >> 10, k = i & 1023; const float v = c == 0 ? p->in[6][k] : p->in[2][(c - 1) * 1024 + k]; sil[i] = siluf_(v); }
    __syncthreads();
    const int c4 = tid & 15, kr = tid >> 4;
    f32x4 a[5];
#pragma unroll
    for (int c = 0; c < 5; ++c) a[c] = (f32x4){0.f, 0.f, 0.f, 0.f};
    const float* wb = p->in[7] + (size_t)layer * 1024 * 6144 + cgp * 64 + c4 * 4;
    for (int k0 = kr; k0 < 1024; k0 += 256) {
        f32x4 w4[8];
#pragma unroll
        for (int u = 0; u < 8; ++u) w4[u] = __builtin_nontemporal_load((const f32x4*)(wb + (size_t)(k0 + 32 * u) * 6144));
#pragma unroll
        for (int u = 0; u < 8; ++u)
#pragma unroll
            for (int c = 0; c < 5; ++c) a[c] += w4[u] * sil[c * 1024 + k0 + 32 * u];
    }
#pragma unroll
    for (int c = 0; c < 5; ++c) *(f32x4*)(red + (kr * 5 + c) * 64 + c4 * 4) = a[c];
    __syncthreads();
    if (tid < 320) {
        const int c = tid >> 6, col = tid & 63;
        float s = p->in[8][layer * 6144 + cgp * 64 + col];
        for (int r = 0; r < 32; ++r) s += red[(r * 5 + c) * 64 + col];
        ((float*)(ws.b + WS_MOD))[(size_t)(layer * 5 + c) * 6144 + cgp * 64 + col] = s;
    }
    if (item < 32) {
        WAITV(0);
        __syncthreads();
        if (tid == 0) { __builtin_amdgcn_fence(__ATOMIC_RELEASE, "agent"); WAITV(0); xb_add((unsigned*)(ws.b + WS_BAR) + 3713, 1u); }
    }
    __syncthreads();
}

struct WtD { const float* src; bf16_t* dst; int K, N, half, tile; };
constexpr int WT_L0_END = 784, WT_A_END = 1296, WT_B_END = 1744, WT_C_END = 2256, WT_D_END = 2768, WT_TOT = 2944;
DEVI WtD wt_make(PP p, const WS& ws, int kind, int l, int tile) {
    WtD d; d.tile = tile;
    if (kind == 0) { d.src = p->in[26] + (size_t)l * 1024 * 5632; d.dst = ws.wt_ffnin(l); d.K = 1024; d.N = 5632; d.half = 2816; }
    else if (kind == 1) { d.src = p->in[27] + (size_t)l * 2816 * 1024; d.dst = ws.wt_ffnout(l); d.K = 2816; d.N = 1024; d.half = 0; }
    else if (kind == 2) { d.src = p->in[20] + (size_t)l * 1024 * 2048; d.dst = ws.wt_glu(l); d.K = 1024; d.N = 2048; d.half = 1024; }
    else if (kind == 3) { d.src = p->in[22] + (size_t)l * 1024 * 1536; d.dst = ws.wt_qkv(l); d.K = 1024; d.N = 1536; d.half = -1; }
    else if (kind == 4) { d.src = p->in[11] + (size_t)l * 1024 * 1024; d.dst = ws.wt_s5in(l); d.K = 1024; d.N = 1024; d.half = 0; }
    else if (kind == 5) { d.src = p->in[21] + (size_t)l * 1024 * 1024; d.dst = ws.wt_s5out(l); d.K = 1024; d.N = 1024; d.half = 0; }
    else { d.src = p->in[25] + (size_t)l * 1024 * 1024; d.dst = ws.wt_o(l); d.K = 1024; d.N = 1024; d.half = 0; }
    return d;
}
DEVI WtD wt_decode(PP p, const WS& ws, int t) {
    if (t < 352) return wt_make(p, ws, 0, 0, t);
    if (t < 528) return wt_make(p, ws, 1, 0, t - 352);
    if (t < 656) return wt_make(p, ws, 2, 0, t - 528);
    if (t < 720) return wt_make(p, ws, 4, 0, t - 656);
    if (t < 784) return wt_make(p, ws, 5, 0, t - 720);
    if (t < 880) return wt_make(p, ws, 3, 0, t - 784);
    if (t < 944) return wt_make(p, ws, 6, 0, t - 880);
    if (t < 1296) return wt_make(p, ws, 0, 1, t - 944);
    if (t < 1472) return wt_make(p, ws, 1, 1, t - 1296);
    if (t < 1568) return wt_make(p, ws, 0, 2, 256 + (t - 1472));
    if (t < 1744) return wt_make(p, ws, 1, 2, t - 1568);
    if (t < 1808) return wt_make(p, ws, 4, 1, t - 1744);
    if (t < 1936) return wt_make(p, ws, 2, 1, t - 1808);
    if (t < 2000) return wt_make(p, ws, 5, 1, t - 1936);
    if (t < 2256) return wt_make(p, ws, 0, 2, t - 2000);
    if (t < 2352) return wt_make(p, ws, 3, 1, t - 2256);
    if (t < 2416) return wt_make(p, ws, 6, 1, t - 2352);
    if (t < 2768) return wt_make(p, ws, 0, 3, t - 2416);
    return wt_make(p, ws, 1, 3, t - 2768);
}
DEVI void wt_load(const WtD& d, int tid, f32x4 (&v)[8]) {
    const int ntn = d.N >> 6, k0 = (d.tile / ntn) * 256, n0 = (d.tile % ntn) * 64, r = tid >> 4, c4 = (tid & 15) * 4;
#pragma unroll
    for (int i = 0; i < 8; ++i) v[i] = __builtin_nontemporal_load((const f32x4*)(d.src + (size_t)(k0 + r + 32 * i) * d.N + n0 + c4));
}
DEVI void wt_all(PP p, const WS& ws, int t0, int tstep, int tot, unsigned char* lds) {
    float* sc = (float*)lds;
    const int tid = tid_();
    if (t0 >= tot) return;
    WtD cur = wt_decode(p, ws, t0);
    f32x4 v[8];
    wt_load(cur, tid, v);
    for (int t = t0; t < tot; t += tstep) {
        const bool has = t + tstep < tot;
        {
            const int r = tid >> 4, c4 = (tid & 15) * 4;
#pragma unroll
            for (int i = 0; i < 8; ++i) { float* q = sc + (r + 32 * i) * 65 + c4; q[0] = v[i].x; q[1] = v[i].y; q[2] = v[i].z; q[3] = v[i].w; }
        }
        __syncthreads();
        WtD nxt = cur;
        if (has) { nxt = wt_decode(p, ws, t + tstep); wt_load(nxt, tid, v); }
        {
            const int ntn = cur.N >> 6, k0 = (cur.tile / ntn) * 256, n0 = (cur.tile % ntn) * 64;
            const int nn = tid >> 3, kq = tid & 7;
            int n = n0 + nn, rho = n;
            if (cur.half > 0) { const int which = n >= cur.half ? 1 : 0, jj = n - which * cur.half; rho = (jj >> 7) * 256 + which * 128 + (jj & 127); }
            else if (cur.half < 0) { const int d = n & 127, wcp = ((d >> 6) << 1) | ((d >> 4) & 1); rho = (n & ~127) + wcp * 32 + ((d >> 5) & 1) * 16 + (d & 15); }
#pragma unroll
            for (int ii = 0; ii < 4; ++ii) {
                const int k8 = (kq + 8 * ii) * 8;
                const float* q = sc + k8 * 65 + nn;
                u32x4 o; o.x = cvt_pk(q[0], q[65]); o.y = cvt_pk(q[130], q[195]); o.z = cvt_pk(q[260], q[325]); o.w = cvt_pk(q[390], q[455]);
                *(u32x4*)(cur.dst + (size_t)rho * cur.K + k0 + k8) = o;
            }
        }
        __syncthreads();
        cur = nxt;
    }
}

DEVI void prep_b(PP p, const WS& ws) {
    const int gt = bid_() * NTHR + tid_(), gn = gridDim.x * NTHR;
    for (int i = gt; i < NROW * (DM / 8); i += gn) {
        const int row = i >> 7, c8 = (i & 127) * 8;
        const float* x = row < NPR ? p->in[0] + (size_t)row * DM : p->in[1] + (size_t)(row - NPR) * DM;
        const int cond = cond_of_row(row);
        const float* sh = ws.mod(0, cond, 0); const float* sc = ws.mod(0, cond, 1);
        const f32x4 x0 = *(const f32x4*)(x + c8), x1 = *(const f32x4*)(x + c8 + 4);
        const f32x4 s0 = *(const f32x4*)(sc + c8), s1 = *(const f32x4*)(sc + c8 + 4);
        const f32x4 h0 = *(const f32x4*)(sh + c8), h1 = *(const f32x4*)(sh + c8 + 4);
        const f32x4 r0 = x0 * (s0 + 1.f) + h0, r1 = x1 * (s1 + 1.f) + h1;
        u32x4 o; o.x = cvt_pk(r0.x, r0.y); o.y = cvt_pk(r0.z, r0.w); o.z = cvt_pk(r1.x, r1.y); o.w = cvt_pk(r1.z, r1.w);
        *(u32x4*)(ws.H() + (size_t)row * DM + c8) = o;
    }
}

DEVI void prep_a(PP p, const WS& ws, unsigned char* lds) {
    const int bid = bid_(), nb = gridDim.x, tid = tid_();
    if (nb == 256) {
        if (bid < 128) s5_mats_item(p, ws, bid, lds);
        else {
            for (int it = bid - 128; it < 192; it += 128) adaln_item(p, ws, it, lds);
            wt_all(p, ws, bid - 128, 128, WT_L0_END, lds);
        }
    } else {
        for (int it = bid; it < 128; it += nb) s5_mats_item(p, ws, it, lds);
        for (int it = nb - 1 - bid; it < 384; it += nb) adaln_item(p, ws, it, lds);
        wt_all(p, ws, bid, nb, WT_TOT, lds);
    }
    const int gt = bid * NTHR + tid, gn = nb * NTHR;
    for (int i = gt; i < 2 * 4 * 512 * 2 * 32; i += gn) {
        const int d4 = (i & 31) * 4, kvh = (i >> 5) & 1, past = (i >> 6) & 511, j = (i >> 15) & 1, b = i >> 16;
        const f32x4 v = *(const f32x4*)(p->in[3] + ((((size_t)b * 2 + j) * 512 + past) * 2 + kvh) * 128 + d4);
        *(u32x2*)(ws.ks(j) + ((size_t)(b * 2 + kvh) * 1536 + 1024 + past) * 128 + d4) = pack4(v);
    }
    for (int i = gt; i < 2 * 4 * 2 * 64 * 128; i += gn) {
        const int d = i & 127, p8 = (i >> 7) & 63, kvh = (i >> 13) & 1, b = (i >> 14) & 3, j = i >> 16;
        const float* s = p->in[4] + ((((size_t)b * 2 + j) * 512 + p8 * 8) * 2 + kvh) * 128 + d;
        u32x4 o; o.x = cvt_pk(s[0], s[256]); o.y = cvt_pk(s[512], s[768]); o.z = cvt_pk(s[1024], s[1280]); o.w = cvt_pk(s[1536], s[1792]);
        *(u32x4*)(ws.vts(j) + ((size_t)(b * 2 + kvh) * 128 + d) * 1536 + 1024 + p8 * 8) = o;
    }
    for (int i = gt; i < 2048; i += gn) {
        const int pos = i >> 5, fi = i & 31;
        const float inv = exp2f(-(float)fi * (13.287712379549449f / 32.f));
        float sn, cs; sincosf((float)pos * inv, &sn, &cs);
        ws.rope()[2 * i] = cs; ws.rope()[2 * i + 1] = sn;
    }
    if (tid == 0) {
        unsigned* cw = (unsigned*)(ws.b + WS_BAR) + 3713; unsigned sp = 0;
        while (xb_ld(cw) < 32u) { __builtin_amdgcn_s_sleep(2); if (++sp > (1u << 22)) break; }
        __builtin_amdgcn_fence(__ATOMIC_ACQUIRE, "agent");
        WAITV(0);
    }
    __syncthreads();
    prep_b(p, ws);
}

DEVI void ln_phase(PP p, const WS& ws, int layer, int which) {
    const int lane = tid_() & 63, gw = bid_() * 8 + (tid_() >> 6), nw = gridDim.x * 8;
    const float* gam = p->in[9] + (layer * 2 + which) * DM; const float* bet = p->in[10] + (layer * 2 + which) * DM;
    const bool last = (layer == 3 && which == 1);
    const int ml = which == 0 ? layer : layer + 1, ms = which == 0 ? 3 : 0;
    float* Xo = last ? p->out + OUT_Y : ws.X();
    for (int row = gw; row < NROW; row += nw) {
        const float* t = ws.T() + (size_t)row * DM;
        f32x4 v[4]; float s = 0.f;
#pragma unroll
        for (int q = 0; q < 4; ++q) { v[q] = *(const f32x4*)(t + q * 256 + lane * 4); s += (v[q].x + v[q].y) + (v[q].z + v[q].w); }
#pragma unroll
        for (int o = 1; o < 64; o <<= 1) s += __shfl_xor(s, o);
        const float mean = s * (1.f / DM); float s2 = 0.f;
#pragma unroll
        for (int q = 0; q < 4; ++q) { v[q] = v[q] - mean; s2 += (v[q].x * v[q].x + v[q].y * v[q].y) + (v[q].z * v[q].z + v[q].w * v[q].w); }
#pragma unroll
        for (int o = 1; o < 64; o <<= 1) s2 += __shfl_xor(s2, o);
        const float rstd = 1.f / sqrtf(s2 * (1.f / DM) + LN_EPS);
        const int cond = cond_of_row(row);
#pragma unroll
        for (int q = 0; q < 4; ++q) {
            const int c = q * 256 + lane * 4;
            const f32x4 y = v[q] * rstd * *(const f32x4*)(gam + c) + *(const f32x4*)(bet + c);
            *(f32x4*)(Xo + (size_t)row * DM + c) = y;
            if (!last) {
                const f32x4 sh = *(const f32x4*)(ws.mod(ml, cond, ms) + c), sc = *(const f32x4*)(ws.mod(ml, cond, ms + 1) + c);
                *(u32x2*)(ws.H() + (size_t)row * DM + c) = pack4(y * (sc + 1.f) + sh);
            }
        }
    }
}

DEVI void out_ln_gemm_phase(PP p, const WS& ws, const bf16_t* A, int K, const bf16_t* Wt, int layer, int which, const float* xlo, const float* xhi, bool xf32, unsigned char* lds) {
    const int gchunk = which == 0 ? 2 : 5;
    const bool last = (layer == 3 && which == 1);
    const int ml = which == 0 ? layer : layer + 1, ms = which == 0 ? 3 : 0;
    const float* gam = p->in[9] + (layer * 2 + which) * DM; const float* bet = p->in[10] + (layer * 2 + which) * DM;
    float* Xo = p->out + OUT_Y;
    bf16_t* Xb = (bf16_t*)ws.X();
    float* part = ws.part() + (size_t)(layer * 2 + which) * NROW * 32;
    unsigned* cnt = (unsigned*)(ws.b + WS_BAR) + 3456 + (layer * 2 + which) * 32;
    for (int t = bid_(); t < 256; t += gridDim.x) {
        const int tm = t & 31, tn = t >> 5;
        const int cond = tm < 16 ? 0 : 1 + ((tm - 16) >> 2);
        const float* gate = ws.mod(layer, cond, gchunk);
        gemm_tile(A + (size_t)tm * 256 * K, K, Wt + (size_t)tn * 128 * K, K, K, lds,
            [&](f32x4 (&acc)[4][4], int wr, int wc, int fr, int fq) {
                const int colb = tn * 128 + wc * 64 + fq * 4;
                const int tid = (wr * 2 + wc) * 64 + fq * 16 + fr;
                {
                    f32x4 gv[4];
#pragma unroll
                    for (int n = 0; n < 4; ++n) gv[n] = *(const f32x4*)(gate + colb + n * 16);
#pragma unroll
                    for (int i = 0; i < 4; ++i) {
                        const int row = tm * 256 + wr * 64 + i * 16 + fr;
                        const float* xp = row < NPR ? xlo + (size_t)row * DM : xhi + (size_t)(row - NPR) * DM;
                        const bf16_t* xq = Xb + (size_t)row * DM;
                        float s1 = 0.f, s2 = 0.f;
#pragma unroll
                        for (int n = 0; n < 4; ++n) {
                            f32x4 xv;
                            if (xf32) xv = *(const f32x4*)(xp + colb + n * 16);
                            else { const u32x2 u = *(const u32x2*)(xq + colb + n * 16); xv.x = __uint_as_float(u.x << 16); xv.y = __uint_as_float(u.x & 0xffff0000u); xv.z = __uint_as_float(u.y << 16); xv.w = __uint_as_float(u.y & 0xffff0000u); }
                            const f32x4 tv = xv * ALPHA + gv[n] * acc[i][n];
                            acc[i][n] = tv;
                            s1 += (tv.x + tv.y) + (tv.z + tv.w);
                            s2 += (tv.x * tv.x + tv.y * tv.y) + (tv.z * tv.z + tv.w * tv.w);
                        }
                        s1 += __shfl_xor(s1, 16); s1 += __shfl_xor(s1, 32);
                        s2 += __shfl_xor(s2, 16); s2 += __shfl_xor(s2, 32);
                        if (fq == 0) { float* rp = (float*)(lds + LDS_RED) + (wc * 256 + wr * 64 + i * 16 + fr) * 2; rp[0] = s1; rp[1] = s2; }
                    }
                }
                __syncthreads();
                if (tid < 256) {
                    const float* rp = (const float*)(lds + LDS_RED);
                    const float v1 = rp[tid * 2] + rp[(256 + tid) * 2], v2 = rp[tid * 2 + 1] + rp[(256 + tid) * 2 + 1];
                    __hip_atomic_store((unsigned long long*)(part + ((size_t)(tm * 8 + tn) * 256 + tid) * 2), (unsigned long long)__float_as_uint(v1) | ((unsigned long long)__float_as_uint(v2) << 32), __ATOMIC_RELAXED, __HIP_MEMORY_SCOPE_AGENT);
                }
                WAITV(0);
                __syncthreads();
                if (tid == 0) {
                    xb_add(&cnt[tm], 1u);
                    unsigned sp = 0;
                    while (xb_ld(&cnt[tm]) < 8u) { __builtin_amdgcn_s_sleep(1); if (++sp > (1u << 24)) break; }
                    __builtin_amdgcn_fence(__ATOMIC_ACQUIRE, "agent");
                    WAITV(0);
                }
                __syncthreads();
                float* stats = (float*)(lds + LDS_RED);
                if (tid < 256) {
                    const float* pp = part + ((size_t)(tm * 8) * 256 + tid) * 2;
                    float s1 = 0.f, s2 = 0.f;
                    f32x2 pv[8];
#pragma unroll
                    for (int q = 0; q < 8; ++q) pv[q] = *(const f32x2*)(pp + q * 512);
#pragma unroll
                    for (int q = 0; q < 8; ++q) { s1 += pv[q].x; s2 += pv[q].y; }
                    const float mean = s1 * (1.f / DM);
                    const float var = fmaxf(s2 * (1.f / DM) - mean * mean, 0.f);
                    stats[2 * tid] = mean; stats[2 * tid + 1] = 1.f / sqrtf(var + LN_EPS);
                }
                __syncthreads();
                const float* shp = ws.mod(ml & 3, cond, ms); const float* scp = ws.mod(ml & 3, cond, ms + 1);
#pragma unroll
                for (int n = 0; n < 4; ++n) {
                    const int c = colb + n * 16;
                    const f32x4 g4 = *(const f32x4*)(gam + c), b4 = *(const f32x4*)(bet + c);
                    f32x4 sh4 = (f32x4){0.f, 0.f, 0.f, 0.f}, sc4 = sh4;
                    if (!last) { sh4 = *(const f32x4*)(shp + c); sc4 = *(const f32x4*)(scp + c); }
#pragma unroll
                    for (int i = 0; i < 4; ++i) {
                        const int rl = wr * 64 + i * 16 + fr, row = tm * 256 + rl;
                        const float mean = stats[2 * rl], rstd = stats[2 * rl + 1];
                        const f32x4 y = (acc[i][n] - mean) * rstd * g4 + b4;
                        if (last) __builtin_nontemporal_store(y, (f32x4*)(Xo + (size_t)row * DM + c));
                        else { *(u32x2*)(Xb + (size_t)row * DM + c) = pack4(y); *(u32x2*)(ws.H() + (size_t)row * DM + c) = pack4(y * (sc4 + 1.f) + sh4); }
                    }
                }
            }, (tm * 5 + tn) % (K >> 6));
    }
}

DEVI void ffn_in_phase(PP p, const WS& ws, int layer, unsigned char* lds) {
    const bf16_t* A = ws.H(); const bf16_t* Wt = ws.wt_ffnin(layer); bf16_t* ACT = ws.act();
    for (int t = bid_(); t < 32 * 22; t += gridDim.x) {
        const int tm = t & 31, tn = t >> 5;
        gemm_tile8p(A + (size_t)tm * 256 * DM, Wt + (size_t)tn * 256 * DM, DM, lds,
            [&](f32x4 (&acc)[2][2][4][2], int wr, int wc, int fr, int fq) {
#pragma unroll
                for (int ai = 0; ai < 2; ++ai)
#pragma unroll
                    for (int m = 0; m < 4; ++m) {
                        const int row = tm * 256 + ai * 128 + wr * 64 + m * 16 + fr;
#pragma unroll
                        for (int n = 0; n < 2; ++n) {
                            const f32x4 g = acc[ai][0][m][n], u = acc[ai][1][m][n];
                            f32x4 r; r.x = siluf_(g.x) * u.x; r.y = siluf_(g.y) * u.y; r.z = siluf_(g.z) * u.z; r.w = siluf_(g.w) * u.w;
                            *(u32x2*)(ACT + (size_t)row * DFF + tn * 128 + wc * 32 + n * 16 + fq * 4) = pack4(r);
                        }
                    }
            });
    }
    if (gridDim.x == 256 && bid_() >= 192 && layer < 3) {
        const int lo = layer == 0 ? WT_L0_END : layer == 1 ? WT_B_END : WT_C_END, hi = layer == 0 ? WT_A_END : layer == 1 ? WT_C_END : WT_D_END;
        wt_all(p, ws, lo + (bid_() - 192), 64, hi, lds);
    }
}

DEVI void glu_phase(const WS& ws, int j, unsigned char* lds) {
    const bf16_t* A = ws.bufa(); const bf16_t* Wt = ws.wt_glu(j); bf16_t* O = ws.bufb();
    for (int t = bid_(); t < 32 * 8; t += gridDim.x) {
        const int tm = t & 31, tn = t >> 5;
        gemm_tile8p(A + (size_t)tm * 256 * DM, Wt + (size_t)tn * 256 * DM, DM, lds,
            [&](f32x4 (&acc)[2][2][4][2], int wr, int wc, int fr, int fq) {
#pragma unroll
                for (int ai = 0; ai < 2; ++ai)
#pragma unroll
                    for (int m = 0; m < 4; ++m) {
                        const int row = tm * 256 + ai * 128 + wr * 64 + m * 16 + fr;
#pragma unroll
                        for (int n = 0; n < 2; ++n) {
                            const f32x4 v = acc[ai][0][m][n], g = acc[ai][1][m][n];
                            f32x4 r; r.x = v.x * sigmoidf_(g.x); r.y = v.y * sigmoidf_(g.y); r.z = v.z * sigmoidf_(g.z); r.w = v.w * sigmoidf_(g.w);
                            *(u32x2*)(O + (size_t)row * DM + tn * 128 + wc * 32 + n * 16 + fq * 4) = pack4(r);
                        }
                    }
            });
    }
}

DEVI void s5_in_phase(const WS& ws, int j, unsigned char* lds) {
    const bf16_t* A = ws.H(); const bf16_t* Wt = ws.wt_s5in(j); bf16_t* Uc = ws.act();
    for (int t = bid_(); t < 256; t += gridDim.x) {
        const int tm = t & 31, tn = t >> 5;
        gemm_tile(A + (size_t)tm * 256 * DM, DM, Wt + (size_t)tn * 128 * DM, DM, DM, lds,
            [&](f32x4 (&acc)[4][4], int wr, int wc, int fr, int fq) {
#pragma unroll
                for (int i = 0; i < 4; ++i) {
                    const int chunk = tm * 16 + wr * 4 + i;
#pragma unroll
                    for (int n = 0; n < 4; ++n) {
                        const int g = tn * 8 + wc * 4 + n;
                        *(u32x2*)(Uc + ((size_t)chunk * 64 + g) * 256 + fr * 16 + fq * 4) = pack4(acc[i][n]);
                    }
                }
            }, (tm * 5 + tn) & 15);
    }
}

DEVI void s5_chunk_phase(PP p, const WS& ws, int j, unsigned char* lds) {
    const bf16_t* Uc = ws.act(); bf16_t* Yi = (bf16_t*)ws.T(); bf16_t* Ss = ws.bufb();
    for (int it0 = bid_(); it0 < 512; it0 += gridDim.x) {
        const int it = it0 < 256 ? it0 : (it0 ^ 2);
        const int g = it >> 3, ct = (it >> 2) & 1, mt = it & 3;
        gemm_tile(Uc + ((size_t)ct * 256 * 64 + g) * 256, 16384, ws.mg(j, g) + (size_t)mt * 128 * 256, 256, 256, lds,
            [&](f32x4 (&acc)[4][4], int wr, int wc, int fr, int fq) {
                if (mt < 2) {
#pragma unroll
                    for (int i = 0; i < 4; ++i) {
                        const int chunk = ct * 256 + wr * 64 + i * 16 + fr;
#pragma unroll
                        for (int n = 0; n < 4; ++n) { const int tt = mt * 8 + wc * 4 + n; *(u32x2*)(Yi + (size_t)(chunk * 16 + tt) * DM + g * 16 + fq * 4) = pack4(acc[i][n]); }
                    }
                } else {
                    const int dir = mt - 2, tid = (wr * 2 + wc) * 64 + fq * 16 + fr;
                    float* sl = (float*)lds;
                    __syncthreads();
#pragma unroll
                    for (int i = 0; i < 4; ++i)
#pragma unroll
                        for (int n = 0; n < 4; ++n) *(f32x4*)(sl + (wr * 64 + i * 16 + fr) * 128 + wc * 64 + n * 16 + fq * 4) = acc[i][n];
                    __syncthreads();
                    const int nchain = ct == 0 ? 1024 : 256, n = ct == 0 ? 16 : 64;
                    for (int c = tid; c < nchain; c += NTHR) {
                        const int b = c >> 6, pp = c & 63, base = b * n;
                        const float* l16 = ws.lam16() + ((size_t)((j * 2 + dir) * 64 + g) * 64 + pp) * 2;
                        const float lr = l16[0], li = l16[1];
                        float sr = 0.f, si = 0.f;
                        const size_t so = ((((size_t)(b * 2 + j) * 2 + dir) * 2 + 0) * 64 + g) * 64 + pp;
                        if (ct == 1) { sr = p->in[5][so]; si = p->in[5][so + 4096]; }
                        for (int q = 0; q < n; ++q) {
                            const int lc = dir == 0 ? base + q : base + n - 1 - q;
                            const size_t o = ((size_t)(ct * 256 + lc) * 64 + g) * 256 + dir * 128 + pp;
                            Ss[o] = (bf16_t)(cvt_pk(sr, sr) & 0xffffu); Ss[o + 64] = (bf16_t)(cvt_pk(si, si) & 0xffffu);
                            const float ar = sl[lc * 128 + pp], ai = sl[lc * 128 + 64 + pp];
                            const float nr = lr * sr - li * si + ar; si = lr * si + li * sr + ai; sr = nr;
                        }
                        if (ct == 0) { p->out[OUT_S + so] = sr; p->out[OUT_S + so + 4096] = si; }
                    }
                }
            });
    }
}

DEVI void s5_y_phase(const WS& ws, int j, unsigned char* lds) {
    const bf16_t* Ss = ws.bufb(); const bf16_t* Yi = (const bf16_t*)ws.T(); bf16_t* Z = ws.bufa();
    for (int it = bid_(); it < 256; it += gridDim.x) {
        const int g = it >> 2, ct = (it >> 1) & 1, mt = it & 1;
        gemm_tile(Ss + ((size_t)ct * 256 * 64 + g) * 256, 16384, ws.vg(j, g) + (size_t)mt * 128 * 256, 256, 256, lds,
            [&](f32x4 (&acc)[4][4], int wr, int wc, int fr, int fq) {
#pragma unroll
                for (int i = 0; i < 4; ++i) {
                    const int chunk = ct * 256 + wr * 64 + i * 16 + fr;
#pragma unroll
                    for (int n = 0; n < 4; ++n) {
                        const int tt = mt * 8 + wc * 4 + n;
                        const size_t o = (size_t)(chunk * 16 + tt) * DM + g * 16 + fq * 4;
                        const u32x2 yu = *(const u32x2*)(Yi + o);
                        f32x4 y = acc[i][n]; y.x += __uint_as_float(yu.x << 16); y.y += __uint_as_float(yu.x & 0xffff0000u); y.z += __uint_as_float(yu.y << 16); y.w += __uint_as_float(yu.y & 0xffff0000u);
                        f32x4 z; z.x = gelu_tanh(y.x); z.y = gelu_tanh(y.y); z.z = gelu_tanh(y.z); z.w = gelu_tanh(y.w);
                        *(u32x2*)(Z + o) = pack4(z);
                    }
                }
            });
    }
}

DEVI void qkv_phase(PP p, const WS& ws, int j, unsigned char* lds) {
    const bf16_t* A = ws.H(); const bf16_t* Wt = ws.wt_qkv(j);
    for (int t = bid_(); t < 32 * 6; t += gridDim.x) {
        const int tm = t & 31, tn = t >> 5;
        if (tn == 5) {
            gemm_tile8p<false>(A + (size_t)tm * 256 * DM, Wt + (size_t)tn * 256 * DM, DM, lds,
                [&](f32x4 (&acc)[2][2][4][2], int wr, int wc, int fr, int fq) {
                    const bool sample = tm >= 16;
                    const int b = sample ? (tm - 16) >> 2 : tm;
                    const int lq = sample ? ((tm - 16) & 3) * 256 : 0, skv = sample ? 1536 : 256;
#pragma unroll
                    for (int bj = 0; bj < 2; ++bj) {
                        bf16_t* vt = (sample ? ws.vts(j) : ws.vtp()) + (size_t)(b * 2 + bj) * 128 * skv;
#pragma unroll
                        for (int n = 0; n < 2; ++n) {
                            const int d = (wc >> 1) * 64 + n * 32 + (wc & 1) * 16 + fr;
#pragma unroll
                            for (int ai = 0; ai < 2; ++ai)
#pragma unroll
                                for (int m = 0; m < 4; ++m) {
                                    const int l = lq + ai * 128 + wr * 64 + m * 16 + fq * 4;
                                    *(u32x2*)(vt + (size_t)d * skv + l) = pack4(acc[ai][bj][m][n]);
                                    if (!sample) { float* o = p->out + OUT_V + ((((size_t)b * 2 + j) * 256 + l) * 2 + bj) * 128 + d; o[0] = acc[ai][bj][m][n].x; o[256] = acc[ai][bj][m][n].y; o[512] = acc[ai][bj][m][n].z; o[768] = acc[ai][bj][m][n].w; }
                                }
                        }
                    }
                });
            continue;
        }
        gemm_tile8p(A + (size_t)tm * 256 * DM, Wt + (size_t)tn * 256 * DM, DM, lds,
            [&](f32x4 (&acc)[2][2][4][2], int wr, int wc, int fr, int fq) {
                const bool sample = tm >= 16;
                const int b = sample ? (tm - 16) >> 2 : tm;
                const int lq = sample ? ((tm - 16) & 3) * 256 : 0;
                const int d0 = (wc >> 1) * 64 + (wc & 1) * 16 + fq * 4;
                {
                    float* red = (float*)(lds + 131072);
#pragma unroll
                    for (int ai = 0; ai < 2; ++ai)
#pragma unroll
                        for (int bj = 0; bj < 2; ++bj)
#pragma unroll
                            for (int m = 0; m < 4; ++m) {
                                const f32x4 u = acc[ai][bj][m][0], v = acc[ai][bj][m][1];
                                float ssq = (u.x * u.x + u.y * u.y) + (u.z * u.z + u.w * u.w) + (v.x * v.x + v.y * v.y) + (v.z * v.z + v.w * v.w);
                                ssq += __shfl_xor(ssq, 16); ssq += __shfl_xor(ssq, 32);
                                if (fq == 0) red[((((ai * 2 + bj) * 2 + wr) * 4 + m) * 16 + fr) * 4 + wc] = ssq;
                            }
                    __syncthreads();
                    const float* gain = (tn < 4 ? p->in[23] : p->in[24]) + j * 128;
                    const f32x4 g0 = *(const f32x4*)(gain + d0), g1 = *(const f32x4*)(gain + d0 + 32);
                    const float* rope = ws.rope();
#pragma unroll
                    for (int ai = 0; ai < 2; ++ai)
#pragma unroll
                        for (int m = 0; m < 4; ++m) {
                            const int rl = ai * 128 + wr * 64 + m * 16 + fr, row = tm * 256 + rl, l = lq + rl;
                            f32x4 r0 = (f32x4){1.f, 0.f, 1.f, 0.f}, r1 = r0;
                            if (sample) { const int pos = (wc >> 1) == 0 ? (l >> 6) : (l & 63); const float* rp = rope + (pos * 32 + (wc & 1) * 16 + fq * 4) * 2; r0 = *(const f32x4*)rp; r1 = *(const f32x4*)(rp + 4); }
#pragma unroll
                            for (int bj = 0; bj < 2; ++bj) {
                                const f32x4 q4 = *(const f32x4*)(red + ((((ai * 2 + bj) * 2 + wr) * 4 + m) * 16 + fr) * 4);
                                const float rstd = 1.f / sqrtf(((q4.x + q4.y) + (q4.z + q4.w)) * (1.f / 128.f) + RMS_EPS);
                                const f32x4 x1 = acc[ai][bj][m][0] * rstd * g0, x2 = acc[ai][bj][m][1] * rstd * g1;
                                f32x4 y1, y2;
                                y1.x = x1.x * r0.x - x2.x * r0.y; y2.x = x2.x * r0.x + x1.x * r0.y;
                                y1.y = x1.y * r0.z - x2.y * r0.w; y2.y = x2.y * r0.z + x1.y * r0.w;
                                y1.z = x1.z * r1.x - x2.z * r1.y; y2.z = x2.z * r1.x + x1.z * r1.y;
                                y1.w = x1.w * r1.z - x2.w * r1.w; y2.w = x2.w * r1.z + x1.w * r1.w;
                                if (tn < 4) {
                                    bf16_t* qp = ws.bufa() + (size_t)row * DM + (tn * 2 + bj) * 128 + d0;
                                    *(u32x2*)qp = pack4(y1); *(u32x2*)(qp + 32) = pack4(y2);
                                } else {
                                    const int kvh = bj;
                                    bf16_t* kp = sample ? ws.ks(j) + ((size_t)(b * 2 + kvh) * 1536 + l) * 128 + d0 : ws.kp() + ((size_t)(b * 2 + kvh) * 256 + l) * 128 + d0;
                                    *(u32x2*)kp = pack4(y1); *(u32x2*)(kp + 32) = pack4(y2);
                                    if (!sample) { float* o = p->out + OUT_K + ((((size_t)b * 2 + j) * 256 + l) * 2 + kvh) * 128 + d0; __builtin_nontemporal_store(y1, (f32x4*)o); __builtin_nontemporal_store(y2, (f32x4*)(o + 32)); }
                                }
                            }
                        }
                }
            });
    }    if (gridDim.x == 256 && bid_() >= 192) {
        const int lo = j == 0 ? WT_A_END : WT_D_END, hi = j == 0 ? WT_B_END : WT_TOT, ib = bid_() - 192;
        if (j == 0) {
            for (int q = ib; q < 128; q += 64) adaln_item(p, ws, 192 + q, lds);
        } else {
            adaln_item(p, ws, 320 + ib, lds);
        }
        wt_all(p, ws, lo + ib, 64, hi, lds);
    }
}

constexpr int AT_KROW = 288, AT_VROW = 288, AT_KB = 64 * AT_KROW, AT_VB = 128 * AT_VROW, AT_STAGE = AT_KB + AT_VB;
DEVI void attn_phase(const WS& ws, int j, unsigned char* lds) {
    const int tid = tid_(), lane = tid & 63, w = tid >> 6, fr = lane & 15, fq = lane >> 4;
    const bf16_t* Q = ws.bufa(); bf16_t* AO = ws.bufb();
    for (int it = bid_(); it < 512; it += gridDim.x) {
        int b, h, qb, skv, row0; const bf16_t *Kb, *Vb;
        if (it < 256) { b = it >> 6; h = (it >> 3) & 7; qb = it & 7; skv = 1536; row0 = NPR + b * 1024 + qb * 128;
            Kb = ws.ks(j) + (size_t)(b * 2 + (h >> 2)) * 1536 * 128; Vb = ws.vts(j) + (size_t)(b * 2 + (h >> 2)) * 128 * 1536; }
        else { const int i2 = it - 256; b = i2 >> 4; h = (i2 >> 1) & 7; qb = i2 & 1; skv = 256; row0 = b * 256 + qb * 128;
            Kb = ws.kp() + (size_t)(b * 2 + (h >> 2)) * 256 * 128; Vb = ws.vtp() + (size_t)(b * 2 + (h >> 2)) * 128 * 256; }
        const int qrow = row0 + w * 16 + fr;
        bf16x8 qf[4];
#pragma unroll
        for (int s = 0; s < 4; ++s) qf[s] = *(const bf16x8*)(Q + (size_t)qrow * DM + h * 128 + s * 32 + fq * 8);
        f32x4 o[8];
#pragma unroll
        for (int m = 0; m < 8; ++m) o[m] = (f32x4){0.f, 0.f, 0.f, 0.f};
        float mrun = -1e30f, lrun = 0.f;
        const int kr0 = tid >> 4, kc = tid & 15;
        const int vr0 = tid >> 3, vc = tid & 7;
        const int vs = vc >> 2, vu = vc & 3;
        const int vslot_lo = vs * 32 + (2 * (vu & 1)) * 8 + (vu >> 1) * 4, vslot_hi = vslot_lo + 8;
        const bf16_t* gk = Kb + (size_t)kr0 * 128 + kc * 8;
        const bf16_t* gv = Vb + (size_t)vr0 * skv + vc * 8;
        u32x4 rk[2], rv[2];
        const int nt = skv >> 6;
        rk[0] = *(const u32x4*)(gk); rk[1] = *(const u32x4*)(gk + 32 * 128);
        rv[0] = *(const u32x4*)(gv); rv[1] = *(const u32x4*)(gv + (size_t)64 * skv);
        {
            unsigned char* sk = lds; unsigned char* sv = lds + AT_KB;
            *(u32x4*)(sk + kr0 * AT_KROW + kc * 16) = rk[0]; *(u32x4*)(sk + (kr0 + 32) * AT_KROW + kc * 16) = rk[1];
#pragma unroll
            for (int q = 0; q < 2; ++q) {
                unsigned char* r = sv + (vr0 + 64 * q) * AT_VROW;
                u32x2 lo; lo.x = rv[q].x; lo.y = rv[q].y; u32x2 hi; hi.x = rv[q].z; hi.y = rv[q].w;
                *(u32x2*)(r + vslot_lo * 2) = lo; *(u32x2*)(r + vslot_hi * 2) = hi;
            }
        }
        __syncthreads();
        for (int kt = 0; kt < nt; ++kt) {
            const bool more = kt + 1 < nt;
            if (more) {
                const int k0 = (kt + 1) * 64;
                rk[0] = *(const u32x4*)(gk + (size_t)k0 * 128); rk[1] = *(const u32x4*)(gk + (size_t)(k0 + 32) * 128);
                rv[0] = *(const u32x4*)(gv + k0); rv[1] = *(const u32x4*)(gv + (size_t)64 * skv + k0);
            }
            const unsigned char* sk = lds + (kt & 1) * AT_STAGE; const unsigned char* sv = sk + AT_KB;
            f32x4 sc[4];
#pragma unroll
            for (int t = 0; t < 4; ++t) {
                sc[t] = (f32x4){0.f, 0.f, 0.f, 0.f};
#pragma unroll
                for (int s = 0; s < 4; ++s) {
                    const bf16x8 kf = *(const bf16x8*)(sk + (t * 16 + fr) * AT_KROW + s * 64 + fq * 16);
                    sc[t] = __builtin_amdgcn_mfma_f32_16x16x32_bf16(kf, qf[s], sc[t], 0, 0, 0);
                }
            }
            bf16x8 vfr[8][2];
#pragma unroll
            for (int m = 0; m < 8; ++m)
#pragma unroll
                for (int s = 0; s < 2; ++s) vfr[m][s] = *(const bf16x8*)(sv + (m * 16 + fr) * AT_VROW + s * 64 + fq * 16);
            float mx = sc[0].x;
#pragma unroll
            for (int t = 0; t < 4; ++t) mx = fmaxf(fmaxf(fmaxf(mx, sc[t].x), fmaxf(sc[t].y, sc[t].z)), sc[t].w);
            mx = fmaxf(mx, __shfl_xor(mx, 16)); mx = fmaxf(mx, __shfl_xor(mx, 32));
            const float mnew = fmaxf(mrun, mx);
            const float alpha = __builtin_amdgcn_exp2f((mrun - mnew) * SM_C);
            mrun = mnew;
            const float mb = -mnew * SM_C;
            float ls = 0.f;
#pragma unroll
            for (int t = 0; t < 4; ++t) {
                sc[t].x = __builtin_amdgcn_exp2f(sc[t].x * SM_C + mb); sc[t].y = __builtin_amdgcn_exp2f(sc[t].y * SM_C + mb);
                sc[t].z = __builtin_amdgcn_exp2f(sc[t].z * SM_C + mb); sc[t].w = __builtin_amdgcn_exp2f(sc[t].w * SM_C + mb);
                ls += (sc[t].x + sc[t].y) + (sc[t].z + sc[t].w);
            }
            lrun = lrun * alpha + ls;
#pragma unroll
            for (int m = 0; m < 8; ++m) o[m] = o[m] * alpha;
            bf16x8 pf[2];
#pragma unroll
            for (int s = 0; s < 2; ++s) {
                u32x4 u; u.x = cvt_pk(sc[2 * s].x, sc[2 * s].y); u.y = cvt_pk(sc[2 * s].z, sc[2 * s].w);
                u.z = cvt_pk(sc[2 * s + 1].x, sc[2 * s + 1].y); u.w = cvt_pk(sc[2 * s + 1].z, sc[2 * s + 1].w);
                pf[s] = __builtin_bit_cast(bf16x8, u);
            }
#pragma unroll
            for (int m = 0; m < 8; ++m)
#pragma unroll
                for (int s = 0; s < 2; ++s) o[m] = __builtin_amdgcn_mfma_f32_16x16x32_bf16(vfr[m][s], pf[s], o[m], 0, 0, 0);
            if (more) {
                unsigned char* wk = lds + ((kt + 1) & 1) * AT_STAGE; unsigned char* wv = wk + AT_KB;
                *(u32x4*)(wk + kr0 * AT_KROW + kc * 16) = rk[0]; *(u32x4*)(wk + (kr0 + 32) * AT_KROW + kc * 16) = rk[1];
#pragma unroll
                for (int q = 0; q < 2; ++q) {
                    unsigned char* r = wv + (vr0 + 64 * q) * AT_VROW;
                    u32x2 lo; lo.x = rv[q].x; lo.y = rv[q].y; u32x2 hi; hi.x = rv[q].z; hi.y = rv[q].w;
                    *(u32x2*)(r + vslot_lo * 2) = lo; *(u32x2*)(r + vslot_hi * 2) = hi;
                }
            }
            __syncthreads();
        }
        float l = lrun; l += __shfl_xor(l, 16); l += __shfl_xor(l, 32);
        const float inv = 1.f / l;
#pragma unroll
        for (int m = 0; m < 8; ++m) *(u32x2*)(AO + (size_t)qrow * DM + h * 128 + m * 16 + fq * 4) = pack4(o[m] * inv);
    }
}

constexpr int N_PHASES = 1 + 7 + 5 + 7 + 5;
#ifndef REP_FFNIN
#define REP_FFNIN 1
#endif
#ifndef REP_ATTN
#define REP_ATTN 1
#endif
#ifndef REP_PREP
#define REP_PREP 1
#endif
#ifndef DBG_N
#define DBG_N 1000
#endif
DEVI void run_phase(PP p, const WS& ws, int ph, unsigned char* lds) {
    if (ph == 0) { for (int rep = 0; rep < REP_PREP; ++rep) prep_a(p, ws, lds); return; }
    int r = ph - 1, layer = 0;
    if (r >= 7) { r -= 7; layer = 1; if (r >= 5) { r -= 5; layer = 2; if (r >= 7) { r -= 7; layer = 3; } } }
    const int j = layer >> 1;
    const bool s5 = (layer & 1) == 0;
    const float* xlo = layer == 0 ? p->in[0] : ws.X();
    const float* xhi = layer == 0 ? p->in[1] : ws.X() + (size_t)NPR * DM;
    int k = r;
    if (s5) {
        if (r == 0) { s5_in_phase(ws, j, lds); return; }
        if (r == 1) { s5_chunk_phase(p, ws, j, lds); return; }
        if (r == 2) { s5_y_phase(ws, j, lds); return; }
        if (r == 3) { glu_phase(ws, j, lds); return; }
        k = r - 4;
        if (k == 0) { out_ln_gemm_phase(p, ws, ws.bufb(), DM, ws.wt_s5out(j), layer, 0, xlo, xhi, layer == 0, lds); return; }
    } else {
        if (r == 0) { qkv_phase(p, ws, j, lds); return; }
        if (r == 1) { for (int rep = 0; rep < REP_ATTN; ++rep) attn_phase(ws, j, lds); return; }
        k = r - 2;
        if (k == 0) { out_ln_gemm_phase(p, ws, ws.bufb(), DM, ws.wt_o(j), layer, 0, xlo, xhi, layer == 0, lds); return; }
    }
    if (k == 1) { for (int rep = 0; rep < REP_FFNIN; ++rep) ffn_in_phase(p, ws, layer, lds); return; }
    out_ln_gemm_phase(p, ws, ws.act(), DFF, ws.wt_ffnout(layer), layer, 1, xlo, xhi, false, lds);
}

__global__ void __launch_bounds__(NTHR) mega(Params p_) {
    extern __shared__ __attribute__((aligned(16))) unsigned char lds[];
    volatile LAS unsigned* xbw = (volatile LAS unsigned*)(LAS unsigned char*)(lds + LDS_XB);
    if (threadIdx.x < 4) xbw[threadIdx.x] = 0u;
    __syncthreads();
    const int ph_lo = p_.ph_lo, ph_hi = p_.ph_hi;
    XcdBarrier xb = xcd_barrier_post((unsigned*)(p_.ws + WS_BAR), xbw);
    for (int ph = ph_lo; ph < ph_hi; ++ph) {
        {
            PP p = (PP)__builtin_amdgcn_kernarg_segment_ptr();
            asm volatile("" : "+s"(p));
            WS ws; ws.b = p->ws;
            run_phase(p, ws, ph, lds);
#ifdef DBG_TWICE
            if (ph == 2) { xcd_barrier(xb); run_phase(p, ws, ph, lds); }
#endif
        }
        if (ph + 1 < ph_hi) {
#if USE_CG
            cg::this_grid().sync();
#else
            if (ph_hi < 0) cg::this_grid().sync();
            xcd_barrier(xb);
#endif
        }
    }
}

extern "C" void kernel_launch(void* const* d_in, const int* in_sizes, int n_in, void* d_out, int out_size, void* d_ws, size_t ws_size, hipStream_t stream) {
    static int grid = 0;
    if (grid == 0) {
        if (n_in != 28 || ws_size < WS_END) { fprintf(stderr, "kernel_launch: unexpected n_in %d or ws_size %zu (< %zu)\n", n_in, ws_size, (size_t)WS_END); grid = -1; return; }
        int dev = 0, cus = 0, per_cu = 0;
        (void)hipGetDevice(&dev);
        (void)hipDeviceGetAttribute(&cus, hipDeviceAttributeMultiprocessorCount, dev);
        (void)hipFuncSetAttribute((const void*)mega, hipFuncAttributeMaxDynamicSharedMemorySize, LDS_BYTES);
        (void)hipOccupancyMaxActiveBlocksPerMultiprocessor(&per_cu, (const void*)mega, NTHR, LDS_BYTES);
        (void)hipGetLastError();
        if (per_cu < 1) per_cu = 1;
        grid = cus * 1;
    }
    if (grid < 0) return;
    (void)hipMemsetAsync((unsigned char*)d_ws + WS_BAR, 0, 16384, stream);
    Params p{};
    for (int i = 0; i < 28; ++i) p.in[i] = (const float*)d_in[i];
    p.out = (float*)d_out; p.ws = (unsigned char*)d_ws; p.ph_lo = 0; p.ph_hi = N_PHASES;
    void* args[] = {&p};
    hipError_t e = hipLaunchCooperativeKernel((const void*)mega, dim3(grid), dim3(NTHR), args, LDS_BYTES, stream);
    if (e != hipSuccess) fprintf(stderr, "cooperative launch failed: %s (grid %d)\n", hipGetErrorString(e), grid);
}
```

```cpp
#include <hip/hip_runtime.h>
#include <hip/hip_cooperative_groups.h>
#include <cstdio>
#include <cstdint>
namespace cg = cooperative_groups;

#define DEVI __device__ __forceinline__
#define LAS __attribute__((address_space(3)))
typedef unsigned short bf16_t;
typedef short bf16x8 __attribute__((ext_vector_type(8)));
typedef float f32x4 __attribute__((ext_vector_type(4)));
typedef float f32x2 __attribute__((ext_vector_type(2)));
typedef unsigned u32x4 __attribute__((ext_vector_type(4)));
typedef unsigned u32x2 __attribute__((ext_vector_type(2)));

constexpr int DM = 1024, NROW = 8192, NPR = 4096, DFF = 2816;
constexpr float ALPHA = 1.681792830507429f;
constexpr float LN_EPS = 1e-6f, RMS_EPS = 1e-6f;
constexpr float SM_C = 0.08838834764831845f * 1.4426950408889634f;

constexpr size_t OUT_Y = 0, OUT_K = 8388608, OUT_V = 10485760, OUT_S = 12582912;

constexpr size_t al256(size_t x) { return (x + 255) & ~(size_t)255; }
constexpr size_t WS_BAR = 0;
constexpr size_t WS_WT_S5IN = 16384;
constexpr size_t WS_WT_GLU = WS_WT_S5IN + 2ull * 1024 * 1024 * 2;
constexpr size_t WS_WT_S5OUT = WS_WT_GLU + 2ull * 2048 * 1024 * 2;
constexpr size_t WS_WT_QKV = WS_WT_S5OUT + 2ull * 1024 * 1024 * 2;
constexpr size_t WS_WT_O = WS_WT_QKV + 2ull * 1536 * 1024 * 2;
constexpr size_t WS_WT_FFNIN = WS_WT_O + 2ull * 1024 * 1024 * 2;
constexpr size_t WS_WT_FFNOUT = WS_WT_FFNIN + 4ull * 5632 * 1024 * 2;
constexpr size_t WS_MG = WS_WT_FFNOUT + 4ull * 1024 * 2816 * 2;
constexpr size_t WS_VG = WS_MG + 2ull * 64 * 512 * 256 * 2;
constexpr size_t WS_LAM16 = WS_VG + 2ull * 64 * 256 * 256 * 2;
constexpr size_t WS_MOD = WS_LAM16 + 2ull * 2 * 64 * 64 * 2 * 4;
constexpr size_t WS_ROPE = WS_MOD + al256(4ull * 5 * 6144 * 4);
constexpr size_t WS_KS = WS_ROPE + 64ull * 32 * 2 * 4;
constexpr size_t KS_LAYER = 4ull * 2 * 1536 * 128 * 2;
constexpr size_t WS_VTS = WS_KS + 2 * KS_LAYER;
constexpr size_t WS_KP = WS_VTS + 2 * KS_LAYER;
constexpr size_t WS_VTP = WS_KP + 16ull * 2 * 256 * 128 * 2;
constexpr size_t WS_X = WS_VTP + 16ull * 2 * 256 * 128 * 2;
constexpr size_t WS_T = WS_X + (size_t)NROW * DM * 4;
constexpr size_t WS_H = WS_T + (size_t)NROW * DM * 4;
constexpr size_t WS_BUFA = WS_H + (size_t)NROW * DM * 2;
constexpr size_t WS_BUFB = WS_BUFA + (size_t)NROW * DM * 2;
constexpr size_t WS_ACT = WS_BUFB + (size_t)NROW * DM * 2;
constexpr size_t WS_SL = WS_ACT + (size_t)NROW * DFF * 2;
constexpr size_t WS_PART = WS_SL + (size_t)NROW * DM * 4;
constexpr size_t WS_END = WS_PART + 8 * (size_t)NROW * 16 * 2 * 4;

constexpr int NTHR = 512;
constexpr int LROW = 144;
constexpr int A_TILE_B = 256 * LROW, B_TILE_B = 128 * LROW, STAGE_B = A_TILE_B + B_TILE_B;
constexpr int LDS_RED = 3 * (256 * 128 + 128 * 128);
constexpr int LDS_XB = LDS_RED + 4096;
constexpr int LDS_BYTES = LDS_XB + 64;

struct Params {
    const float* in[28];
    float* out;
    unsigned char* ws;
    int ph_lo, ph_hi;
};
typedef const __attribute__((address_space(4))) Params* PP;

typedef __bf16 bf16v2 __attribute__((ext_vector_type(2)));
DEVI unsigned cvt_pk(float lo, float hi) { f32x2 v = {lo, hi}; bf16v2 b = __builtin_convertvector(v, bf16v2); return __builtin_bit_cast(unsigned, b); }
DEVI u32x2 pack4(f32x4 v) { u32x2 r; r.x = cvt_pk(v.x, v.y); r.y = cvt_pk(v.z, v.w); return r; }
DEVI float sigmoidf_(float x) { return 1.f / (1.f + __expf(-x)); }
DEVI float siluf_(float x) { return x / (1.f + __expf(-x)); }
DEVI float gelu_tanh(float y) { const float a = 0.7978845608028654f * (y + 0.044715f * y * y * y); const float th = 1.f - 2.f / (__expf(2.f * a) + 1.f); return 0.5f * y * (1.f + th); }

#define XB_TMO      128
#define XB_XCNT(j)  (256  + 64 * (j))
#define XB_XSUB(j)  (1280 + 64 * (j))
#define XB_XGEN(j)  (2304 + 64 * (j))
#define XB_TOP      3328
#define XB_TOPGEN   3392
#define XCD_BAR_WORDS 3456
#define XB_SPIN_CAP (1u << 22)
#define WAITV(n) asm volatile("s_waitcnt vmcnt(" #n ")" ::: "memory")
DEVI unsigned xb_ld(unsigned* p)              { return __hip_atomic_load(p, __ATOMIC_RELAXED, __HIP_MEMORY_SCOPE_AGENT); }
DEVI unsigned xb_add(unsigned* p, unsigned v) { return __hip_atomic_fetch_add(p, v, __ATOMIC_RELAXED, __HIP_MEMORY_SCOPE_AGENT); }
DEVI unsigned xb_xcc_id() { return (unsigned)__builtin_amdgcn_s_getreg((3 << 11) | 20) & 0xFu; }
#define XB_SPIN(cond, bar) do { unsigned _sp = 0; while (cond) { __builtin_amdgcn_s_sleep(1); \
    if ((++_sp & 255u) == 0u) { if (xb_ld(&(bar)[XB_TMO])) break; if (_sp > XB_SPIN_CAP) { atomicAdd(&(bar)[XB_TMO], 1u); break; } } } } while (0)
struct XcdBarrier { unsigned* bar; unsigned x; volatile LAS unsigned* st; };
DEVI XcdBarrier xcd_barrier_post(unsigned* bar, volatile LAS unsigned* st) {
    XcdBarrier b; b.bar = bar; b.x = xb_xcc_id(); b.st = st;
    if (threadIdx.x == 0) (void)xb_add(&bar[XB_XCNT(b.x)], 1u);
    return b;
}
DEVI void xcd_barrier_complete(unsigned* bar, unsigned x, unsigned& nloc, unsigned& nx) {
    const unsigned G = gridDim.x * gridDim.y * gridDim.z;
    unsigned sum, cnt, mine, sp = 0u;
    for (;;) {
        sum = 0u; cnt = 0u; mine = 0u;
#pragma unroll
        for (unsigned j = 0; j < 16; ++j) { const unsigned c = xb_ld(&bar[XB_XCNT(j)]); sum += c; cnt += (c > 0u) ? 1u : 0u; mine = (j == x) ? c : mine; }
        if (sum == G) break;
        __builtin_amdgcn_s_sleep(1);
        if ((++sp & 255u) == 0u) { if (xb_ld(&bar[XB_TMO])) break; if (sp > XB_SPIN_CAP) { atomicAdd(&bar[XB_TMO], 1u); break; } }
    }
    nloc = mine > 0u ? mine : 1u; nx = cnt > 0u ? cnt : 1u;
}
DEVI void xcd_barrier(const XcdBarrier& b) {
    asm volatile("s_waitcnt vmcnt(0)" ::: "memory");
    __syncthreads();
    if (threadIdx.x == 0) {
        unsigned* bar = b.bar;
        __builtin_amdgcn_s_waitcnt(0);
        unsigned nloc = b.st[0], nx = b.st[1];
        if (nloc == 0u) { xcd_barrier_complete(bar, b.x, nloc, nx); b.st[0] = nloc; b.st[1] = nx; }
        const unsigned old = xb_add(&bar[XB_XSUB(b.x)], 1u);
        const unsigned gen = old / nloc;
        if (old + 1u == (gen + 1u) * nloc) {
            __builtin_amdgcn_fence(__ATOMIC_RELEASE, "agent");
            asm volatile("s_waitcnt vmcnt(0)" ::: "memory");
            const unsigned og = xb_add(&bar[XB_TOP], 1u);
            const unsigned tg = og / nx;
            if (og + 1u == (tg + 1u) * nx) xb_add(&bar[XB_TOPGEN], 1u);
            else XB_SPIN(xb_ld(&bar[XB_TOPGEN]) == tg, bar);
            __builtin_amdgcn_fence(__ATOMIC_ACQUIRE, "agent");
            xb_add(&bar[XB_XGEN(b.x)], 1u);
            asm volatile("s_waitcnt vmcnt(0)" ::: "memory");
        } else {
            XB_SPIN(xb_ld(&bar[XB_XGEN(b.x)]) == gen, bar);
            __builtin_amdgcn_fence(__ATOMIC_ACQUIRE, "agent");
            asm volatile("s_waitcnt vmcnt(0)" ::: "memory");
        }
    }
    __syncthreads();
}

DEVI int tid_() { int t = threadIdx.x; asm volatile("" : "+v"(t)); return t; }
DEVI int bid_() { int b = blockIdx.x; asm volatile("" : "+s"(b)); return b; }
#ifndef PF_DIST
#define PF_DIST 2
#endif
constexpr int GA_B = 256 * 128, GB_B = 128 * 128, GSTAGE = GA_B + GB_B, GNST = 3;
template <class Epi>
DEVI void gemm_tile(const bf16_t* __restrict__ A, size_t lda, const bf16_t* __restrict__ Bt, size_t ldb, int K, unsigned char* lds, Epi epi, int koff = 0) {
    const int tid = tid_(), lane = tid & 63, w = tid >> 6, wr = w >> 1, wc = w & 1, fr = lane & 15, fq = lane >> 4;
    f32x4 acc[4][4];
#pragma unroll
    for (int i = 0; i < 4; ++i)
#pragma unroll
        for (int n = 0; n < 4; ++n) acc[i][n] = (f32x4){0.f, 0.f, 0.f, 0.f};
    const int lr8 = lane >> 3, pch = lane & 7;
    const bf16_t* ga[4]; const bf16_t* gb[2];
#pragma unroll
    for (int i = 0; i < 4; ++i) { const int row = (i * 8 + w) * 8 + lr8; ga[i] = A + (size_t)row * lda + ((pch ^ ((row >> 1) & 7)) * 8); }
#pragma unroll
    for (int i = 0; i < 2; ++i) { const int row = (i * 8 + w) * 8 + lr8; gb[i] = Bt + (size_t)row * ldb + ((pch ^ ((row >> 1) & 7)) * 8); }
    const int dofs = w * 1024 + lane * 16;
    const int nk = K >> 6;
    const unsigned ldsbase = (unsigned)(uintptr_t)(LAS unsigned char*)lds;
    const int sx = fr >> 1;
    const int aofs0 = (wr * 64 + fr) * 128 + ((fq ^ sx) * 16), aofs1 = (wr * 64 + fr) * 128 + (((4 + fq) ^ sx) * 16);
    const int bofs0 = GA_B + (wc * 64 + fr) * 128 + ((fq ^ sx) * 16), bofs1 = GA_B + (wc * 64 + fr) * 128 + (((4 + fq) ^ sx) * 16);
#define GEMM_ISSUE(stage, kt_) do { unsigned char* _sb = lds + (stage) * GSTAGE + dofs; int _kk = (kt_) + koff; if (_kk >= nk) _kk -= nk; const int _ko = _kk * 64; \
        _Pragma("unroll") for (int _i = 0; _i < 4; ++_i) __builtin_amdgcn_global_load_lds((const unsigned*)(ga[_i] + _ko), (LAS unsigned*)(LAS unsigned char*)(_sb + _i * 8192), 16, 0, 0); \
        _Pragma("unroll") for (int _i = 0; _i < 2; ++_i) __builtin_amdgcn_global_load_lds((const unsigned*)(gb[_i] + _ko), (LAS unsigned*)(LAS unsigned char*)(_sb + GA_B + _i * 8192), 16, 0, 0); } while (0)
    WAITV(0);
    __builtin_amdgcn_s_barrier();
    GEMM_ISSUE(0, 0);
#if PF_DIST == 2
    if (nk > 1) GEMM_ISSUE(1, 1);
#endif
    int st = 0;
    for (int kt = 0; kt < nk; ++kt) {
#if PF_DIST == 2
        if (kt + 1 < nk) WAITV(6); else WAITV(0);
#else
        WAITV(0);
#endif
        __builtin_amdgcn_s_barrier();
        const unsigned sb = ldsbase + st * GSTAGE;
        bf16x8 af[2][4], bfr[2][4];
#define DSR(dst, addr, off) asm volatile("ds_read_b128 %0, %1 offset:%2" : "=v"(dst) : "v"(addr), "n"(off))
        { const unsigned ab0 = sb + bofs0, aa0 = sb + aofs0, ab1 = sb + bofs1, aa1 = sb + aofs1;
          DSR(bfr[0][0], ab0, 0); DSR(bfr[0][1], ab0, 2048); DSR(bfr[0][2], ab0, 4096); DSR(bfr[0][3], ab0, 6144);
          DSR(af[0][0], aa0, 0); DSR(af[0][1], aa0, 2048); DSR(af[0][2], aa0, 4096); DSR(af[0][3], aa0, 6144);
          DSR(bfr[1][0], ab1, 0); DSR(bfr[1][1], ab1, 2048); DSR(bfr[1][2], ab1, 4096); DSR(bfr[1][3], ab1, 6144);
          DSR(af[1][0], aa1, 0); DSR(af[1][1], aa1, 2048); DSR(af[1][2], aa1, 4096);
          asm volatile("s_waitcnt lgkmcnt(7)" : "+v"(bfr[0][0]), "+v"(bfr[0][1]), "+v"(bfr[0][2]), "+v"(bfr[0][3]), "+v"(af[0][0]), "+v"(af[0][1]), "+v"(af[0][2]), "+v"(af[0][3]));
          DSR(af[1][3], aa1, 6144); }
        __builtin_amdgcn_s_setprio(1);
#pragma unroll
        for (int i = 0; i < 4; ++i)
#pragma unroll
            for (int n = 0; n < 4; ++n) acc[i][n] = __builtin_amdgcn_mfma_f32_16x16x32_bf16(bfr[0][n], af[0][i], acc[i][n], 0, 0, 0);
        __builtin_amdgcn_s_setprio(0);
        __builtin_amdgcn_sched_barrier(0);
#if PF_DIST == 2
        if (kt + 2 < nk) { const int s2 = st >= 1 ? st - 1 : 2; GEMM_ISSUE(s2, kt + 2); }
#else
        if (kt + 1 < nk) { const int s2 = st == 2 ? 0 : st + 1; GEMM_ISSUE(s2, kt + 1); }
#endif
        __builtin_amdgcn_sched_barrier(0);
        asm volatile("s_waitcnt lgkmcnt(0)" : "+v"(bfr[1][0]), "+v"(bfr[1][1]), "+v"(bfr[1][2]), "+v"(bfr[1][3]), "+v"(af[1][0]), "+v"(af[1][1]), "+v"(af[1][2]), "+v"(af[1][3]));
        __builtin_amdgcn_s_setprio(1);
#pragma unroll
        for (int i = 0; i < 4; ++i)
#pragma unroll
            for (int n = 0; n < 4; ++n) acc[i][n] = __builtin_amdgcn_mfma_f32_16x16x32_bf16(bfr[1][n], af[1][i], acc[i][n], 0, 0, 0);
        __builtin_amdgcn_s_setprio(0);
        st = st == 2 ? 0 : st + 1;
    }
    epi(acc, wr, wc, fr, fq);
}

constexpr int H_HALF = 256 * 64, HSTAGE = 2 * H_HALF;
template <class Epi>
DEVI void gemm_tile256(const bf16_t* __restrict__ A, size_t lda, const bf16_t* __restrict__ Bt, size_t ldb, int K, unsigned char* lds, Epi epi) {
    const int tid = tid_(), lane = tid & 63, w = tid >> 6, wr = w >> 2, wc = w & 3, fr = lane & 15, fq = lane >> 4;
    f32x4 acc[8][4];
#pragma unroll
    for (int i = 0; i < 8; ++i)
#pragma unroll
        for (int n = 0; n < 4; ++n) acc[i][n] = (f32x4){0.f, 0.f, 0.f, 0.f};
    const int lr4 = lane >> 2, pch = lane & 3;
    const bf16_t* ga[2]; const bf16_t* gb[2];
#pragma unroll
    for (int i = 0; i < 2; ++i) { const int row = (i * 8 + w) * 16 + lr4; const int lch = pch ^ ((0x1320 >> (((row >> 2) & 3) * 4)) & 3); ga[i] = A + (size_t)row * lda + lch * 8; gb[i] = Bt + (size_t)row * ldb + lch * 8; }
    const int dofs = w * 1024 + lane * 16;
    const int nk = K >> 5;
    const unsigned ldsbase = (unsigned)(uintptr_t)(LAS unsigned char*)lds;
    const int pcs = (fq ^ ((0x1320 >> (((fr >> 2) & 3) * 4)) & 3)) * 16;
    const int aofs = (wr * 128 + fr) * 64 + pcs, bofs = H_HALF + (wc * 64 + fr) * 64 + pcs;
#define H_ISSUE(stage, kt_) do { unsigned char* _sb = lds + (stage) * HSTAGE + dofs; const int _ko = (kt_) * 32; \
        _Pragma("unroll") for (int _i = 0; _i < 2; ++_i) __builtin_amdgcn_global_load_lds((const unsigned*)(ga[_i] + _ko), (LAS unsigned*)(LAS unsigned char*)(_sb + _i * 8192), 16, 0, 0); \
        _Pragma("unroll") for (int _i = 0; _i < 2; ++_i) __builtin_amdgcn_global_load_lds((const unsigned*)(gb[_i] + _ko), (LAS unsigned*)(LAS unsigned char*)(_sb + H_HALF + _i * 8192), 16, 0, 0); } while (0)
#define DSR2(dst, addr, off) asm volatile("ds_read_b128 %0, %1 offset:%2" : "=v"(dst) : "v"(addr), "n"(off))
    const int wu = __builtin_amdgcn_readfirstlane(w);
    bf16x8 af[8], bfr[4];
#define H_READS(stg) do { const unsigned sa = ldsbase + (stg) * HSTAGE + aofs, sb = ldsbase + (stg) * HSTAGE + bofs; \
        DSR2(bfr[0], sb, 0); DSR2(bfr[1], sb, 1024); DSR2(bfr[2], sb, 2048); DSR2(bfr[3], sb, 3072); \
        DSR2(af[0], sa, 0); DSR2(af[1], sa, 1024); DSR2(af[2], sa, 2048); DSR2(af[3], sa, 3072); \
        DSR2(af[4], sa, 4096); DSR2(af[5], sa, 5120); DSR2(af[6], sa, 6144); DSR2(af[7], sa, 7168); } while (0)
#define H_WAIT_LO(n_) asm volatile("s_waitcnt lgkmcnt(" #n_ ")" : "+v"(bfr[0]), "+v"(bfr[1]), "+v"(bfr[2]), "+v"(bfr[3]), "+v"(af[0]), "+v"(af[1]), "+v"(af[2]), "+v"(af[3]))
#define H_WAIT_HI() asm volatile("s_waitcnt lgkmcnt(0)" : "+v"(af[4]), "+v"(af[5]), "+v"(af[6]), "+v"(af[7]))
#define H_MMA2(i0) do { __builtin_amdgcn_s_setprio(1); \
        _Pragma("unroll") for (int i = (i0); i < (i0) + 2; ++i) _Pragma("unroll") for (int n = 0; n < 4; ++n) acc[i][n] = __builtin_amdgcn_mfma_f32_16x16x32_bf16(bfr[n], af[i], acc[i][n], 0, 0, 0); \
        __builtin_amdgcn_s_setprio(0); __builtin_amdgcn_sched_barrier(0); } while (0)
#define H_PIECE(stage, kt_, j_) do { if ((kt_) < nk) { unsigned char* _sb = lds + (stage) * HSTAGE + dofs; const int _ko = (kt_) * 32; \
        if ((j_) < 2) __builtin_amdgcn_global_load_lds((const unsigned*)(ga[(j_) & 1] + _ko), (LAS unsigned*)(LAS unsigned char*)(_sb + ((j_) & 1) * 8192), 16, 0, 0); \
        else __builtin_amdgcn_global_load_lds((const unsigned*)(gb[(j_) & 1] + _ko), (LAS unsigned*)(LAS unsigned char*)(_sb + H_HALF + ((j_) & 1) * 8192), 16, 0, 0); } \
        __builtin_amdgcn_sched_barrier(0); } while (0)
#define H_SCHED() __builtin_amdgcn_sched_barrier(0)
    WAITV(0);
    __builtin_amdgcn_s_barrier();
    H_ISSUE(0, 0); H_ISSUE(1, 1); H_ISSUE(2, 2);
    if (wu < 4) {
        for (int kt = 0; kt < nk; ++kt) {
            if (kt + 2 < nk) WAITV(8); else if (kt + 1 < nk) WAITV(4); else WAITV(0);
            __builtin_amdgcn_s_barrier();
            const int s3 = (kt + 3) & 3;
            H_READS(kt & 3); H_SCHED();
            H_WAIT_LO(4);
            H_MMA2(0); H_PIECE(s3, kt + 3, 0);
            H_MMA2(2); H_PIECE(s3, kt + 3, 1);
            H_WAIT_HI();
            H_MMA2(4); H_PIECE(s3, kt + 3, 2);
            H_MMA2(6); H_PIECE(s3, kt + 3, 3);
        }
    } else {
        for (int kt = 0; kt < nk; ++kt) {
            if (kt + 2 < nk) WAITV(8); else if (kt + 1 < nk) WAITV(4); else WAITV(0);
            __builtin_amdgcn_s_barrier();
            const int s3 = (kt + 3) & 3;
            if (kt > 0) {
                H_MMA2(0); H_PIECE(s3, kt + 3, 0);
                H_MMA2(2); H_PIECE(s3, kt + 3, 1);
                H_MMA2(4); H_PIECE(s3, kt + 3, 2);
                H_MMA2(6); H_PIECE(s3, kt + 3, 3);
            } else { H_PIECE(s3, kt + 3, 0); H_PIECE(s3, kt + 3, 1); H_PIECE(s3, kt + 3, 2); H_PIECE(s3, kt + 3, 3); }
            H_READS(kt & 3); H_SCHED();
            H_WAIT_LO(0); H_WAIT_HI();
            H_SCHED();
        }
        H_MMA2(0); H_MMA2(2); H_MMA2(4); H_MMA2(6);
    }
    epi(acc, wr, wc, fr, fq);
}

DEVI int p8_lds_byte(int r, int c) { const int st = (r >> 4) * 2 + (c >> 5), rr = r & 15, cc = c & 31, ob = rr * 64 + cc * 2; return st * 1024 + (ob ^ (((ob >> 9) & 1) << 5)); }
DEVI void p8_stage_rc(int b, int& R, int& C) { const int st = b / 1024, sb = b % 1024, swz = sb ^ (((sb >> 9) & 1) << 5); R = (st >> 1) * 16 + swz / 64; C = (st & 1) * 32 + (swz % 64) / 2; }
template <bool SWAP = true, class Epi>
DEVI void gemm_tile8p(const bf16_t* __restrict__ A, const bf16_t* __restrict__ Bt, int K, unsigned char* lds, Epi epi) {
    constexpr int HTB = 128 * 64 * 2;
    const int tid = tid_(), lane = tid & 63, wid = __builtin_amdgcn_readfirstlane(tid >> 6), wr = wid >> 2, wc = wid & 3, fr = lane & 15, fq = lane >> 4;
    f32x4 acc[2][2][4][2];
#pragma unroll
    for (int a_ = 0; a_ < 2; ++a_)
#pragma unroll
        for (int b_ = 0; b_ < 2; ++b_)
#pragma unroll
            for (int m = 0; m < 4; ++m)
#pragma unroll
                for (int n = 0; n < 2; ++n) acc[a_][b_][m][n] = (f32x4){0.f, 0.f, 0.f, 0.f};
    bf16x8 At[4][2], B0[2][2], B1[2][2];
    unsigned voff[2];
#pragma unroll
    for (int i = 0; i < 2; ++i) { int R, C; p8_stage_rc(tid * 16 + i * 8192, R, C); voff[i] = (unsigned)(R * K + C); }
    const int aoff = p8_lds_byte(wr * 64 + fr, fq * 8), boff = p8_lds_byte(wc * 32 + fr, fq * 8);
    const size_t hstep = (size_t)128 * K;
    const int nt = K >> 6;
#define P8_SA(b, h) (((b) * 2 + (h)) * HTB)
#define P8_SB(b, h) ((4 + (b) * 2 + (h)) * HTB)
#define P8_STAGE(bufoff, gbase, kt_) do { _Pragma("unroll") for (int _i = 0; _i < 2; ++_i) \
        __builtin_amdgcn_global_load_lds((const unsigned*)((gbase) + voff[_i] + (size_t)(kt_) * 64), (LAS unsigned*)(LAS unsigned char*)(lds + (bufoff) + tid * 16 + _i * 8192), 16, 0, 0); } while (0)
#define P8_LDA(dst, b, h) do { _Pragma("unroll") for (int m = 0; m < 4; ++m) _Pragma("unroll") for (int k = 0; k < 2; ++k) dst[m][k] = *(const bf16x8*)(lds + P8_SA(b, h) + aoff + m * 2048 + k * 1024); } while (0)
#define P8_LDB(dst, b, h) do { _Pragma("unroll") for (int n = 0; n < 2; ++n) _Pragma("unroll") for (int k = 0; k < 2; ++k) dst[n][k] = *(const bf16x8*)(lds + P8_SB(b, h) + boff + n * 2048 + k * 1024); } while (0)
#define P8_MMA(ai, bj, At_, Bt_) do { __builtin_amdgcn_s_setprio(1); _Pragma("unroll") for (int m = 0; m < 4; ++m) _Pragma("unroll") for (int n = 0; n < 2; ++n) _Pragma("unroll") for (int k = 0; k < 2; ++k) \
        acc[ai][bj][m][n] = SWAP ? __builtin_amdgcn_mfma_f32_16x16x32_bf16(Bt_[n][k], At_[m][k], acc[ai][bj][m][n], 0, 0, 0) : __builtin_amdgcn_mfma_f32_16x16x32_bf16(At_[m][k], Bt_[n][k], acc[ai][bj][m][n], 0, 0, 0); __builtin_amdgcn_s_setprio(0); } while (0)
#define P8_WAIT_L(n) asm volatile("s_waitcnt lgkmcnt(" #n ")" ::: "memory")
#define P8_BAR __builtin_amdgcn_s_barrier()
#define P8_SCHED __builtin_amdgcn_sched_barrier(0)
    const bf16_t* cA = A; const bf16_t* cB = Bt;
    WAITV(0);
    P8_BAR;
    P8_STAGE(P8_SB(0, 0), cB, 0); P8_STAGE(P8_SA(0, 0), cA, 0); P8_STAGE(P8_SB(0, 1), cB + hstep, 0); P8_STAGE(P8_SA(0, 1), cA + hstep, 0);
    if (wr == 1) P8_BAR;
    WAITV(4); P8_BAR;
    P8_STAGE(P8_SB(1, 0), cB, 1); P8_STAGE(P8_SA(1, 0), cA, 1); P8_STAGE(P8_SB(1, 1), cB + hstep, 1);
    WAITV(6); P8_BAR;
    for (int t = 0; t < nt - 2; t += 2) {
        P8_LDB(B0, 0, 0); P8_SCHED; P8_LDA(At, 0, 0); P8_STAGE(P8_SA(1, 1), cA + hstep, t + 1);
        P8_WAIT_L(8); P8_BAR; P8_WAIT_L(0); P8_MMA(0, 0, At, B0); P8_BAR; P8_SCHED;
        P8_LDB(B1, 0, 1); P8_STAGE(P8_SB(0, 0), cB, t + 2);
        P8_BAR; P8_WAIT_L(0); P8_MMA(0, 1, At, B1); P8_BAR;
        P8_LDA(At, 0, 1); P8_STAGE(P8_SA(0, 0), cA, t + 2);
        P8_BAR; P8_WAIT_L(0); P8_MMA(1, 0, At, B0); P8_BAR; P8_SCHED;
        P8_STAGE(P8_SB(0, 1), cB + hstep, t + 2);
        WAITV(6); P8_BAR; P8_MMA(1, 1, At, B1); P8_BAR;
        P8_LDB(B0, 1, 0); P8_SCHED; P8_LDA(At, 1, 0); P8_STAGE(P8_SA(0, 1), cA + hstep, t + 2);
        P8_WAIT_L(8); P8_BAR; P8_WAIT_L(0); P8_MMA(0, 0, At, B0); P8_BAR; P8_SCHED;
        P8_LDB(B1, 1, 1); P8_STAGE(P8_SB(1, 0), cB, t + 3);
        P8_BAR; P8_WAIT_L(0); P8_MMA(0, 1, At, B1); P8_BAR;
        P8_LDA(At, 1, 1); P8_STAGE(P8_SA(1, 0), cA, t + 3);
        P8_BAR; P8_WAIT_L(0); P8_MMA(1, 0, At, B0); P8_BAR; P8_SCHED;
        P8_STAGE(P8_SB(1, 1), cB + hstep, t + 3);
        WAITV(6); P8_BAR; P8_MMA(1, 1, At, B1); P8_BAR;
    }
    { P8_LDB(B0, 0, 0); P8_LDA(At, 0, 0); P8_STAGE(P8_SA(1, 1), cA + hstep, nt - 1);
      P8_BAR; P8_WAIT_L(0); P8_MMA(0, 0, At, B0); P8_BAR;
      P8_LDB(B1, 0, 1); P8_BAR; P8_WAIT_L(0); P8_MMA(0, 1, At, B1); P8_BAR;
      P8_LDA(At, 0, 1); WAITV(4); P8_BAR; P8_WAIT_L(0); P8_MMA(1, 0, At, B0); P8_MMA(1, 1, At, B1); P8_BAR; }
    { P8_LDB(B0, 1, 0); P8_LDA(At, 1, 0); WAITV(2); P8_BAR; P8_WAIT_L(0); P8_MMA(0, 0, At, B0); P8_BAR;
      P8_LDB(B1, 1, 1); WAITV(0); P8_BAR; P8_WAIT_L(0); P8_MMA(0, 1, At, B1); P8_BAR;
      P8_LDA(At, 1, 1); P8_BAR; P8_WAIT_L(0); P8_MMA(1, 0, At, B0); P8_MMA(1, 1, At, B1); P8_BAR; }
    if (wr == 0) P8_BAR;
    epi(acc, wr, wc, fr, fq);
}

struct WS {
    unsigned char* b;
    DEVI bf16_t* wt_s5in(int j) const { return (bf16_t*)(b + WS_WT_S5IN) + (size_t)j * 1024 * 1024; }
    DEVI bf16_t* wt_glu(int j) const { return (bf16_t*)(b + WS_WT_GLU) + (size_t)j * 2048 * 1024; }
    DEVI bf16_t* wt_s5out(int j) const { return (bf16_t*)(b + WS_WT_S5OUT) + (size_t)j * 1024 * 1024; }
    DEVI bf16_t* wt_qkv(int j) const { return (bf16_t*)(b + WS_WT_QKV) + (size_t)j * 1536 * 1024; }
    DEVI bf16_t* wt_o(int j) const { return (bf16_t*)(b + WS_WT_O) + (size_t)j * 1024 * 1024; }
    DEVI bf16_t* wt_ffnin(int l) const { return (bf16_t*)(b + WS_WT_FFNIN) + (size_t)l * 5632 * 1024; }
    DEVI bf16_t* wt_ffnout(int l) const { return (bf16_t*)(b + WS_WT_FFNOUT) + (size_t)l * 1024 * 2816; }
    DEVI bf16_t* mg(int j, int g) const { return (bf16_t*)(b + WS_MG) + ((size_t)(j * 64 + g) * 512) * 256; }
    DEVI bf16_t* vg(int j, int g) const { return (bf16_t*)(b + WS_VG) + ((size_t)(j * 64 + g) * 256) * 256; }
    DEVI float* lam16() const { return (float*)(b + WS_LAM16); }
    DEVI float* mod(int layer, int cond, int chunk) const { return (float*)(b + WS_MOD) + ((size_t)(layer * 5 + cond) * 6144 + chunk * 1024); }
    DEVI float* rope() const { return (float*)(b + WS_ROPE); }
    DEVI bf16_t* ks(int j) const { return (bf16_t*)(b + WS_KS + j * KS_LAYER); }
    DEVI bf16_t* vts(int j) const { return (bf16_t*)(b + WS_VTS + j * KS_LAYER); }
    DEVI bf16_t* kp() const { return (bf16_t*)(b + WS_KP); }
    DEVI bf16_t* vtp() const { return (bf16_t*)(b + WS_VTP); }
    DEVI float* X() const { return (float*)(b + WS_X); }
    DEVI float* T() const { return (float*)(b + WS_T); }
    DEVI bf16_t* H() const { return (bf16_t*)(b + WS_H); }
    DEVI bf16_t* bufa() const { return (bf16_t*)(b + WS_BUFA); }
    DEVI bf16_t* bufb() const { return (bf16_t*)(b + WS_BUFB); }
    DEVI bf16_t* act() const { return (bf16_t*)(b + WS_ACT); }
    DEVI float* sl() const { return (float*)(b + WS_SL); }
    DEVI float* part() const { return (float*)(b + WS_PART); }
};
DEVI int cond_of_row(int row) { return row < NPR ? 0 : 1 + ((row - NPR) >> 10); }

DEVI void s5_mats_item(PP p, const WS& ws, int item, unsigned char* lds) {
    const int j = item >> 6, g = item & 63, tid = tid_();
    float* lamp = (float*)lds;
    float* bbar = lamp + 2 * 64 * 17 * 2;
    float* ktab = bbar + 2 * 64 * 16 * 2;
    if (tid < 128) {
        const int dir = tid >> 6, pp = tid & 63;
        const int gi = (j * 2 + dir) * 64 + g, idx = gi * 64 + pp;
        const float are = p->in[12][idx], aim = p->in[13][idx], dt = expf(p->in[14][gi]);
        const float mag = expf(dt * are);
        float sn, cs; sincosf(dt * aim, &sn, &cs);
        const float lr = mag * cs, li = mag * sn;
        const float den = are * are + aim * aim, nr = lr - 1.f;
        const float kre = (nr * are + li * aim) / den, kim = (li * are - nr * aim) / den;
        float pr = 1.f, pi = 0.f;
        float* lp = lamp + (dir * 64 + pp) * 34;
        for (int e = 0; e <= 16; ++e) { lp[2 * e] = pr; lp[2 * e + 1] = pi; const float t = pr * lr - pi * li; pi = pr * li + pi * lr; pr = t; }
        float* l16 = ws.lam16() + (size_t)idx * 2; l16[0] = lp[32]; l16[1] = lp[33];
        const float* bre = p->in[15] + (size_t)idx * 16; const float* bim = p->in[16] + (size_t)idx * 16;
        float* bb = bbar + (dir * 64 + pp) * 32;
        for (int h = 0; h < 16; ++h) { const float br = bre[h], bi = bim[h]; bb[h] = kre * br - kim * bi; bb[16 + h] = kre * bi + kim * br; }
    }
    __syncthreads();
    {
        const int dir = tid >> 8, tau = (tid >> 4) & 15, h = tid & 15;
        const float* cre = p->in[17] + ((size_t)((j * 2 + dir) * 64 + g) * 16 + h) * 64;
        const float* cim = p->in[18] + ((size_t)((j * 2 + dir) * 64 + g) * 16 + h) * 64;
        f32x4 a4[4];
#pragma unroll
        for (int q = 0; q < 4; ++q) a4[q] = (f32x4){0.f, 0.f, 0.f, 0.f};
        for (int pp = 0; pp < 64; ++pp) {
            const float cr = cre[pp], ci = cim[pp];
            const float lr = lamp[(dir * 64 + pp) * 34 + 2 * tau], li = lamp[(dir * 64 + pp) * 34 + 2 * tau + 1];
            const float qr = cr * lr - ci * li, qi = cr * li + ci * lr;
            const f32x4* br4 = (const f32x4*)(bbar + (dir * 64 + pp) * 32);
#pragma unroll
            for (int q = 0; q < 4; ++q) a4[q] += br4[q] * qr - br4[4 + q] * qi;
        }
        float* kt = ktab + ((dir * 16 + tau) * 16 + h) * 16;
#pragma unroll
        for (int q = 0; q < 4; ++q) *(f32x4*)(kt + 4 * q) = a4[q];
    }
    __syncthreads();
    bf16_t* Mg = ws.mg(j, g);
    bf16_t* Vg = ws.vg(j, g);
    const float* dsk = p->in[19] + j * 1024 + g * 16;
    for (int i8 = tid; i8 < 8192; i8 += NTHR) {
        const int m = i8 >> 5, k8 = (i8 & 31) * 8;
        {
            const int t = m >> 4, h = m & 15, t2 = k8 >> 4, h0 = k8 & 15;
            float v[8];
#pragma unroll
            for (int e = 0; e < 8; ++e) {
                float x = 0.f;
                if (t2 <= t) x += ktab[((0 * 16 + (t - t2)) * 16 + h) * 16 + h0 + e];
                if (t2 >= t) x += ktab[((1 * 16 + (t2 - t)) * 16 + h) * 16 + h0 + e];
                if (t2 == t && h0 + e == h) x += dsk[h];
                v[e] = x;
            }
            u32x4 o; o.x = cvt_pk(v[0], v[1]); o.y = cvt_pk(v[2], v[3]); o.z = cvt_pk(v[4], v[5]); o.w = cvt_pk(v[6], v[7]);
            *(u32x4*)(Mg + (size_t)m * 256 + k8) = o;
        }
        {
            const int dir = m >> 7, ri = (m >> 6) & 1, pp = m & 63, t2 = k8 >> 4, h0 = k8 & 15;
            const int e = dir == 0 ? 15 - t2 : t2;
            const float lr = lamp[(dir * 64 + pp) * 34 + 2 * e], li = lamp[(dir * 64 + pp) * 34 + 2 * e + 1];
            const float* bb = bbar + (dir * 64 + pp) * 32;
            float v[8];
#pragma unroll
            for (int q = 0; q < 8; ++q) { const float br = bb[h0 + q], bi = bb[16 + h0 + q]; v[q] = ri == 0 ? lr * br - li * bi : lr * bi + li * br; }
            u32x4 o; o.x = cvt_pk(v[0], v[1]); o.y = cvt_pk(v[2], v[3]); o.z = cvt_pk(v[4], v[5]); o.w = cvt_pk(v[6], v[7]);
            *(u32x4*)(Mg + (size_t)(256 + m) * 256 + k8) = o;
        }
        {
            const int t = m >> 4, h = m & 15, dir = k8 >> 7, ri = (k8 >> 6) & 1, p0 = k8 & 63;
            const int e = dir == 0 ? t + 1 : 16 - t;
            const float* cre = p->in[17] + ((size_t)((j * 2 + dir) * 64 + g) * 16 + h) * 64 + p0;
            const float* cim = p->in[18] + ((size_t)((j * 2 + dir) * 64 + g) * 16 + h) * 64 + p0;
            float v[8];
#pragma unroll
            for (int q = 0; q < 8; ++q) {
                const float cr = cre[q], ci = cim[q];
                const float lr = lamp[(dir * 64 + p0 + q) * 34 + 2 * e], li = lamp[(dir * 64 + p0 + q) * 34 + 2 * e + 1];
                v[q] = ri == 0 ? (cr * lr - ci * li) : -(cr * li + ci * lr);
            }
            u32x4 o; o.x = cvt_pk(v[0], v[1]); o.y = cvt_pk(v[2], v[3]); o.z = cvt_pk(v[4], v[5]); o.w = cvt_pk(v[6], v[7]);
            *(u32x4*)(Vg + (size_t)m * 256 + k8) = o;
        }
    }
    __syncthreads();
}

DEVI void adaln_item(PP p, const WS& ws, int item, unsigned char* lds) {
    const int layer = item / 96, cgp = item % 96, tid = tid_();
    float* sil = (float*)lds;
    float* red = sil + 5 * 1024;
    for (int i = tid; i < 5120; i += NTHR) { const int c = i >> 10, k = i & 1023; const float v = c == 0 ? p->in[6][k] : p->in[2][(c - 1) * 1024 + k]; sil[i] = siluf_(v); }
    __syncthreads();
    const int c4 = tid & 15, kr = tid >> 4;
    f32x4 a[5];
#pragma unroll
    for (int c = 0; c < 5; ++c) a[c] = (f32x4){0.f, 0.f, 0.f, 0.f};
    const float* wb = p->in[7] + (size_t)layer * 1024 * 6144 + cgp * 64 + c4 * 4;
    for (int k0 = kr; k0 < 1024; k0 += 256) {
        f32x4 w4[8];
#pragma unroll
        for (int u = 0; u < 8; ++u) w4[u] = __builtin_nontemporal_load((const f32x4*)(wb + (size_t)(k0 + 32 * u) * 6144));
#pragma unroll
        for (int u = 0; u < 8; ++u)
#pragma unroll
            for (int c = 0; c < 5; ++c) a[c] += w4[u] * sil[c * 1024 + k0 + 32 * u];
    }
#pragma unroll
    for (int c = 0; c < 5; ++c) *(f32x4*)(red + (kr * 5 + c) * 64 + c4 * 4) = a[c];
    __syncthreads();
    if (tid < 320) {
        const int c = tid >> 6, col = tid & 63;
        float s = p->in[8][layer * 6144 + cgp * 64 + col];
        for (int r = 0; r < 32; ++r) s += red[(r * 5 + c) * 64 + col];
        ((float*)(ws.b + WS_MOD))[(size_t)(layer * 5 + c) * 6144 + cgp * 64 + col] = s;
    }
    if (item < 32) {
        WAITV(0);
        __syncthreads();
        if (tid == 0) { __builtin_amdgcn_fence(__ATOMIC_RELEASE, "agent"); WAITV(0); xb_add((unsigned*)(ws.b + WS_BAR) + 3713, 1u); }
    }
    __syncthreads();
}

struct WtD { const float* src; bf16_t* dst; int K, N, half, tile; };
constexpr int WT_L0_END = 784, WT_A_END = 1296, WT_B_END = 1744, WT_C_END = 2256, WT_D_END = 2768, WT_TOT = 2944;
DEVI WtD wt_make(PP p, const WS& ws, int kind, int l, int tile) {
    WtD d; d.tile = tile;
    if (kind == 0) { d.src = p->in[26] + (size_t)l * 1024 * 5632; d.dst = ws.wt_ffnin(l); d.K = 1024; d.N = 5632; d.half = 2816; }
    else if (kind == 1) { d.src = p->in[27] + (size_t)l * 2816 * 1024; d.dst = ws.wt_ffnout(l); d.K = 2816; d.N = 1024; d.half = 0; }
    else if (kind == 2) { d.src = p->in[20] + (size_t)l * 1024 * 2048; d.dst = ws.wt_glu(l); d.K = 1024; d.N = 2048; d.half = 1024; }
    else if (kind == 3) { d.src = p->in[22] + (size_t)l * 1024 * 1536; d.dst = ws.wt_qkv(l); d.K = 1024; d.N = 1536; d.half = -1; }
    else if (kind == 4) { d.src = p->in[11] + (size_t)l * 1024 * 1024; d.dst = ws.wt_s5in(l); d.K = 1024; d.N = 1024; d.half = 0; }
    else if (kind == 5) { d.src = p->in[21] + (size_t)l * 1024 * 1024; d.dst = ws.wt_s5out(l); d.K = 1024; d.N = 1024; d.half = 0; }
    else { d.src = p->in[25] + (size_t)l * 1024 * 1024; d.dst = ws.wt_o(l); d.K = 1024; d.N = 1024; d.half = 0; }
    return d;
}
DEVI WtD wt_decode(PP p, const WS& ws, int t) {
    if (t < 352) return wt_make(p, ws, 0, 0, t);
    if (t < 528) return wt_make(p, ws, 1, 0, t - 352);
    if (t < 656) return wt_make(p, ws, 2, 0, t - 528);
    if (t < 720) return wt_make(p, ws, 4, 0, t - 656);
    if (t < 784) return wt_make(p, ws, 5, 0, t - 720);
    if (t < 880) return wt_make(p, ws, 3, 0, t - 784);
    if (t < 944) return wt_make(p, ws, 6, 0, t - 880);
    if (t < 1296) return wt_make(p, ws, 0, 1, t - 944);
    if (t < 1472) return wt_make(p, ws, 1, 1, t - 1296);
    if (t < 1568) return wt_make(p, ws, 0, 2, 256 + (t - 1472));
    if (t < 1744) return wt_make(p, ws, 1, 2, t - 1568);
    if (t < 1808) return wt_make(p, ws, 4, 1, t - 1744);
    if (t < 1936) return wt_make(p, ws, 2, 1, t - 1808);
    if (t < 2000) return wt_make(p, ws, 5, 1, t - 1936);
    if (t < 2256) return wt_make(p, ws, 0, 2, t - 2000);
    if (t < 2352) return wt_make(p, ws, 3, 1, t - 2256);
    if (t < 2416) return wt_make(p, ws, 6, 1, t - 2352);
    if (t < 2768) return wt_make(p, ws, 0, 3, t - 2416);
    return wt_make(p, ws, 1, 3, t - 2768);
}
DEVI void wt_load(const WtD& d, int tid, f32x4 (&v)[8]) {
    const int ntn = d.N >> 6, k0 = (d.tile / ntn) * 256, n0 = (d.tile % ntn) * 64, r = tid >> 4, c4 = (tid & 15) * 4;
#pragma unroll
    for (int i = 0; i < 8; ++i) v[i] = __builtin_nontemporal_load((const f32x4*)(d.src + (size_t)(k0 + r + 32 * i) * d.N + n0 + c4));
}
DEVI void wt_all(PP p, const WS& ws, int t0, int tstep, int tot, unsigned char* lds) {
    float* sc = (float*)lds;
    const int tid = tid_();
    if (t0 >= tot) return;
    WtD cur = wt_decode(p, ws, t0);
    f32x4 v[8];
    wt_load(cur, tid, v);
    for (int t = t0; t < tot; t += tstep) {
        const bool has = t + tstep < tot;
        {
            const int r = tid >> 4, c4 = (tid & 15) * 4;
#pragma unroll
            for (int i = 0; i < 8; ++i) { float* q = sc + (r + 32 * i) * 65 + c4; q[0] = v[i].x; q[1] = v[i].y; q[2] = v[i].z; q[3] = v[i].w; }
        }
        __syncthreads();
        WtD nxt = cur;
        if (has) { nxt = wt_decode(p, ws, t + tstep); wt_load(nxt, tid, v); }
        {
            const int ntn = cur.N >> 6, k0 = (cur.tile / ntn) * 256, n0 = (cur.tile % ntn) * 64;
            const int nn = tid >> 3, kq = tid & 7;
            int n = n0 + nn, rho = n;
            if (cur.half > 0) { const int which = n >= cur.half ? 1 : 0, jj = n - which * cur.half, c = jj & 31; rho = (jj >> 7) * 256 + which * 128 + (jj & 96) + ((c >> 2) & 1) * 16 + (c >> 3) * 4 + (c & 3); }
            else if (cur.half < 0) { const int d = n & 127, wcp = ((d >> 6) << 1) | ((d >> 4) & 1); rho = (n & ~127) + wcp * 32 + ((d >> 5) & 1) * 16 + (d & 15); }
#pragma unroll
            for (int ii = 0; ii < 4; ++ii) {
                const int k8 = (kq + 8 * ii) * 8;
                const float* q = sc + k8 * 65 + nn;
                u32x4 o; o.x = cvt_pk(q[0], q[65]); o.y = cvt_pk(q[130], q[195]); o.z = cvt_pk(q[260], q[325]); o.w = cvt_pk(q[390], q[455]);
                *(u32x4*)(cur.dst + (size_t)rho * cur.K + k0 + k8) = o;
            }
        }
        __syncthreads();
        cur = nxt;
    }
}

DEVI void prep_b(PP p, const WS& ws) {
    const int gt = bid_() * NTHR + tid_(), gn = gridDim.x * NTHR;
    for (int i = gt; i < NROW * (DM / 8); i += gn) {
        const int row = i >> 7, c8 = (i & 127) * 8;
        const float* x = row < NPR ? p->in[0] + (size_t)row * DM : p->in[1] + (size_t)(row - NPR) * DM;
        const int cond = cond_of_row(row);
        const float* sh = ws.mod(0, cond, 0); const float* sc = ws.mod(0, cond, 1);
        const f32x4 x0 = *(const f32x4*)(x + c8), x1 = *(const f32x4*)(x + c8 + 4);
        const f32x4 s0 = *(const f32x4*)(sc + c8), s1 = *(const f32x4*)(sc + c8 + 4);
        const f32x4 h0 = *(const f32x4*)(sh + c8), h1 = *(const f32x4*)(sh + c8 + 4);
        const f32x4 r0 = x0 * (s0 + 1.f) + h0, r1 = x1 * (s1 + 1.f) + h1;
        u32x4 o; o.x = cvt_pk(r0.x, r0.y); o.y = cvt_pk(r0.z, r0.w); o.z = cvt_pk(r1.x, r1.y); o.w = cvt_pk(r1.z, r1.w);
        *(u32x4*)(ws.H() + (size_t)row * DM + c8) = o;
    }
}

DEVI void prep_a(PP p, const WS& ws, unsigned char* lds) {
    const int bid = bid_(), nb = gridDim.x, tid = tid_();
    if (nb == 256) {
        if (bid < 128) s5_mats_item(p, ws, bid, lds);
        else {
            for (int it = bid - 128; it < 192; it += 128) adaln_item(p, ws, it, lds);
            wt_all(p, ws, bid - 128, 128, WT_L0_END, lds);
        }
    } else {
        for (int it = bid; it < 128; it += nb) s5_mats_item(p, ws, it, lds);
        for (int it = nb - 1 - bid; it < 384; it += nb) adaln_item(p, ws, it, lds);
        wt_all(p, ws, bid, nb, WT_TOT, lds);
    }
    const int gt = bid * NTHR + tid, gn = nb * NTHR;
    for (int i = gt; i < 2 * 4 * 512 * 2 * 32; i += gn) {
        const int d4 = (i & 31) * 4, kvh = (i >> 5) & 1, past = (i >> 6) & 511, j = (i >> 15) & 1, b = i >> 16;
        const f32x4 v = *(const f32x4*)(p->in[3] + ((((size_t)b * 2 + j) * 512 + past) * 2 + kvh) * 128 + d4);
        *(u32x2*)(ws.ks(j) + ((size_t)(b * 2 + kvh) * 1536 + 1024 + past) * 128 + d4) = pack4(v);
    }
    for (int i = gt; i < 2 * 4 * 2 * 64 * 128; i += gn) {
        const int d = i & 127, p8 = (i >> 7) & 63, kvh = (i >> 13) & 1, b = (i >> 14) & 3, j = i >> 16;
        const float* s = p->in[4] + ((((size_t)b * 2 + j) * 512 + p8 * 8) * 2 + kvh) * 128 + d;
        u32x4 o; o.x = cvt_pk(s[0], s[256]); o.y = cvt_pk(s[512], s[768]); o.z = cvt_pk(s[1024], s[1280]); o.w = cvt_pk(s[1536], s[1792]);
        *(u32x4*)(ws.vts(j) + ((size_t)(b * 2 + kvh) * 128 + d) * 1536 + 1024 + p8 * 8) = o;
    }
    for (int i = gt; i < 2048; i += gn) {
        const int pos = i >> 5, fi = i & 31;
        const float inv = exp2f(-(float)fi * (13.287712379549449f / 32.f));
        float sn, cs; sincosf((float)pos * inv, &sn, &cs);
        ws.rope()[2 * i] = cs; ws.rope()[2 * i + 1] = sn;
    }
    if (tid == 0) {
        unsigned* cw = (unsigned*)(ws.b + WS_BAR) + 3713; unsigned sp = 0;
        while (xb_ld(cw) < 32u) { __builtin_amdgcn_s_sleep(2); if (++sp > (1u << 22)) break; }
        __builtin_amdgcn_fence(__ATOMIC_ACQUIRE, "agent");
        WAITV(0);
    }
    __syncthreads();
    prep_b(p, ws);
}

DEVI void ln_phase(PP p, const WS& ws, int layer, int which) {
    const int lane = tid_() & 63, gw = bid_() * 8 + (tid_() >> 6), nw = gridDim.x * 8;
    const float* gam = p->in[9] + (layer * 2 + which) * DM; const float* bet = p->in[10] + (layer * 2 + which) * DM;
    const bool last = (layer == 3 && which == 1);
    const int ml = which == 0 ? layer : layer + 1, ms = which == 0 ? 3 : 0;
    float* Xo = last ? p->out + OUT_Y : ws.X();
    for (int row = gw; row < NROW; row += nw) {
        const float* t = ws.T() + (size_t)row * DM;
        f32x4 v[4]; float s = 0.f;
#pragma unroll
        for (int q = 0; q < 4; ++q) { v[q] = *(const f32x4*)(t + q * 256 + lane * 4); s += (v[q].x + v[q].y) + (v[q].z + v[q].w); }
#pragma unroll
        for (int o = 1; o < 64; o <<= 1) s += __shfl_xor(s, o);
        const float mean = s * (1.f / DM); float s2 = 0.f;
#pragma unroll
        for (int q = 0; q < 4; ++q) { v[q] = v[q] - mean; s2 += (v[q].x * v[q].x + v[q].y * v[q].y) + (v[q].z * v[q].z + v[q].w * v[q].w); }
#pragma unroll
        for (int o = 1; o < 64; o <<= 1) s2 += __shfl_xor(s2, o);
        const float rstd = 1.f / sqrtf(s2 * (1.f / DM) + LN_EPS);
        const int cond = cond_of_row(row);
#pragma unroll
        for (int q = 0; q < 4; ++q) {
            const int c = q * 256 + lane * 4;
            const f32x4 y = v[q] * rstd * *(const f32x4*)(gam + c) + *(const f32x4*)(bet + c);
            *(f32x4*)(Xo + (size_t)row * DM + c) = y;
            if (!last) {
                const f32x4 sh = *(const f32x4*)(ws.mod(ml, cond, ms) + c), sc = *(const f32x4*)(ws.mod(ml, cond, ms + 1) + c);
                *(u32x2*)(ws.H() + (size_t)row * DM + c) = pack4(y * (sc + 1.f) + sh);
            }
        }
    }
}

DEVI void out_ln_gemm_phase(PP p, const WS& ws, const bf16_t* A, int K, const bf16_t* Wt, int layer, int which, const float* xlo, const float* xhi, bool xf32, unsigned char* lds) {
    const int gchunk = which == 0 ? 2 : 5;
    const bool last = (layer == 3 && which == 1);
    const int ml = which == 0 ? layer : layer + 1, ms = which == 0 ? 3 : 0;
    const float* gam = p->in[9] + (layer * 2 + which) * DM; const float* bet = p->in[10] + (layer * 2 + which) * DM;
    float* Xo = p->out + OUT_Y;
    bf16_t* Xb = (bf16_t*)ws.X();
    float* part = ws.part() + (size_t)(layer * 2 + which) * NROW * 32;
    unsigned* cnt = (unsigned*)(ws.b + WS_BAR) + 3456 + (layer * 2 + which) * 32;
    for (int t = bid_(); t < 256; t += gridDim.x) {
        const int tm = t & 31, tn = t >> 5;
        const int cond = tm < 16 ? 0 : 1 + ((tm - 16) >> 2);
        const float* gate = ws.mod(layer, cond, gchunk);
        gemm_tile(A + (size_t)tm * 256 * K, K, Wt + (size_t)tn * 128 * K, K, K, lds,
            [&](f32x4 (&acc)[4][4], int wr, int wc, int fr, int fq) {
                const int colb = tn * 128 + wc * 64 + fq * 4;
                const int tid = (wr * 2 + wc) * 64 + fq * 16 + fr;
                {
                    f32x4 gv[4];
#pragma unroll
                    for (int n = 0; n < 4; ++n) gv[n] = *(const f32x4*)(gate + colb + n * 16);
#pragma unroll
                    for (int i = 0; i < 4; ++i) {
                        const int row = tm * 256 + wr * 64 + i * 16 + fr;
                        const float* xp = row < NPR ? xlo + (size_t)row * DM : xhi + (size_t)(row - NPR) * DM;
                        const bf16_t* xq = Xb + (size_t)row * DM;
                        float s1 = 0.f, s2 = 0.f;
#pragma unroll
                        for (int n = 0; n < 4; ++n) {
                            f32x4 xv;
                            if (xf32) xv = *(const f32x4*)(xp + colb + n * 16);
                            else { const u32x2 u = *(const u32x2*)(xq + colb + n * 16); xv.x = __uint_as_float(u.x << 16); xv.y = __uint_as_float(u.x & 0xffff0000u); xv.z = __uint_as_float(u.y << 16); xv.w = __uint_as_float(u.y & 0xffff0000u); }
                            const f32x4 tv = xv * ALPHA + gv[n] * acc[i][n];
                            acc[i][n] = tv;
                            s1 += (tv.x + tv.y) + (tv.z + tv.w);
                            s2 += (tv.x * tv.x + tv.y * tv.y) + (tv.z * tv.z + tv.w * tv.w);
                        }
                        s1 += __shfl_xor(s1, 16); s1 += __shfl_xor(s1, 32);
                        s2 += __shfl_xor(s2, 16); s2 += __shfl_xor(s2, 32);
                        if (fq == 0) { float* rp = (float*)(lds + LDS_RED) + (wc * 256 + wr * 64 + i * 16 + fr) * 2; rp[0] = s1; rp[1] = s2; }
                    }
                }
                __syncthreads();
                if (tid < 256) {
                    const float* rp = (const float*)(lds + LDS_RED);
                    const float v1 = rp[tid * 2] + rp[(256 + tid) * 2], v2 = rp[tid * 2 + 1] + rp[(256 + tid) * 2 + 1];
                    __hip_atomic_store((unsigned long long*)(part + ((size_t)(tm * 8 + tn) * 256 + tid) * 2), (unsigned long long)__float_as_uint(v1) | ((unsigned long long)__float_as_uint(v2) << 32), __ATOMIC_RELAXED, __HIP_MEMORY_SCOPE_AGENT);
                }
                WAITV(0);
                __syncthreads();
                if (tid == 0) {
                    xb_add(&cnt[tm], 1u);
                    unsigned sp = 0;
                    while (xb_ld(&cnt[tm]) < 8u) { __builtin_amdgcn_s_sleep(1); if (++sp > (1u << 24)) break; }
                    __builtin_amdgcn_fence(__ATOMIC_ACQUIRE, "agent");
                    WAITV(0);
                }
                __syncthreads();
                float* stats = (float*)(lds + LDS_RED);
                if (tid < 256) {
                    const float* pp = part + ((size_t)(tm * 8) * 256 + tid) * 2;
                    float s1 = 0.f, s2 = 0.f;
                    f32x2 pv[8];
#pragma unroll
                    for (int q = 0; q < 8; ++q) pv[q] = *(const f32x2*)(pp + q * 512);
#pragma unroll
                    for (int q = 0; q < 8; ++q) { s1 += pv[q].x; s2 += pv[q].y; }
                    const float mean = s1 * (1.f / DM);
                    const float var = fmaxf(s2 * (1.f / DM) - mean * mean, 0.f);
                    stats[2 * tid] = mean; stats[2 * tid + 1] = 1.f / sqrtf(var + LN_EPS);
                }
                __syncthreads();
                const float* shp = ws.mod(ml & 3, cond, ms); const float* scp = ws.mod(ml & 3, cond, ms + 1);
#pragma unroll
                for (int n = 0; n < 4; ++n) {
                    const int c = colb + n * 16;
                    const f32x4 g4 = *(const f32x4*)(gam + c), b4 = *(const f32x4*)(bet + c);
                    f32x4 sh4 = (f32x4){0.f, 0.f, 0.f, 0.f}, sc4 = sh4;
                    if (!last) { sh4 = *(const f32x4*)(shp + c); sc4 = *(const f32x4*)(scp + c); }
#pragma unroll
                    for (int i = 0; i < 4; ++i) {
                        const int rl = wr * 64 + i * 16 + fr, row = tm * 256 + rl;
                        const float mean = stats[2 * rl], rstd = stats[2 * rl + 1];
                        const f32x4 y = (acc[i][n] - mean) * rstd * g4 + b4;
                        if (last) __builtin_nontemporal_store(y, (f32x4*)(Xo + (size_t)row * DM + c));
                        else { *(u32x2*)(Xb + (size_t)row * DM + c) = pack4(y); *(u32x2*)(ws.H() + (size_t)row * DM + c) = pack4(y * (sc4 + 1.f) + sh4); }
                    }
                }
            }, (tm * 5 + tn) % (K >> 6));
    }
}

DEVI void ffn_in_phase(PP p, const WS& ws, int layer, unsigned char* lds) {
    const bf16_t* A = ws.H(); const bf16_t* Wt = ws.wt_ffnin(layer); bf16_t* ACT = ws.act();
    for (int t = bid_(); t < 32 * 22; t += gridDim.x) {
        const int tm = t & 31, tn = t >> 5;
        gemm_tile8p(A + (size_t)tm * 256 * DM, Wt + (size_t)tn * 256 * DM, DM, lds,
            [&](f32x4 (&acc)[2][2][4][2], int wr, int wc, int fr, int fq) {
#pragma unroll
                for (int ai = 0; ai < 2; ++ai)
#pragma unroll
                    for (int m = 0; m < 4; ++m) {
                        const int row = tm * 256 + ai * 128 + wr * 64 + m * 16 + fr;
                        u32x4 o8;
#pragma unroll
                        for (int n = 0; n < 2; ++n) {
                            const f32x4 g = acc[ai][0][m][n], u = acc[ai][1][m][n];
                            f32x4 r; r.x = siluf_(g.x) * u.x; r.y = siluf_(g.y) * u.y; r.z = siluf_(g.z) * u.z; r.w = siluf_(g.w) * u.w;
                            const u32x2 pk = pack4(r);
                            if (n == 0) { o8.x = pk.x; o8.y = pk.y; } else { o8.z = pk.x; o8.w = pk.y; }
                        }
                        *(u32x4*)(ACT + (size_t)row * DFF + tn * 128 + wc * 32 + fq * 8) = o8;
                    }
            });
    }
    if (gridDim.x == 256 && bid_() >= 192 && layer < 3) {
        const int lo = layer == 0 ? WT_L0_END : layer == 1 ? WT_B_END : WT_C_END, hi = layer == 0 ? WT_A_END : layer == 1 ? WT_C_END : WT_D_END;
        wt_all(p, ws, lo + (bid_() - 192), 64, hi, lds);
    }
}

DEVI void glu_phase(const WS& ws, int j, unsigned char* lds) {
    const bf16_t* A = ws.bufa(); const bf16_t* Wt = ws.wt_glu(j); bf16_t* O = ws.bufb();
    for (int t = bid_(); t < 32 * 8; t += gridDim.x) {
        const int tm = t & 31, tn = t >> 5;
        gemm_tile8p(A + (size_t)tm * 256 * DM, Wt + (size_t)tn * 256 * DM, DM, lds,
            [&](f32x4 (&acc)[2][2][4][2], int wr, int wc, int fr, int fq) {
#pragma unroll
                for (int ai = 0; ai < 2; ++ai)
#pragma unroll
                    for (int m = 0; m < 4; ++m) {
                        const int row = tm * 256 + ai * 128 + wr * 64 + m * 16 + fr;
                        u32x4 o8;
#pragma unroll
                        for (int n = 0; n < 2; ++n) {
                            const f32x4 v = acc[ai][0][m][n], g = acc[ai][1][m][n];
                            f32x4 r; r.x = v.x * sigmoidf_(g.x); r.y = v.y * sigmoidf_(g.y); r.z = v.z * sigmoidf_(g.z); r.w = v.w * sigmoidf_(g.w);
                            const u32x2 pk = pack4(r);
                            if (n == 0) { o8.x = pk.x; o8.y = pk.y; } else { o8.z = pk.x; o8.w = pk.y; }
                        }
                        *(u32x4*)(O + (size_t)row * DM + tn * 128 + wc * 32 + fq * 8) = o8;
                    }
            });
    }
}

DEVI void s5_in_phase(const WS& ws, int j, unsigned char* lds) {
    const bf16_t* A = ws.H(); const bf16_t* Wt = ws.wt_s5in(j); bf16_t* Uc = ws.act();
    for (int t = bid_(); t < 256; t += gridDim.x) {
        const int tm = t & 31, tn = t >> 5;
        gemm_tile(A + (size_t)tm * 256 * DM, DM, Wt + (size_t)tn * 128 * DM, DM, DM, lds,
            [&](f32x4 (&acc)[4][4], int wr, int wc, int fr, int fq) {
#pragma unroll
                for (int i = 0; i < 4; ++i) {
                    const int chunk = tm * 16 + wr * 4 + i;
#pragma unroll
                    for (int n = 0; n < 4; ++n) {
                        const int g = tn * 8 + wc * 4 + n;
                        *(u32x2*)(Uc + ((size_t)chunk * 64 + g) * 256 + fr * 16 + fq * 4) = pack4(acc[i][n]);
                    }
                }
            }, (tm * 5 + tn) & 15);
    }
}

DEVI void s5_chunk_phase(PP p, const WS& ws, int j, unsigned char* lds) {
    const bf16_t* Uc = ws.act(); bf16_t* Yi = (bf16_t*)ws.T(); bf16_t* Ss = ws.bufb();
    for (int it0 = bid_(); it0 < 512; it0 += gridDim.x) {
        const int it = it0 < 256 ? it0 : (it0 ^ 2);
        const int g = it >> 3, ct = (it >> 2) & 1, mt = it & 3;
        gemm_tile(Uc + ((size_t)ct * 256 * 64 + g) * 256, 16384, ws.mg(j, g) + (size_t)mt * 128 * 256, 256, 256, lds,
            [&](f32x4 (&acc)[4][4], int wr, int wc, int fr, int fq) {
                if (mt < 2) {
#pragma unroll
                    for (int i = 0; i < 4; ++i) {
                        const int chunk = ct * 256 + wr * 64 + i * 16 + fr;
#pragma unroll
                        for (int n = 0; n < 4; ++n) { const int tt = mt * 8 + wc * 4 + n; *(u32x2*)(Yi + (size_t)(chunk * 16 + tt) * DM + g * 16 + fq * 4) = pack4(acc[i][n]); }
                    }
                } else {
                    const int dir = mt - 2, tid = (wr * 2 + wc) * 64 + fq * 16 + fr;
                    float* sl = (float*)lds;
                    __syncthreads();
#pragma unroll
                    for (int i = 0; i < 4; ++i)
#pragma unroll
                        for (int n = 0; n < 4; ++n) *(f32x4*)(sl + (wr * 64 + i * 16 + fr) * 128 + wc * 64 + n * 16 + fq * 4) = acc[i][n];
                    __syncthreads();
                    const int nchain = ct == 0 ? 1024 : 256, n = ct == 0 ? 16 : 64;
                    for (int c = tid; c < nchain; c += NTHR) {
                        const int b = c >> 6, pp = c & 63, base = b * n;
                        const float* l16 = ws.lam16() + ((size_t)((j * 2 + dir) * 64 + g) * 64 + pp) * 2;
                        const float lr = l16[0], li = l16[1];
                        float sr = 0.f, si = 0.f;
                        const size_t so = ((((size_t)(b * 2 + j) * 2 + dir) * 2 + 0) * 64 + g) * 64 + pp;
                        if (ct == 1) { sr = p->in[5][so]; si = p->in[5][so + 4096]; }
                        for (int q = 0; q < n; ++q) {
                            const int lc = dir == 0 ? base + q : base + n - 1 - q;
                            const size_t o = ((size_t)(ct * 256 + lc) * 64 + g) * 256 + dir * 128 + pp;
                            Ss[o] = (bf16_t)(cvt_pk(sr, sr) & 0xffffu); Ss[o + 64] = (bf16_t)(cvt_pk(si, si) & 0xffffu);
                            const float ar = sl[lc * 128 + pp], ai = sl[lc * 128 + 64 + pp];
                            const float nr = lr * sr - li * si + ar; si = lr * si + li * sr + ai; sr = nr;
                        }
                        if (ct == 0) { p->out[OUT_S + so] = sr; p->out[OUT_S + so + 4096] = si; }
                    }
                }
            });
    }
}

DEVI void s5_y_phase(const WS& ws, int j, unsigned char* lds) {
    const bf16_t* Ss = ws.bufb(); const bf16_t* Yi = (const bf16_t*)ws.T(); bf16_t* Z = ws.bufa();
    for (int it = bid_(); it < 256; it += gridDim.x) {
        const int g = it >> 2, ct = (it >> 1) & 1, mt = it & 1;
        gemm_tile(Ss + ((size_t)ct * 256 * 64 + g) * 256, 16384, ws.vg(j, g) + (size_t)mt * 128 * 256, 256, 256, lds,
            [&](f32x4 (&acc)[4][4], int wr, int wc, int fr, int fq) {
#pragma unroll
                for (int i = 0; i < 4; ++i) {
                    const int chunk = ct * 256 + wr * 64 + i * 16 + fr;
#pragma unroll
                    for (int n = 0; n < 4; ++n) {
                        const int tt = mt * 8 + wc * 4 + n;
                        const size_t o = (size_t)(chunk * 16 + tt) * DM + g * 16 + fq * 4;
                        const u32x2 yu = *(const u32x2*)(Yi + o);
                        f32x4 y = acc[i][n]; y.x += __uint_as_float(yu.x << 16); y.y += __uint_as_float(yu.x & 0xffff0000u); y.z += __uint_as_float(yu.y << 16); y.w += __uint_as_float(yu.y & 0xffff0000u);
                        f32x4 z; z.x = gelu_tanh(y.x); z.y = gelu_tanh(y.y); z.z = gelu_tanh(y.z); z.w = gelu_tanh(y.w);
                        *(u32x2*)(Z + o) = pack4(z);
                    }
                }
            });
    }
}

DEVI void qkv_phase(PP p, const WS& ws, int j, unsigned char* lds) {
    const bf16_t* A = ws.H(); const bf16_t* Wt = ws.wt_qkv(j);
    for (int t = bid_(); t < 32 * 6; t += gridDim.x) {
        const int tm = t & 31, tn = t >> 5;
        if (tn == 5) {
            gemm_tile8p<false>(A + (size_t)tm * 256 * DM, Wt + (size_t)tn * 256 * DM, DM, lds,
                [&](f32x4 (&acc)[2][2][4][2], int wr, int wc, int fr, int fq) {
                    const bool sample = tm >= 16;
                    const int b = sample ? (tm - 16) >> 2 : tm;
                    const int lq = sample ? ((tm - 16) & 3) * 256 : 0, skv = sample ? 1536 : 256;
#pragma unroll
                    for (int bj = 0; bj < 2; ++bj) {
                        bf16_t* vt = (sample ? ws.vts(j) : ws.vtp()) + (size_t)(b * 2 + bj) * 128 * skv;
#pragma unroll
                        for (int n = 0; n < 2; ++n) {
                            const int d = (wc >> 1) * 64 + n * 32 + (wc & 1) * 16 + fr;
#pragma unroll
                            for (int ai = 0; ai < 2; ++ai)
#pragma unroll
                                for (int m = 0; m < 4; ++m) {
                                    const int l = lq + ai * 128 + wr * 64 + m * 16 + fq * 4;
                                    *(u32x2*)(vt + (size_t)d * skv + l) = pack4(acc[ai][bj][m][n]);
                                    if (!sample) { float* o = p->out + OUT_V + ((((size_t)b * 2 + j) * 256 + l) * 2 + bj) * 128 + d; o[0] = acc[ai][bj][m][n].x; o[256] = acc[ai][bj][m][n].y; o[512] = acc[ai][bj][m][n].z; o[768] = acc[ai][bj][m][n].w; }
                                }
                        }
                    }
                });
            continue;
        }
        gemm_tile8p(A + (size_t)tm * 256 * DM, Wt + (size_t)tn * 256 * DM, DM, lds,
            [&](f32x4 (&acc)[2][2][4][2], int wr, int wc, int fr, int fq) {
                const bool sample = tm >= 16;
                const int b = sample ? (tm - 16) >> 2 : tm;
                const int lq = sample ? ((tm - 16) & 3) * 256 : 0;
                const int d0 = (wc >> 1) * 64 + (wc & 1) * 16 + fq * 4;
                {
                    float* red = (float*)(lds + 131072);
#pragma unroll
                    for (int ai = 0; ai < 2; ++ai)
#pragma unroll
                        for (int bj = 0; bj < 2; ++bj)
#pragma unroll
                            for (int m = 0; m < 4; ++m) {
                                const f32x4 u = acc[ai][bj][m][0], v = acc[ai][bj][m][1];
                                float ssq = (u.x * u.x + u.y * u.y) + (u.z * u.z + u.w * u.w) + (v.x * v.x + v.y * v.y) + (v.z * v.z + v.w * v.w);
                                ssq += __shfl_xor(ssq, 16); ssq += __shfl_xor(ssq, 32);
                                if (fq == 0) red[((((ai * 2 + bj) * 2 + wr) * 4 + m) * 16 + fr) * 4 + wc] = ssq;
                            }
                    __syncthreads();
                    const float* gain = (tn < 4 ? p->in[23] : p->in[24]) + j * 128;
                    const f32x4 g0 = *(const f32x4*)(gain + d0), g1 = *(const f32x4*)(gain + d0 + 32);
                    const float* rope = ws.rope();
#pragma unroll
                    for (int ai = 0; ai < 2; ++ai)
#pragma unroll
                        for (int m = 0; m < 4; ++m) {
                            const int rl = ai * 128 + wr * 64 + m * 16 + fr, row = tm * 256 + rl, l = lq + rl;
                            f32x4 r0 = (f32x4){1.f, 0.f, 1.f, 0.f}, r1 = r0;
                            if (sample) { const int pos = (wc >> 1) == 0 ? (l >> 6) : (l & 63); const float* rp = rope + (pos * 32 + (wc & 1) * 16 + fq * 4) * 2; r0 = *(const f32x4*)rp; r1 = *(const f32x4*)(rp + 4); }
#pragma unroll
                            for (int bj = 0; bj < 2; ++bj) {
                                const f32x4 q4 = *(const f32x4*)(red + ((((ai * 2 + bj) * 2 + wr) * 4 + m) * 16 + fr) * 4);
                                const float rstd = 1.f / sqrtf(((q4.x + q4.y) + (q4.z + q4.w)) * (1.f / 128.f) + RMS_EPS);
                                const f32x4 x1 = acc[ai][bj][m][0] * rstd * g0, x2 = acc[ai][bj][m][1] * rstd * g1;
                                f32x4 y1, y2;
                                y1.x = x1.x * r0.x - x2.x * r0.y; y2.x = x2.x * r0.x + x1.x * r0.y;
                                y1.y = x1.y * r0.z - x2.y * r0.w; y2.y = x2.y * r0.z + x1.y * r0.w;
                                y1.z = x1.z * r1.x - x2.z * r1.y; y2.z = x2.z * r1.x + x1.z * r1.y;
                                y1.w = x1.w * r1.z - x2.w * r1.w; y2.w = x2.w * r1.z + x1.w * r1.w;
                                if (tn < 4) {
                                    bf16_t* qp = ws.bufa() + (size_t)row * DM + (tn * 2 + bj) * 128 + d0;
                                    *(u32x2*)qp = pack4(y1); *(u32x2*)(qp + 32) = pack4(y2);
                                } else {
                                    const int kvh = bj;
                                    bf16_t* kp = sample ? ws.ks(j) + ((size_t)(b * 2 + kvh) * 1536 + l) * 128 + d0 : ws.kp() + ((size_t)(b * 2 + kvh) * 256 + l) * 128 + d0;
                                    *(u32x2*)kp = pack4(y1); *(u32x2*)(kp + 32) = pack4(y2);
                                    if (!sample) { float* o = p->out + OUT_K + ((((size_t)b * 2 + j) * 256 + l) * 2 + kvh) * 128 + d0; __builtin_nontemporal_store(y1, (f32x4*)o); __builtin_nontemporal_store(y2, (f32x4*)(o + 32)); }
                                }
                            }
                        }
                }
            });
    }    if (gridDim.x == 256 && bid_() >= 192) {
        const int lo = j == 0 ? WT_A_END : WT_D_END, hi = j == 0 ? WT_B_END : WT_TOT, ib = bid_() - 192;
        if (j == 0) {
            for (int q = ib; q < 128; q += 64) adaln_item(p, ws, 192 + q, lds);
        } else {
            adaln_item(p, ws, 320 + ib, lds);
        }
        wt_all(p, ws, lo + ib, 64, hi, lds);
    }
}

constexpr int AT_KROW = 288, AT_VROW = 288, AT_KB = 64 * AT_KROW, AT_VB = 128 * AT_VROW, AT_STAGE = AT_KB + AT_VB;
DEVI void attn_phase(const WS& ws, int j, unsigned char* lds) {
    const int tid = tid_(), lane = tid & 63, w = tid >> 6, fr = lane & 15, fq = lane >> 4;
    const bf16_t* Q = ws.bufa(); bf16_t* AO = ws.bufb();
    for (int it = bid_(); it < 512; it += gridDim.x) {
        int b, h, qb, skv, row0; const bf16_t *Kb, *Vb;
        if (it < 256) { b = it >> 6; h = (it >> 3) & 7; qb = it & 7; skv = 1536; row0 = NPR + b * 1024 + qb * 128;
            Kb = ws.ks(j) + (size_t)(b * 2 + (h >> 2)) * 1536 * 128; Vb = ws.vts(j) + (size_t)(b * 2 + (h >> 2)) * 128 * 1536; }
        else { const int i2 = it - 256; b = i2 >> 4; h = (i2 >> 1) & 7; qb = i2 & 1; skv = 256; row0 = b * 256 + qb * 128;
            Kb = ws.kp() + (size_t)(b * 2 + (h >> 2)) * 256 * 128; Vb = ws.vtp() + (size_t)(b * 2 + (h >> 2)) * 128 * 256; }
        const int qrow = row0 + w * 16 + fr;
        bf16x8 qf[4];
#pragma unroll
        for (int s = 0; s < 4; ++s) qf[s] = *(const bf16x8*)(Q + (size_t)qrow * DM + h * 128 + s * 32 + fq * 8);
        f32x4 o[8];
#pragma unroll
        for (int m = 0; m < 8; ++m) o[m] = (f32x4){0.f, 0.f, 0.f, 0.f};
        float mrun = -1e30f, lrun = 0.f;
        const int kr0 = tid >> 4, kc = tid & 15;
        const int vr0 = tid >> 3, vc = tid & 7;
        const int vs = vc >> 2, vu = vc & 3;
        const int vslot_lo = vs * 32 + (2 * (vu & 1)) * 8 + (vu >> 1) * 4, vslot_hi = vslot_lo + 8;
        const bf16_t* gk = Kb + (size_t)kr0 * 128 + kc * 8;
        const bf16_t* gv = Vb + (size_t)vr0 * skv + vc * 8;
        u32x4 rk[2], rv[2];
        const int nt = skv >> 6;
        rk[0] = *(const u32x4*)(gk); rk[1] = *(const u32x4*)(gk + 32 * 128);
        rv[0] = *(const u32x4*)(gv); rv[1] = *(const u32x4*)(gv + (size_t)64 * skv);
        {
            unsigned char* sk = lds; unsigned char* sv = lds + AT_KB;
            *(u32x4*)(sk + kr0 * AT_KROW + kc * 16) = rk[0]; *(u32x4*)(sk + (kr0 + 32) * AT_KROW + kc * 16) = rk[1];
#pragma unroll
            for (int q = 0; q < 2; ++q) {
                unsigned char* r = sv + (vr0 + 64 * q) * AT_VROW;
                u32x2 lo; lo.x = rv[q].x; lo.y = rv[q].y; u32x2 hi; hi.x = rv[q].z; hi.y = rv[q].w;
                *(u32x2*)(r + vslot_lo * 2) = lo; *(u32x2*)(r + vslot_hi * 2) = hi;
            }
        }
        __syncthreads();
        for (int kt = 0; kt < nt; ++kt) {
            const bool more = kt + 1 < nt;
            if (more) {
                const int k0 = (kt + 1) * 64;
                rk[0] = *(const u32x4*)(gk + (size_t)k0 * 128); rk[1] = *(const u32x4*)(gk + (size_t)(k0 + 32) * 128);
                rv[0] = *(const u32x4*)(gv + k0); rv[1] = *(const u32x4*)(gv + (size_t)64 * skv + k0);
            }
            const unsigned char* sk = lds + (kt & 1) * AT_STAGE; const unsigned char* sv = sk + AT_KB;
            f32x4 sc[4];
#pragma unroll
            for (int t = 0; t < 4; ++t) {
                sc[t] = (f32x4){0.f, 0.f, 0.f, 0.f};
#pragma unroll
                for (int s = 0; s < 4; ++s) {
                    const bf16x8 kf = *(const bf16x8*)(sk + (t * 16 + fr) * AT_KROW + s * 64 + fq * 16);
                    sc[t] = __builtin_amdgcn_mfma_f32_16x16x32_bf16(kf, qf[s], sc[t], 0, 0, 0);
                }
            }
            bf16x8 vfr[8][2];
#pragma unroll
            for (int m = 0; m < 8; ++m)
#pragma unroll
                for (int s = 0; s < 2; ++s) vfr[m][s] = *(const bf16x8*)(sv + (m * 16 + fr) * AT_VROW + s * 64 + fq * 16);
            float mx = sc[0].x;
#pragma unroll
            for (int t = 0; t < 4; ++t) mx = fmaxf(fmaxf(fmaxf(mx, sc[t].x), fmaxf(sc[t].y, sc[t].z)), sc[t].w);
            mx = fmaxf(mx, __shfl_xor(mx, 16)); mx = fmaxf(mx, __shfl_xor(mx, 32));
            const float mnew = fmaxf(mrun, mx);
            const float alpha = __builtin_amdgcn_exp2f((mrun - mnew) * SM_C);
            mrun = mnew;
            const float mb = -mnew * SM_C;
            float ls = 0.f;
#pragma unroll
            for (int t = 0; t < 4; ++t) {
                sc[t].x = __builtin_amdgcn_exp2f(sc[t].x * SM_C + mb); sc[t].y = __builtin_amdgcn_exp2f(sc[t].y * SM_C + mb);
                sc[t].z = __builtin_amdgcn_exp2f(sc[t].z * SM_C + mb); sc[t].w = __builtin_amdgcn_exp2f(sc[t].w * SM_C + mb);
                ls += (sc[t].x + sc[t].y) + (sc[t].z + sc[t].w);
            }
            lrun = lrun * alpha + ls;
#pragma unroll
            for (int m = 0; m < 8; ++m) o[m] = o[m] * alpha;
            bf16x8 pf[2];
#pragma unroll
            for (int s = 0; s < 2; ++s) {
                u32x4 u; u.x = cvt_pk(sc[2 * s].x, sc[2 * s].y); u.y = cvt_pk(sc[2 * s].z, sc[2 * s].w);
                u.z = cvt_pk(sc[2 * s + 1].x, sc[2 * s + 1].y); u.w = cvt_pk(sc[2 * s + 1].z, sc[2 * s + 1].w);
                pf[s] = __builtin_bit_cast(bf16x8, u);
            }
#pragma unroll
            for (int m = 0; m < 8; ++m)
#pragma unroll
                for (int s = 0; s < 2; ++s) o[m] = __builtin_amdgcn_mfma_f32_16x16x32_bf16(vfr[m][s], pf[s], o[m], 0, 0, 0);
            if (more) {
                unsigned char* wk = lds + ((kt + 1) & 1) * AT_STAGE; unsigned char* wv = wk + AT_KB;
                *(u32x4*)(wk + kr0 * AT_KROW + kc * 16) = rk[0]; *(u32x4*)(wk + (kr0 + 32) * AT_KROW + kc * 16) = rk[1];
#pragma unroll
                for (int q = 0; q < 2; ++q) {
                    unsigned char* r = wv + (vr0 + 64 * q) * AT_VROW;
                    u32x2 lo; lo.x = rv[q].x; lo.y = rv[q].y; u32x2 hi; hi.x = rv[q].z; hi.y = rv[q].w;
                    *(u32x2*)(r + vslot_lo * 2) = lo; *(u32x2*)(r + vslot_hi * 2) = hi;
                }
            }
            __syncthreads();
        }
        float l = lrun; l += __shfl_xor(l, 16); l += __shfl_xor(l, 32);
        const float inv = 1.f / l;
#pragma unroll
        for (int m = 0; m < 8; ++m) *(u32x2*)(AO + (size_t)qrow * DM + h * 128 + m * 16 + fq * 4) = pack4(o[m] * inv);
    }
}

constexpr int N_PHASES = 1 + 7 + 5 + 7 + 5;
#ifndef REP_FFNIN
#define REP_FFNIN 1
#endif
#ifndef REP_ATTN
#define REP_ATTN 1
#endif
#ifndef REP_PREP
#define REP_PREP 1
#endif
#ifndef DBG_N
#define DBG_N 1000
#endif
DEVI void run_phase(PP p, const WS& ws, int ph, unsigned char* lds) {
    if (ph == 0) { for (int rep = 0; rep < REP_PREP; ++rep) prep_a(p, ws, lds); return; }
    int r = ph - 1, layer = 0;
    if (r >= 7) { r -= 7; layer = 1; if (r >= 5) { r -= 5; layer = 2; if (r >= 7) { r -= 7; layer = 3; } } }
    const int j = layer >> 1;
    const bool s5 = (layer & 1) == 0;
    const float* xlo = layer == 0 ? p->in[0] : ws.X();
    const float* xhi = layer == 0 ? p->in[1] : ws.X() + (size_t)NPR * DM;
    int k = r;
    if (s5) {
        if (r == 0) { s5_in_phase(ws, j, lds); return; }
        if (r == 1) { s5_chunk_phase(p, ws, j, lds); return; }
        if (r == 2) { s5_y_phase(ws, j, lds); return; }
        if (r == 3) { glu_phase(ws, j, lds); return; }
        k = r - 4;
        if (k == 0) { out_ln_gemm_phase(p, ws, ws.bufb(), DM, ws.wt_s5out(j), layer, 0, xlo, xhi, layer == 0, lds); return; }
    } else {
        if (r == 0) { qkv_phase(p, ws, j, lds); return; }
        if (r == 1) { for (int rep = 0; rep < REP_ATTN; ++rep) attn_phase(ws, j, lds); return; }
        k = r - 2;
        if (k == 0) { out_ln_gemm_phase(p, ws, ws.bufb(), DM, ws.wt_o(j), layer, 0, xlo, xhi, layer == 0, lds); return; }
    }
    if (k == 1) { for (int rep = 0; rep < REP_FFNIN; ++rep) ffn_in_phase(p, ws, layer, lds); return; }
    out_ln_gemm_phase(p, ws, ws.act(), DFF, ws.wt_ffnout(layer), layer, 1, xlo, xhi, false, lds);
}

__global__ void __launch_bounds__(NTHR) mega(Params p_) {
    extern __shared__ __attribute__((aligned(16))) unsigned char lds[];
    volatile LAS unsigned* xbw = (volatile LAS unsigned*)(LAS unsigned char*)(lds + LDS_XB);
    if (threadIdx.x < 4) xbw[threadIdx.x] = 0u;
    __syncthreads();
    const int ph_lo = p_.ph_lo, ph_hi = p_.ph_hi;
    XcdBarrier xb = xcd_barrier_post((unsigned*)(p_.ws + WS_BAR), xbw);
    for (int ph = ph_lo; ph < ph_hi; ++ph) {
        {
            PP p = (PP)__builtin_amdgcn_kernarg_segment_ptr();
            asm volatile("" : "+s"(p));
            WS ws; ws.b = p->ws;
            run_phase(p, ws, ph, lds);
#ifdef DBG_TWICE
            if (ph == 2) { xcd_barrier(xb); run_phase(p, ws, ph, lds); }
#endif
        }
        if (ph + 1 < ph_hi) {
#if USE_CG
            cg::this_grid().sync();
#else
            if (ph_hi < 0) cg::this_grid().sync();
            xcd_barrier(xb);
#endif
        }
    }
}

extern "C" void kernel_launch(void* const* d_in, const int* in_sizes, int n_in, void* d_out, int out_size, void* d_ws, size_t ws_size, hipStream_t stream) {
    static int grid = 0;
    if (grid == 0) {
        if (n_in != 28 || ws_size < WS_END) { fprintf(stderr, "kernel_launch: unexpected n_in %d or ws_size %zu (< %zu)\n", n_in, ws_size, (size_t)WS_END); grid = -1; return; }
        int dev = 0, cus = 0, per_cu = 0;
        (void)hipGetDevice(&dev);
        (void)hipDeviceGetAttribute(&cus, hipDeviceAttributeMultiprocessorCount, dev);
        (void)hipFuncSetAttribute((const void*)mega, hipFuncAttributeMaxDynamicSharedMemorySize, LDS_BYTES);
        (void)hipOccupancyMaxActiveBlocksPerMultiprocessor(&per_cu, (const void*)mega, NTHR, LDS_BYTES);
        (void)hipGetLastError();
        if (per_cu < 1) per_cu = 1;
        grid = cus * 1;
    }
    if (grid < 0) return;
    (void)hipMemsetAsync((unsigned char*)d_ws + WS_BAR, 0, 16384, stream);
    Params p{};
    for (int i = 0; i < 28; ++i) p.in[i] = (const float*)d_in[i];
    p.out = (float*)d_out; p.ws = (unsigned char*)d_ws; p.ph_lo = 0; p.ph_hi = N_PHASES;
    void* args[] = {&p};
    hipError_t e = hipLaunchCooperativeKernel((const void*)mega, dim3(grid), dim3(NTHR), args, LDS_BYTES, stream);
    if (e != hipSuccess) fprintf(stderr, "cooperative launch failed: %s (grid %d)\n", hipGetErrorString(e), grid);
}
```

```cpp
#include <hip/hip_runtime.h>
#include <hip/hip_cooperative_groups.h>
#include <cstdio>
#include <cstdint>
namespace cg = cooperative_groups;

#define DEVI __device__ __forceinline__
#define LAS __attribute__((address_space(3)))
typedef unsigned short bf16_t;
typedef short bf16x8 __attribute__((ext_vector_type(8)));
typedef float f32x4 __attribute__((ext_vector_type(4)));
typedef float f32x2 __attribute__((ext_vector_type(2)));
typedef unsigned u32x4 __attribute__((ext_vector_type(4)));
typedef unsigned u32x2 __attribute__((ext_vector_type(2)));

constexpr int DM = 1024, NROW = 8192, NPR = 4096, DFF = 2816;
constexpr float ALPHA = 1.681792830507429f;
constexpr float LN_EPS = 1e-6f, RMS_EPS = 1e-6f;
constexpr float SM_C = 0.08838834764831845f * 1.4426950408889634f;

constexpr size_t OUT_Y = 0, OUT_K = 8388608, OUT_V = 10485760, OUT_S = 12582912;

constexpr size_t al256(size_t x) { return (x + 255) & ~(size_t)255; }
constexpr size_t WS_BAR = 0;
constexpr size_t WS_WT_S5IN = 16384;
constexpr size_t WS_WT_GLU = WS_WT_S5IN + 2ull * 1024 * 1024 * 2;
constexpr size_t WS_WT_S5OUT = WS_WT_GLU + 2ull * 2048 * 1024 * 2;
constexpr size_t WS_WT_QKV = WS_WT_S5OUT + 2ull * 1024 * 1024 * 2;
constexpr size_t WS_WT_O = WS_WT_QKV + 2ull * 1536 * 1024 * 2;
constexpr size_t WS_WT_FFNIN = WS_WT_O + 2ull * 1024 * 1024 * 2;
constexpr size_t WS_WT_FFNOUT = WS_WT_FFNIN + 4ull * 5632 * 1024 * 2;
constexpr size_t WS_MG = WS_WT_FFNOUT + 4ull * 1024 * 2816 * 2;
constexpr size_t WS_VG = WS_MG + 2ull * 64 * 512 * 256 * 2;
constexpr size_t WS_LAM16 = WS_VG + 2ull * 64 * 256 * 256 * 2;
constexpr size_t WS_MOD = WS_LAM16 + 2ull * 2 * 64 * 64 * 2 * 4;
constexpr size_t WS_ROPE = WS_MOD + al256(4ull * 5 * 6144 * 4);
constexpr size_t WS_KS = WS_ROPE + 64ull * 32 * 2 * 4;
constexpr size_t KS_LAYER = 4ull * 2 * 1536 * 128 * 2;
constexpr size_t WS_VTS = WS_KS + 2 * KS_LAYER;
constexpr size_t WS_KP = WS_VTS + 2 * KS_LAYER;
constexpr size_t WS_VTP = WS_KP + 16ull * 2 * 256 * 128 * 2;
constexpr size_t WS_X = WS_VTP + 16ull * 2 * 256 * 128 * 2;
constexpr size_t WS_T = WS_X + (size_t)NROW * DM * 4;
constexpr size_t WS_H = WS_T + (size_t)NROW * DM * 4;
constexpr size_t WS_BUFA = WS_H + (size_t)NROW * DM * 2;
constexpr size_t WS_BUFB = WS_BUFA + (size_t)NROW * DM * 2;
constexpr size_t WS_ACT = WS_BUFB + (size_t)NROW * DM * 2;
constexpr size_t WS_SL = WS_ACT + (size_t)NROW * DFF * 2;
constexpr size_t WS_PART = WS_SL + (size_t)NROW * DM * 4;
constexpr size_t WS_END = WS_PART + 8 * (size_t)NROW * 16 * 2 * 4;

constexpr int NTHR = 512;
constexpr int LROW = 144;
constexpr int A_TILE_B = 256 * LROW, B_TILE_B = 128 * LROW, STAGE_B = A_TILE_B + B_TILE_B;
constexpr int LDS_RED = 3 * (256 * 128 + 128 * 128);
constexpr int LDS_XB = LDS_RED + 4096;
constexpr int LDS_BYTES = LDS_XB + 64;

struct Params {
    const float* in[28];
    float* out;
    unsigned char* ws;
    int ph_lo, ph_hi;
};
typedef const __attribute__((address_space(4))) Params* PP;

typedef __bf16 bf16v2 __attribute__((ext_vector_type(2)));
DEVI unsigned cvt_pk(float lo, float hi) { f32x2 v = {lo, hi}; bf16v2 b = __builtin_convertvector(v, bf16v2); return __builtin_bit_cast(unsigned, b); }
DEVI u32x2 pack4(f32x4 v) { u32x2 r; r.x = cvt_pk(v.x, v.y); r.y = cvt_pk(v.z, v.w); return r; }
DEVI float sigmoidf_(float x) { return 1.f / (1.f + __expf(-x)); }
DEVI float siluf_(float x) { return x / (1.f + __expf(-x)); }
DEVI float gelu_tanh(float y) { const float a = 0.7978845608028654f * (y + 0.044715f * y * y * y); const float th = 1.f - 2.f / (__expf(2.f * a) + 1.f); return 0.5f * y * (1.f + th); }

#define XB_TMO      128
#define XB_XCNT(j)  (256  + 64 * (j))
#define XB_XSUB(j)  (1280 + 64 * (j))
#define XB_XGEN(j)  (2304 + 64 * (j))
#define XB_TOP      3328
#define XB_TOPGEN   3392
#define XCD_BAR_WORDS 3456
#define XB_SPIN_CAP (1u << 22)
#define WAITV(n) asm volatile("s_waitcnt vmcnt(" #n ")" ::: "memory")
DEVI unsigned xb_ld(unsigned* p)              { return __hip_atomic_load(p, __ATOMIC_RELAXED, __HIP_MEMORY_SCOPE_AGENT); }
DEVI unsigned xb_add(unsigned* p, unsigned v) { return __hip_atomic_fetch_add(p, v, __ATOMIC_RELAXED, __HIP_MEMORY_SCOPE_AGENT); }
DEVI unsigned xb_xcc_id() { return (unsigned)__builtin_amdgcn_s_getreg((3 << 11) | 20) & 0xFu; }
#define XB_SPIN(cond, bar) do { unsigned _sp = 0; while (cond) { __builtin_amdgcn_s_sleep(1); \
    if ((++_sp & 255u) == 0u) { if (xb_ld(&(bar)[XB_TMO])) break; if (_sp > XB_SPIN_CAP) { atomicAdd(&(bar)[XB_TMO], 1u); break; } } } } while (0)
struct XcdBarrier { unsigned* bar; unsigned x; volatile LAS unsigned* st; };
DEVI XcdBarrier xcd_barrier_post(unsigned* bar, volatile LAS unsigned* st) {
    XcdBarrier b; b.bar = bar; b.x = xb_xcc_id(); b.st = st;
    if (threadIdx.x == 0) (void)xb_add(&bar[XB_XCNT(b.x)], 1u);
    return b;
}
DEVI void xcd_barrier_complete(unsigned* bar, unsigned x, unsigned& nloc, unsigned& nx) {
    const unsigned G = gridDim.x * gridDim.y * gridDim.z;
    unsigned sum, cnt, mine, sp = 0u;
    for (;;) {
        sum = 0u; cnt = 0u; mine = 0u;
#pragma unroll
        for (unsigned j = 0; j < 16; ++j) { const unsigned c = xb_ld(&bar[XB_XCNT(j)]); sum += c; cnt += (c > 0u) ? 1u : 0u; mine = (j == x) ? c : mine; }
        if (sum == G) break;
        __builtin_amdgcn_s_sleep(1);
        if ((++sp & 255u) == 0u) { if (xb_ld(&bar[XB_TMO])) break; if (sp > XB_SPIN_CAP) { atomicAdd(&bar[XB_TMO], 1u); break; } }
    }
    nloc = mine > 0u ? mine : 1u; nx = cnt > 0u ? cnt : 1u;
}
DEVI void xcd_barrier(const XcdBarrier& b) {
    asm volatile("s_waitcnt vmcnt(0)" ::: "memory");
    __syncthreads();
    if (threadIdx.x == 0) {
        unsigned* bar = b.bar;
        __builtin_amdgcn_s_waitcnt(0);
        unsigned nloc = b.st[0], nx = b.st[1];
        if (nloc == 0u) { xcd_barrier_complete(bar, b.x, nloc, nx); b.st[0] = nloc; b.st[1] = nx; }
        const unsigned old = xb_add(&bar[XB_XSUB(b.x)], 1u);
        const unsigned gen = old / nloc;
        if (old + 1u == (gen + 1u) * nloc) {
            __builtin_amdgcn_fence(__ATOMIC_RELEASE, "agent");
            asm volatile("s_waitcnt vmcnt(0)" ::: "memory");
            const unsigned og = xb_add(&bar[XB_TOP], 1u);
            const unsigned tg = og / nx;
            if (og + 1u == (tg + 1u) * nx) xb_add(&bar[XB_TOPGEN], 1u);
            else XB_SPIN(xb_ld(&bar[XB_TOPGEN]) == tg, bar);
            __builtin_amdgcn_fence(__ATOMIC_ACQUIRE, "agent");
            xb_add(&bar[XB_XGEN(b.x)], 1u);
            asm volatile("s_waitcnt vmcnt(0)" ::: "memory");
        } else {
            XB_SPIN(xb_ld(&bar[XB_XGEN(b.x)]) == gen, bar);
            __builtin_amdgcn_fence(__ATOMIC_ACQUIRE, "agent");
            asm volatile("s_waitcnt vmcnt(0)" ::: "memory");
        }
    }
    __syncthreads();
}

DEVI int tid_() { int t = threadIdx.x; asm volatile("" : "+v"(t)); return t; }
DEVI int bid_() { int b = blockIdx.x; asm volatile("" : "+s"(b)); return b; }
#ifndef PF_DIST
#define PF_DIST 2
#endif
constexpr int GA_B = 256 * 128, GB_B = 128 * 128, GSTAGE = GA_B + GB_B, GNST = 3;
template <class Epi>
DEVI void gemm_tile(const bf16_t* __restrict__ A, size_t lda, const bf16_t* __restrict__ Bt, size_t ldb, int K, unsigned char* lds, Epi epi, int koff = 0) {
    const int tid = tid_(), lane = tid & 63, w = tid >> 6, wr = w >> 1, wc = w & 1, fr = lane & 15, fq = lane >> 4;
    f32x4 acc[4][4];
#pragma unroll
    for (int i = 0; i < 4; ++i)
#pragma unroll
        for (int n = 0; n < 4; ++n) acc[i][n] = (f32x4){0.f, 0.f, 0.f, 0.f};
    const int lr8 = lane >> 3, pch = lane & 7;
    const bf16_t* ga[4]; const bf16_t* gb[2];
#pragma unroll
    for (int i = 0; i < 4; ++i) { const int row = (i * 8 + w) * 8 + lr8; ga[i] = A + (size_t)row * lda + ((pch ^ ((row >> 1) & 7)) * 8); }
#pragma unroll
    for (int i = 0; i < 2; ++i) { const int row = (i * 8 + w) * 8 + lr8; gb[i] = Bt + (size_t)row * ldb + ((pch ^ ((row >> 1) & 7)) * 8); }
    const int dofs = w * 1024 + lane * 16;
    const int nk = K >> 6;
    const unsigned ldsbase = (unsigned)(uintptr_t)(LAS unsigned char*)lds;
    const int sx = fr >> 1;
    const int aofs0 = (wr * 64 + fr) * 128 + ((fq ^ sx) * 16), aofs1 = (wr * 64 + fr) * 128 + (((4 + fq) ^ sx) * 16);
    const int bofs0 = GA_B + (wc * 64 + fr) * 128 + ((fq ^ sx) * 16), bofs1 = GA_B + (wc * 64 + fr) * 128 + (((4 + fq) ^ sx) * 16);
#define GEMM_ISSUE(stage, kt_) do { unsigned char* _sb = lds + (stage) * GSTAGE + dofs; int _kk = (kt_) + koff; if (_kk >= nk) _kk -= nk; const int _ko = _kk * 64; \
        _Pragma("unroll") for (int _i = 0; _i < 4; ++_i) __builtin_amdgcn_global_load_lds((const unsigned*)(ga[_i] + _ko), (LAS unsigned*)(LAS unsigned char*)(_sb + _i * 8192), 16, 0, 0); \
        _Pragma("unroll") for (int _i = 0; _i < 2; ++_i) __builtin_amdgcn_global_load_lds((const unsigned*)(gb[_i] + _ko), (LAS unsigned*)(LAS unsigned char*)(_sb + GA_B + _i * 8192), 16, 0, 0); } while (0)
    WAITV(0);
    __builtin_amdgcn_s_barrier();
    GEMM_ISSUE(0, 0);
#if PF_DIST == 2
    if (nk > 1) GEMM_ISSUE(1, 1);
#endif
    int st = 0;
    for (int kt = 0; kt < nk; ++kt) {
#if PF_DIST == 2
        if (kt + 1 < nk) WAITV(6); else WAITV(0);
#else
        WAITV(0);
#endif
        __builtin_amdgcn_s_barrier();
        const unsigned sb = ldsbase + st * GSTAGE;
        bf16x8 af[2][4], bfr[2][4];
#define DSR(dst, addr, off) asm volatile("ds_read_b128 %0, %1 offset:%2" : "=v"(dst) : "v"(addr), "n"(off))
        { const unsigned ab0 = sb + bofs0, aa0 = sb + aofs0, ab1 = sb + bofs1, aa1 = sb + aofs1;
          DSR(bfr[0][0], ab0, 0); DSR(bfr[0][1], ab0, 2048); DSR(bfr[0][2], ab0, 4096); DSR(bfr[0][3], ab0, 6144);
          DSR(af[0][0], aa0, 0); DSR(af[0][1], aa0, 2048); DSR(af[0][2], aa0, 4096); DSR(af[0][3], aa0, 6144);
          DSR(bfr[1][0], ab1, 0); DSR(bfr[1][1], ab1, 2048); DSR(bfr[1][2], ab1, 4096); DSR(bfr[1][3], ab1, 6144);
          DSR(af[1][0], aa1, 0); DSR(af[1][1], aa1, 2048); DSR(af[1][2], aa1, 4096);
          asm volatile("s_waitcnt lgkmcnt(7)" : "+v"(bfr[0][0]), "+v"(bfr[0][1]), "+v"(bfr[0][2]), "+v"(bfr[0][3]), "+v"(af[0][0]), "+v"(af[0][1]), "+v"(af[0][2]), "+v"(af[0][3]));
          DSR(af[1][3], aa1, 6144); }
        __builtin_amdgcn_s_setprio(1);
#pragma unroll
        for (int i = 0; i < 4; ++i)
#pragma unroll
            for (int n = 0; n < 4; ++n) acc[i][n] = __builtin_amdgcn_mfma_f32_16x16x32_bf16(bfr[0][n], af[0][i], acc[i][n], 0, 0, 0);
        __builtin_amdgcn_s_setprio(0);
        __builtin_amdgcn_sched_barrier(0);
#if PF_DIST == 2
        if (kt + 2 < nk) { const int s2 = st >= 1 ? st - 1 : 2; GEMM_ISSUE(s2, kt + 2); }
#else
        if (kt + 1 < nk) { const int s2 = st == 2 ? 0 : st + 1; GEMM_ISSUE(s2, kt + 1); }
#endif
        __builtin_amdgcn_sched_barrier(0);
        asm volatile("s_waitcnt lgkmcnt(0)" : "+v"(bfr[1][0]), "+v"(bfr[1][1]), "+v"(bfr[1][2]), "+v"(bfr[1][3]), "+v"(af[1][0]), "+v"(af[1][1]), "+v"(af[1][2]), "+v"(af[1][3]));
        __builtin_amdgcn_s_setprio(1);
#pragma unroll
        for (int i = 0; i < 4; ++i)
#pragma unroll
            for (int n = 0; n < 4; ++n) acc[i][n] = __builtin_amdgcn_mfma_f32_16x16x32_bf16(bfr[1][n], af[1][i], acc[i][n], 0, 0, 0);
        __builtin_amdgcn_s_setprio(0);
        st = st == 2 ? 0 : st + 1;
    }
    epi(acc, wr, wc, fr, fq);
}

constexpr int H_HALF = 256 * 64, HSTAGE = 2 * H_HALF;
template <class Epi>
DEVI void gemm_tile256(const bf16_t* __restrict__ A, size_t lda, const bf16_t* __restrict__ Bt, size_t ldb, int K, unsigned char* lds, Epi epi) {
    const int tid = tid_(), lane = tid & 63, w = tid >> 6, wr = w >> 2, wc = w & 3, fr = lane & 15, fq = lane >> 4;
    f32x4 acc[8][4];
#pragma unroll
    for (int i = 0; i < 8; ++i)
#pragma unroll
        for (int n = 0; n < 4; ++n) acc[i][n] = (f32x4){0.f, 0.f, 0.f, 0.f};
    const int lr4 = lane >> 2, pch = lane & 3;
    const bf16_t* ga[2]; const bf16_t* gb[2];
#pragma unroll
    for (int i = 0; i < 2; ++i) { const int row = (i * 8 + w) * 16 + lr4; const int lch = pch ^ ((0x1320 >> (((row >> 2) & 3) * 4)) & 3); ga[i] = A + (size_t)row * lda + lch * 8; gb[i] = Bt + (size_t)row * ldb + lch * 8; }
    const int dofs = w * 1024 + lane * 16;
    const int nk = K >> 5;
    const unsigned ldsbase = (unsigned)(uintptr_t)(LAS unsigned char*)lds;
    const int pcs = (fq ^ ((0x1320 >> (((fr >> 2) & 3) * 4)) & 3)) * 16;
    const int aofs = (wr * 128 + fr) * 64 + pcs, bofs = H_HALF + (wc * 64 + fr) * 64 + pcs;
#define H_ISSUE(stage, kt_) do { unsigned char* _sb = lds + (stage) * HSTAGE + dofs; const int _ko = (kt_) * 32; \
        _Pragma("unroll") for (int _i = 0; _i < 2; ++_i) __builtin_amdgcn_global_load_lds((const unsigned*)(ga[_i] + _ko), (LAS unsigned*)(LAS unsigned char*)(_sb + _i * 8192), 16, 0, 0); \
        _Pragma("unroll") for (int _i = 0; _i < 2; ++_i) __builtin_amdgcn_global_load_lds((const unsigned*)(gb[_i] + _ko), (LAS unsigned*)(LAS unsigned char*)(_sb + H_HALF + _i * 8192), 16, 0, 0); } while (0)
#define DSR2(dst, addr, off) asm volatile("ds_read_b128 %0, %1 offset:%2" : "=v"(dst) : "v"(addr), "n"(off))
    const int wu = __builtin_amdgcn_readfirstlane(w);
    bf16x8 af[8], bfr[4];
#define H_READS(stg) do { const unsigned sa = ldsbase + (stg) * HSTAGE + aofs, sb = ldsbase + (stg) * HSTAGE + bofs; \
        DSR2(bfr[0], sb, 0); DSR2(bfr[1], sb, 1024); DSR2(bfr[2], sb, 2048); DSR2(bfr[3], sb, 3072); \
        DSR2(af[0], sa, 0); DSR2(af[1], sa, 1024); DSR2(af[2], sa, 2048); DSR2(af[3], sa, 3072); \
        DSR2(af[4], sa, 4096); DSR2(af[5], sa, 5120); DSR2(af[6], sa, 6144); DSR2(af[7], sa, 7168); } while (0)
#define H_WAIT_LO(n_) asm volatile("s_waitcnt lgkmcnt(" #n_ ")" : "+v"(bfr[0]), "+v"(bfr[1]), "+v"(bfr[2]), "+v"(bfr[3]), "+v"(af[0]), "+v"(af[1]), "+v"(af[2]), "+v"(af[3]))
#define H_WAIT_HI() asm volatile("s_waitcnt lgkmcnt(0)" : "+v"(af[4]), "+v"(af[5]), "+v"(af[6]), "+v"(af[7]))
#define H_MMA2(i0) do { __builtin_amdgcn_s_setprio(1); \
        _Pragma("unroll") for (int i = (i0); i < (i0) + 2; ++i) _Pragma("unroll") for (int n = 0; n < 4; ++n) acc[i][n] = __builtin_amdgcn_mfma_f32_16x16x32_bf16(bfr[n], af[i], acc[i][n], 0, 0, 0); \
        __builtin_amdgcn_s_setprio(0); __builtin_amdgcn_sched_barrier(0); } while (0)
#define H_PIECE(stage, kt_, j_) do { if ((kt_) < nk) { unsigned char* _sb = lds + (stage) * HSTAGE + dofs; const int _ko = (kt_) * 32; \
        if ((j_) < 2) __builtin_amdgcn_global_load_lds((const unsigned*)(ga[(j_) & 1] + _ko), (LAS unsigned*)(LAS unsigned char*)(_sb + ((j_) & 1) * 8192), 16, 0, 0); \
        else __builtin_amdgcn_global_load_lds((const unsigned*)(gb[(j_) & 1] + _ko), (LAS unsigned*)(LAS unsigned char*)(_sb + H_HALF + ((j_) & 1) * 8192), 16, 0, 0); } \
        __builtin_amdgcn_sched_barrier(0); } while (0)
#define H_SCHED() __builtin_amdgcn_sched_barrier(0)
    WAITV(0);
    __builtin_amdgcn_s_barrier();
    H_ISSUE(0, 0); H_ISSUE(1, 1); H_ISSUE(2, 2);
    if (wu < 4) {
        for (int kt = 0; kt < nk; ++kt) {
            if (kt + 2 < nk) WAITV(8); else if (kt + 1 < nk) WAITV(4); else WAITV(0);
            __builtin_amdgcn_s_barrier();
            const int s3 = (kt + 3) & 3;
            H_READS(kt & 3); H_SCHED();
            H_WAIT_LO(4);
            H_MMA2(0); H_PIECE(s3, kt + 3, 0);
            H_MMA2(2); H_PIECE(s3, kt + 3, 1);
            H_WAIT_HI();
            H_MMA2(4); H_PIECE(s3, kt + 3, 2);
            H_MMA2(6); H_PIECE(s3, kt + 3, 3);
        }
    } else {
        for (int kt = 0; kt < nk; ++kt) {
            if (kt + 2 < nk) WAITV(8); else if (kt + 1 < nk) WAITV(4); else WAITV(0);
            __builtin_amdgcn_s_barrier();
            const int s3 = (kt + 3) & 3;
            if (kt > 0) {
                H_MMA2(0); H_PIECE(s3, kt + 3, 0);
                H_MMA2(2); H_PIECE(s3, kt + 3, 1);
                H_MMA2(4); H_PIECE(s3, kt + 3, 2);
                H_MMA2(6); H_PIECE(s3, kt + 3, 3);
            } else { H_PIECE(s3, kt + 3, 0); H_PIECE(s3, kt + 3, 1); H_PIECE(s3, kt + 3, 2); H_PIECE(s3, kt + 3, 3); }
            H_READS(kt & 3); H_SCHED();
            H_WAIT_LO(0); H_WAIT_HI();
            H_SCHED();
        }
        H_MMA2(0); H_MMA2(2); H_MMA2(4); H_MMA2(6);
    }
    epi(acc, wr, wc, fr, fq);
}

DEVI int p8_lds_byte(int r, int c) { const int st = (r >> 4) * 2 + (c >> 5), rr = r & 15, cc = c & 31, ob = rr * 64 + cc * 2; return st * 1024 + (ob ^ (((ob >> 9) & 1) << 5)); }
DEVI void p8_stage_rc(int b, int& R, int& C) { const int st = b / 1024, sb = b % 1024, swz = sb ^ (((sb >> 9) & 1) << 5); R = (st >> 1) * 16 + swz / 64; C = (st & 1) * 32 + (swz % 64) / 2; }
template <bool SWAP = true, class Epi>
DEVI void gemm_tile8p(const bf16_t* __restrict__ A, const bf16_t* __restrict__ Bt, int K, unsigned char* lds, Epi epi) {
    constexpr int HTB = 128 * 64 * 2;
    const int tid = tid_(), lane = tid & 63, wid = __builtin_amdgcn_readfirstlane(tid >> 6), wr = wid >> 2, wc = wid & 3, fr = lane & 15, fq = lane >> 4;
    f32x4 acc[2][2][4][2];
#pragma unroll
    for (int a_ = 0; a_ < 2; ++a_)
#pragma unroll
        for (int b_ = 0; b_ < 2; ++b_)
#pragma unroll
            for (int m = 0; m < 4; ++m)
#pragma unroll
                for (int n = 0; n < 2; ++n) acc[a_][b_][m][n] = (f32x4){0.f, 0.f, 0.f, 0.f};
    bf16x8 At[4][2], B0[2][2], B1[2][2];
    unsigned voff[2];
#pragma unroll
    for (int i = 0; i < 2; ++i) { int R, C; p8_stage_rc(tid * 16 + i * 8192, R, C); voff[i] = (unsigned)(R * K + C); }
    const int aoff = p8_lds_byte(wr * 64 + fr, fq * 8), boff = p8_lds_byte(wc * 32 + fr, fq * 8);
    const size_t hstep = (size_t)128 * K;
    const int nt = K >> 6;
#define P8_SA(b, h) (((b) * 2 + (h)) * HTB)
#define P8_SB(b, h) ((4 + (b) * 2 + (h)) * HTB)
#define P8_STAGE(bufoff, gbase, kt_) do { _Pragma("unroll") for (int _i = 0; _i < 2; ++_i) \
        __builtin_amdgcn_global_load_lds((const unsigned*)((gbase) + voff[_i] + (size_t)(kt_) * 64), (LAS unsigned*)(LAS unsigned char*)(lds + (bufoff) + tid * 16 + _i * 8192), 16, 0, 0); } while (0)
#define P8_LDA(dst, b, h) do { _Pragma("unroll") for (int m = 0; m < 4; ++m) _Pragma("unroll") for (int k = 0; k < 2; ++k) dst[m][k] = *(const bf16x8*)(lds + P8_SA(b, h) + aoff + m * 2048 + k * 1024); } while (0)
#define P8_LDB(dst, b, h) do { _Pragma("unroll") for (int n = 0; n < 2; ++n) _Pragma("unroll") for (int k = 0; k < 2; ++k) dst[n][k] = *(const bf16x8*)(lds + P8_SB(b, h) + boff + n * 2048 + k * 1024); } while (0)
#define P8_MMA(ai, bj, At_, Bt_) do { __builtin_amdgcn_s_setprio(1); _Pragma("unroll") for (int m = 0; m < 4; ++m) _Pragma("unroll") for (int n = 0; n < 2; ++n) _Pragma("unroll") for (int k = 0; k < 2; ++k) \
        acc[ai][bj][m][n] = SWAP ? __builtin_amdgcn_mfma_f32_16x16x32_bf16(Bt_[n][k], At_[m][k], acc[ai][bj][m][n], 0, 0, 0) : __builtin_amdgcn_mfma_f32_16x16x32_bf16(At_[m][k], Bt_[n][k], acc[ai][bj][m][n], 0, 0, 0); __builtin_amdgcn_s_setprio(0); } while (0)
#define P8_WAIT_L(n) asm volatile("s_waitcnt lgkmcnt(" #n ")" ::: "memory")
#define P8_BAR __builtin_amdgcn_s_barrier()
#define P8_SCHED __builtin_amdgcn_sched_barrier(0)
    const bf16_t* cA = A; const bf16_t* cB = Bt;
    WAITV(0);
    P8_BAR;
    P8_STAGE(P8_SB(0, 0), cB, 0); P8_STAGE(P8_SA(0, 0), cA, 0); P8_STAGE(P8_SB(0, 1), cB + hstep, 0); P8_STAGE(P8_SA(0, 1), cA + hstep, 0);
    if (wr == 1) P8_BAR;
    WAITV(4); P8_BAR;
    P8_STAGE(P8_SB(1, 0), cB, 1); P8_STAGE(P8_SA(1, 0), cA, 1); P8_STAGE(P8_SB(1, 1), cB + hstep, 1);
    WAITV(6); P8_BAR;
    for (int t = 0; t < nt - 2; t += 2) {
        P8_LDB(B0, 0, 0); P8_SCHED; P8_LDA(At, 0, 0); P8_STAGE(P8_SA(1, 1), cA + hstep, t + 1);
        P8_WAIT_L(8); P8_BAR; P8_WAIT_L(0); P8_MMA(0, 0, At, B0); P8_BAR; P8_SCHED;
        P8_LDB(B1, 0, 1); P8_STAGE(P8_SB(0, 0), cB, t + 2);
        P8_BAR; P8_WAIT_L(0); P8_MMA(0, 1, At, B1); P8_BAR;
        P8_LDA(At, 0, 1); P8_STAGE(P8_SA(0, 0), cA, t + 2);
        P8_BAR; P8_WAIT_L(0); P8_MMA(1, 0, At, B0); P8_BAR; P8_SCHED;
        P8_STAGE(P8_SB(0, 1), cB + hstep, t + 2);
        WAITV(6); P8_BAR; P8_MMA(1, 1, At, B1); P8_BAR;
        P8_LDB(B0, 1, 0); P8_SCHED; P8_LDA(At, 1, 0); P8_STAGE(P8_SA(0, 1), cA + hstep, t + 2);
        P8_WAIT_L(8); P8_BAR; P8_WAIT_L(0); P8_MMA(0, 0, At, B0); P8_BAR; P8_SCHED;
        P8_LDB(B1, 1, 1); P8_STAGE(P8_SB(1, 0), cB, t + 3);
        P8_BAR; P8_WAIT_L(0); P8_MMA(0, 1, At, B1); P8_BAR;
        P8_LDA(At, 1, 1); P8_STAGE(P8_SA(1, 0), cA, t + 3);
        P8_BAR; P8_WAIT_L(0); P8_MMA(1, 0, At, B0); P8_BAR; P8_SCHED;
        P8_STAGE(P8_SB(1, 1), cB + hstep, t + 3);
        WAITV(6); P8_BAR; P8_MMA(1, 1, At, B1); P8_BAR;
    }
    { P8_LDB(B0, 0, 0); P8_LDA(At, 0, 0); P8_STAGE(P8_SA(1, 1), cA + hstep, nt - 1);
      P8_BAR; P8_WAIT_L(0); P8_MMA(0, 0, At, B0); P8_BAR;
      P8_LDB(B1, 0, 1); P8_BAR; P8_WAIT_L(0); P8_MMA(0, 1, At, B1); P8_BAR;
      P8_LDA(At, 0, 1); WAITV(4); P8_BAR; P8_WAIT_L(0); P8_MMA(1, 0, At, B0); P8_MMA(1, 1, At, B1); P8_BAR; }
    { P8_LDB(B0, 1, 0); P8_LDA(At, 1, 0); WAITV(2); P8_BAR; P8_WAIT_L(0); P8_MMA(0, 0, At, B0); P8_BAR;
      P8_LDB(B1, 1, 1); WAITV(0); P8_BAR; P8_WAIT_L(0); P8_MMA(0, 1, At, B1); P8_BAR;
      P8_LDA(At, 1, 1); P8_BAR; P8_WAIT_L(0); P8_MMA(1, 0, At, B0); P8_MMA(1, 1, At, B1); P8_BAR; }
    if (wr == 0) P8_BAR;
    epi(acc, wr, wc, fr, fq);
}

struct WS {
    unsigned char* b;
    DEVI bf16_t* wt_s5in(int j) const { return (bf16_t*)(b + WS_WT_S5IN) + (size_t)j * 1024 * 1024; }
    DEVI bf16_t* wt_glu(int j) const { return (bf16_t*)(b + WS_WT_GLU) + (size_t)j * 2048 * 1024; }
    DEVI bf16_t* wt_s5out(int j) const { return (bf16_t*)(b + WS_WT_S5OUT) + (size_t)j * 1024 * 1024; }
    DEVI bf16_t* wt_qkv(int j) const { return (bf16_t*)(b + WS_WT_QKV) + (size_t)j * 1536 * 1024; }
    DEVI bf16_t* wt_o(int j) const { return (bf16_t*)(b + WS_WT_O) + (size_t)j * 1024 * 1024; }
    DEVI bf16_t* wt_ffnin(int l) const { return (bf16_t*)(b + WS_WT_FFNIN) + (size_t)l * 5632 * 1024; }
    DEVI bf16_t* wt_ffnout(int l) const { return (bf16_t*)(b + WS_WT_FFNOUT) + (size_t)l * 1024 * 2816; }
    DEVI bf16_t* mg(int j, int g) const { return (bf16_t*)(b + WS_MG) + ((size_t)(j * 64 + g) * 512) * 256; }
    DEVI bf16_t* vg(int j, int g) const { return (bf16_t*)(b + WS_VG) + ((size_t)(j * 64 + g) * 256) * 256; }
    DEVI float* lam16() const { return (float*)(b + WS_LAM16); }
    DEVI float* mod(int layer, int cond, int chunk) const { return (float*)(b + WS_MOD) + ((size_t)(layer * 5 + cond) * 6144 + chunk * 1024); }
    DEVI float* rope() const { return (float*)(b + WS_ROPE); }
    DEVI bf16_t* ks(int j) const { return (bf16_t*)(b + WS_KS + j * KS_LAYER); }
    DEVI bf16_t* vts(int j) const { return (bf16_t*)(b + WS_VTS + j * KS_LAYER); }
    DEVI bf16_t* kp() const { return (bf16_t*)(b + WS_KP); }
    DEVI bf16_t* vtp() const { return (bf16_t*)(b + WS_VTP); }
    DEVI float* X() const { return (float*)(b + WS_X); }
    DEVI float* T() const { return (float*)(b + WS_T); }
    DEVI bf16_t* H() const { return (bf16_t*)(b + WS_H); }
    DEVI bf16_t* bufa() const { return (bf16_t*)(b + WS_BUFA); }
    DEVI bf16_t* bufb() const { return (bf16_t*)(b + WS_BUFB); }
    DEVI bf16_t* act() const { return (bf16_t*)(b + WS_ACT); }
    DEVI float* sl() const { return (float*)(b + WS_SL); }
    DEVI float* part() const { return (float*)(b + WS_PART); }
};
DEVI int cond_of_row(int row) { return row < NPR ? 0 : 1 + ((row - NPR) >> 10); }

DEVI void s5_mats_item(PP p, const WS& ws, int item, unsigned char* lds) {
    const int j = item >> 6, g = item & 63, tid = tid_();
    float* lamp = (float*)lds;
    float* bbar = lamp + 2 * 64 * 17 * 2;
    float* ktab = bbar + 2 * 64 * 16 * 2;
    if (tid < 128) {
        const int dir = tid >> 6, pp = tid & 63;
        const int gi = (j * 2 + dir) * 64 + g, idx = gi * 64 + pp;
        const float are = p->in[12][idx], aim = p->in[13][idx], dt = expf(p->in[14][gi]);
        const float mag = expf(dt * are);
        float sn, cs; sincosf(dt * aim, &sn, &cs);
        const float lr = mag * cs, li = mag * sn;
        const float den = are * are + aim * aim, nr = lr - 1.f;
        const float kre = (nr * are + li * aim) / den, kim = (li * are - nr * aim) / den;
        float pr = 1.f, pi = 0.f;
        float* lp = lamp + (dir * 64 + pp) * 34;
        for (int e = 0; e <= 16; ++e) { lp[2 * e] = pr; lp[2 * e + 1] = pi; const float t = pr * lr - pi * li; pi = pr * li + pi * lr; pr = t; }
        float* l16 = ws.lam16() + (size_t)idx * 2; l16[0] = lp[32]; l16[1] = lp[33];
        const float* bre = p->in[15] + (size_t)idx * 16; const float* bim = p->in[16] + (size_t)idx * 16;
        float* bb = bbar + (dir * 64 + pp) * 32;
        for (int h = 0; h < 16; ++h) { const float br = bre[h], bi = bim[h]; bb[h] = kre * br - kim * bi; bb[16 + h] = kre * bi + kim * br; }
    }
    __syncthreads();
    {
        const int dir = tid >> 8, tau = (tid >> 4) & 15, h = tid & 15;
        const float* cre = p->in[17] + ((size_t)((j * 2 + dir) * 64 + g) * 16 + h) * 64;
        const float* cim = p->in[18] + ((size_t)((j * 2 + dir) * 64 + g) * 16 + h) * 64;
        f32x4 a4[4];
#pragma unroll
        for (int q = 0; q < 4; ++q) a4[q] = (f32x4){0.f, 0.f, 0.f, 0.f};
        for (int pp = 0; pp < 64; ++pp) {
            const float cr = cre[pp], ci = cim[pp];
            const float lr = lamp[(dir * 64 + pp) * 34 + 2 * tau], li = lamp[(dir * 64 + pp) * 34 + 2 * tau + 1];
            const float qr = cr * lr - ci * li, qi = cr * li + ci * lr;
            const f32x4* br4 = (const f32x4*)(bbar + (dir * 64 + pp) * 32);
#pragma unroll
            for (int q = 0; q < 4; ++q) a4[q] += br4[q] * qr - br4[4 + q] * qi;
        }
        float* kt = ktab + ((dir * 16 + tau) * 16 + h) * 16;
#pragma unroll
        for (int q = 0; q < 4; ++q) *(f32x4*)(kt + 4 * q) = a4[q];
    }
    __syncthreads();
    bf16_t* Mg = ws.mg(j, g);
    bf16_t* Vg = ws.vg(j, g);
    const float* dsk = p->in[19] + j * 1024 + g * 16;
    for (int i8 = tid; i8 < 8192; i8 += NTHR) {
        const int m = i8 >> 5, k8 = (i8 & 31) * 8;
        {
            const int t = m >> 4, h = m & 15, t2 = k8 >> 4, h0 = k8 & 15;
            float v[8];
#pragma unroll
            for (int e = 0; e < 8; ++e) {
                float x = 0.f;
                if (t2 <= t) x += ktab[((0 * 16 + (t - t2)) * 16 + h) * 16 + h0 + e];
                if (t2 >= t) x += ktab[((1 * 16 + (t2 - t)) * 16 + h) * 16 + h0 + e];
                if (t2 == t && h0 + e == h) x += dsk[h];
                v[e] = x;
            }
            u32x4 o; o.x = cvt_pk(v[0], v[1]); o.y = cvt_pk(v[2], v[3]); o.z = cvt_pk(v[4], v[5]); o.w = cvt_pk(v[6], v[7]);
            *(u32x4*)(Mg + (size_t)m * 256 + k8) = o;
        }
        {
            const int dir = m >> 7, ri = (m >> 6) & 1, pp = m & 63, t2 = k8 >> 4, h0 = k8 & 15;
            const int e = dir == 0 ? 15 - t2 : t2;
            const float lr = lamp[(dir * 64 + pp) * 34 + 2 * e], li = lamp[(dir * 64 + pp) * 34 + 2 * e + 1];
            const float* bb = bbar + (dir * 64 + pp) * 32;
            float v[8];
#pragma unroll
            for (int q = 0; q < 8; ++q) { const float br = bb[h0 + q], bi = bb[16 + h0 + q]; v[q] = ri == 0 ? lr * br - li * bi : lr * bi + li * br; }
            u32x4 o; o.x = cvt_pk(v[0], v[1]); o.y = cvt_pk(v[2], v[3]); o.z = cvt_pk(v[4], v[5]); o.w = cvt_pk(v[6], v[7]);
            *(u32x4*)(Mg + (size_t)(256 + m) * 256 + k8) = o;
        }
        {
            const int t = m >> 4, h = m & 15, dir = k8 >> 7, ri = (k8 >> 6) & 1, p0 = k8 & 63;
            const int e = dir == 0 ? t + 1 : 16 - t;
            const float* cre = p->in[17] + ((size_t)((j * 2 + dir) * 64 + g) * 16 + h) * 64 + p0;
            const float* cim = p->in[18] + ((size_t)((j * 2 + dir) * 64 + g) * 16 + h) * 64 + p0;
            float v[8];
#pragma unroll
            for (int q = 0; q < 8; ++q) {
                const float cr = cre[q], ci = cim[q];
                const float lr = lamp[(dir * 64 + p0 + q) * 34 + 2 * e], li = lamp[(dir * 64 + p0 + q) * 34 + 2 * e + 1];
                v[q] = ri == 0 ? (cr * lr - ci * li) : -(cr * li + ci * lr);
            }
            u32x4 o; o.x = cvt_pk(v[0], v[1]); o.y = cvt_pk(v[2], v[3]); o.z = cvt_pk(v[4], v[5]); o.w = cvt_pk(v[6], v[7]);
            *(u32x4*)(Vg + (size_t)m * 256 + k8) = o;
        }
    }
    __syncthreads();
}

DEVI void adaln_item(PP p, const WS& ws, int item, unsigned char* lds) {
    const int layer = item / 96, cgp = item % 96, tid = tid_();
    float* sil = (float*)lds;
    float* red = sil + 5 * 1024;
    for (int i = tid; i < 5120; i += NTHR) { const int c = i >> 10, k = i & 1023; const float v = c == 0 ? p->in[6][k] : p->in[2][(c - 1) * 1024 + k]; sil[i] = siluf_(v); }
    __syncthreads();
    const int c4 = tid & 15, kr = tid >> 4;
    f32x4 a[5];
#pragma unroll
    for (int c = 0; c < 5; ++c) a[c] = (f32x4){0.f, 0.f, 0.f, 0.f};
    const float* wb = p->in[7] + (size_t)layer * 1024 * 6144 + cgp * 64 + c4 * 4;
    for (int k0 = kr; k0 < 1024; k0 += 256) {
        f32x4 w4[8];
#pragma unroll
        for (int u = 0; u < 8; ++u) w4[u] = __builtin_nontemporal_load((const f32x4*)(wb + (size_t)(k0 + 32 * u) * 6144));
#pragma unroll
        for (int u = 0; u < 8; ++u)
#pragma unroll
            for (int c = 0; c < 5; ++c) a[c] += w4[u] * sil[c * 1024 + k0 + 32 * u];
    }
#pragma unroll
    for (int c = 0; c < 5; ++c) *(f32x4*)(red + (kr * 5 + c) * 64 + c4 * 4) = a[c];
    __syncthreads();
    if (tid < 320) {
        const int c = tid >> 6, col = tid & 63;
        float s = p->in[8][layer * 6144 + cgp * 64 + col];
        for (int r = 0; r < 32; ++r) s += red[(r * 5 + c) * 64 + col];
        ((float*)(ws.b + WS_MOD))[(size_t)(layer * 5 + c) * 6144 + cgp * 64 + col] = s;
    }
    if (item < 32) {
        WAITV(0);
        __syncthreads();
        if (tid == 0) { __builtin_amdgcn_fence(__ATOMIC_RELEASE, "agent"); WAITV(0); xb_add((unsigned*)(ws.b + WS_BAR) + 3713, 1u); }
    }
    __syncthreads();
}

struct WtD { const float* src; bf16_t* dst; int K, N, half, tile; };
constexpr int WT_L0_END = 784, WT_A_END = 1296, WT_B_END = 1744, WT_C_END = 2256, WT_D_END = 2768, WT_TOT = 2944;
DEVI WtD wt_make(PP p, const WS& ws, int kind, int l, int tile) {
    WtD d; d.tile = tile;
    if (kind == 0) { d.src = p->in[26] + (size_t)l * 1024 * 5632; d.dst = ws.wt_ffnin(l); d.K = 1024; d.N = 5632; d.half = 2816; }
    else if (kind == 1) { d.src = p->in[27] + (size_t)l * 2816 * 1024; d.dst = ws.wt_ffnout(l); d.K = 2816; d.N = 1024; d.half = -2; }
    else if (kind == 2) { d.src = p->in[20] + (size_t)l * 1024 * 2048; d.dst = ws.wt_glu(l); d.K = 1024; d.N = 2048; d.half = 1024; }
    else if (kind == 3) { d.src = p->in[22] + (size_t)l * 1024 * 1536; d.dst = ws.wt_qkv(l); d.K = 1024; d.N = 1536; d.half = -1; }
    else if (kind == 4) { d.src = p->in[11] + (size_t)l * 1024 * 1024; d.dst = ws.wt_s5in(l); d.K = 1024; d.N = 1024; d.half = 0; }
    else if (kind == 5) { d.src = p->in[21] + (size_t)l * 1024 * 1024; d.dst = ws.wt_s5out(l); d.K = 1024; d.N = 1024; d.half = -2; }
    else { d.src = p->in[25] + (size_t)l * 1024 * 1024; d.dst = ws.wt_o(l); d.K = 1024; d.N = 1024; d.half = -2; }
    return d;
}
DEVI WtD wt_decode(PP p, const WS& ws, int t) {
    if (t < 352) return wt_make(p, ws, 0, 0, t);
    if (t < 528) return wt_make(p, ws, 1, 0, t - 352);
    if (t < 656) return wt_make(p, ws, 2, 0, t - 528);
    if (t < 720) return wt_make(p, ws, 4, 0, t - 656);
    if (t < 784) return wt_make(p, ws, 5, 0, t - 720);
    if (t < 880) return wt_make(p, ws, 3, 0, t - 784);
    if (t < 944) return wt_make(p, ws, 6, 0, t - 880);
    if (t < 1296) return wt_make(p, ws, 0, 1, t - 944);
    if (t < 1472) return wt_make(p, ws, 1, 1, t - 1296);
    if (t < 1568) return wt_make(p, ws, 0, 2, 256 + (t - 1472));
    if (t < 1744) return wt_make(p, ws, 1, 2, t - 1568);
    if (t < 1808) return wt_make(p, ws, 4, 1, t - 1744);
    if (t < 1936) return wt_make(p, ws, 2, 1, t - 1808);
    if (t < 2000) return wt_make(p, ws, 5, 1, t - 1936);
    if (t < 2256) return wt_make(p, ws, 0, 2, t - 2000);
    if (t < 2352) return wt_make(p, ws, 3, 1, t - 2256);
    if (t < 2416) return wt_make(p, ws, 6, 1, t - 2352);
    if (t < 2768) return wt_make(p, ws, 0, 3, t - 2416);
    return wt_make(p, ws, 1, 3, t - 2768);
}
DEVI void wt_load(const WtD& d, int tid, f32x4 (&v)[8]) {
    const int ntn = d.N >> 6, k0 = (d.tile / ntn) * 256, n0 = (d.tile % ntn) * 64, r = tid >> 4, c4 = (tid & 15) * 4;
#pragma unroll
    for (int i = 0; i < 8; ++i) v[i] = __builtin_nontemporal_load((const f32x4*)(d.src + (size_t)(k0 + r + 32 * i) * d.N + n0 + c4));
}
DEVI void wt_all(PP p, const WS& ws, int t0, int tstep, int tot, unsigned char* lds) {
    float* sc = (float*)lds;
    const int tid = tid_();
    if (t0 >= tot) return;
    WtD cur = wt_decode(p, ws, t0);
    f32x4 v[8];
    wt_load(cur, tid, v);
    for (int t = t0; t < tot; t += tstep) {
        const bool has = t + tstep < tot;
        {
            const int r = tid >> 4, c4 = (tid & 15) * 4;
#pragma unroll
            for (int i = 0; i < 8; ++i) { float* q = sc + (r + 32 * i) * 65 + c4; q[0] = v[i].x; q[1] = v[i].y; q[2] = v[i].z; q[3] = v[i].w; }
        }
        __syncthreads();
        WtD nxt = cur;
        if (has) { nxt = wt_decode(p, ws, t + tstep); wt_load(nxt, tid, v); }
        {
            const int ntn = cur.N >> 6, k0 = (cur.tile / ntn) * 256, n0 = (cur.tile % ntn) * 64;
            const int nn = tid >> 3, kq = tid & 7;
            int n = n0 + nn, rho = n;
            if (cur.half > 0) { const int which = n >= cur.half ? 1 : 0, jj = n - which * cur.half, c = jj & 31; rho = (jj >> 7) * 256 + which * 128 + (jj & 96) + ((c >> 2) & 1) * 16 + (c >> 3) * 4 + (c & 3); }
            else if (cur.half == -2) { const int c = n & 31; rho = (n & ~31) + ((c >> 2) & 1) * 16 + (c >> 3) * 4 + (c & 3); }
            else if (cur.half < 0) { const int d = n & 127, wcp = ((d >> 6) << 1) | ((d >> 4) & 1); rho = (n & ~127) + wcp * 32 + ((d >> 5) & 1) * 16 + (d & 15); }
#pragma unroll
            for (int ii = 0; ii < 4; ++ii) {
                const int k8 = (kq + 8 * ii) * 8;
                const float* q = sc + k8 * 65 + nn;
                u32x4 o; o.x = cvt_pk(q[0], q[65]); o.y = cvt_pk(q[130], q[195]); o.z = cvt_pk(q[260], q[325]); o.w = cvt_pk(q[390], q[455]);
                *(u32x4*)(cur.dst + (size_t)rho * cur.K + k0 + k8) = o;
            }
        }
        __syncthreads();
        cur = nxt;
    }
}

DEVI void prep_b(PP p, const WS& ws) {
    const int gt = bid_() * NTHR + tid_(), gn = gridDim.x * NTHR;
    for (int i = gt; i < NROW * (DM / 8); i += gn) {
        const int row = i >> 7, c8 = (i & 127) * 8;
        const float* x = row < NPR ? p->in[0] + (size_t)row * DM : p->in[1] + (size_t)(row - NPR) * DM;
        const int cond = cond_of_row(row);
        const float* sh = ws.mod(0, cond, 0); const float* sc = ws.mod(0, cond, 1);
        const f32x4 x0 = *(const f32x4*)(x + c8), x1 = *(const f32x4*)(x + c8 + 4);
        const f32x4 s0 = *(const f32x4*)(sc + c8), s1 = *(const f32x4*)(sc + c8 + 4);
        const f32x4 h0 = *(const f32x4*)(sh + c8), h1 = *(const f32x4*)(sh + c8 + 4);
        const f32x4 r0 = x0 * (s0 + 1.f) + h0, r1 = x1 * (s1 + 1.f) + h1;
        u32x4 o; o.x = cvt_pk(r0.x, r0.y); o.y = cvt_pk(r0.z, r0.w); o.z = cvt_pk(r1.x, r1.y); o.w = cvt_pk(r1.z, r1.w);
        *(u32x4*)(ws.H() + (size_t)row * DM + c8) = o;
    }
}

DEVI void prep_a(PP p, const WS& ws, unsigned char* lds) {
    const int bid = bid_(), nb = gridDim.x, tid = tid_();
    if (nb == 256) {
        if (bid < 128) s5_mats_item(p, ws, bid, lds);
        else {
            for (int it = bid - 128; it < 192; it += 128) adaln_item(p, ws, it, lds);
            wt_all(p, ws, bid - 128, 128, WT_L0_END, lds);
        }
    } else {
        for (int it = bid; it < 128; it += nb) s5_mats_item(p, ws, it, lds);
        for (int it = nb - 1 - bid; it < 384; it += nb) adaln_item(p, ws, it, lds);
        wt_all(p, ws, bid, nb, WT_TOT, lds);
    }
    const int gt = bid * NTHR + tid, gn = nb * NTHR;
    for (int i = gt; i < 2 * 4 * 512 * 2 * 32; i += gn) {
        const int d4 = (i & 31) * 4, kvh = (i >> 5) & 1, past = (i >> 6) & 511, j = (i >> 15) & 1, b = i >> 16;
        const f32x4 v = *(const f32x4*)(p->in[3] + ((((size_t)b * 2 + j) * 512 + past) * 2 + kvh) * 128 + d4);
        *(u32x2*)(ws.ks(j) + ((size_t)(b * 2 + kvh) * 1536 + 1024 + past) * 128 + d4) = pack4(v);
    }
    for (int i = gt; i < 2 * 4 * 2 * 64 * 128; i += gn) {
        const int d = i & 127, p8 = (i >> 7) & 63, kvh = (i >> 13) & 1, b = (i >> 14) & 3, j = i >> 16;
        const float* s = p->in[4] + ((((size_t)b * 2 + j) * 512 + p8 * 8) * 2 + kvh) * 128 + d;
        u32x4 o; o.x = cvt_pk(s[0], s[256]); o.y = cvt_pk(s[512], s[768]); o.z = cvt_pk(s[1024], s[1280]); o.w = cvt_pk(s[1536], s[1792]);
        *(u32x4*)(ws.vts(j) + ((size_t)(b * 2 + kvh) * 128 + d) * 1536 + 1024 + p8 * 8) = o;
    }
    for (int i = gt; i < 2048; i += gn) {
        const int pos = i >> 5, fi = i & 31;
        const float inv = exp2f(-(float)fi * (13.287712379549449f / 32.f));
        float sn, cs; sincosf((float)pos * inv, &sn, &cs);
        ws.rope()[2 * i] = cs; ws.rope()[2 * i + 1] = sn;
    }
    if (tid == 0) {
        unsigned* cw = (unsigned*)(ws.b + WS_BAR) + 3713; unsigned sp = 0;
        while (xb_ld(cw) < 32u) { __builtin_amdgcn_s_sleep(2); if (++sp > (1u << 22)) break; }
        __builtin_amdgcn_fence(__ATOMIC_ACQUIRE, "agent");
        WAITV(0);
    }
    __syncthreads();
    prep_b(p, ws);
}

DEVI void ln_phase(PP p, const WS& ws, int layer, int which) {
    const int lane = tid_() & 63, gw = bid_() * 8 + (tid_() >> 6), nw = gridDim.x * 8;
    const float* gam = p->in[9] + (layer * 2 + which) * DM; const float* bet = p->in[10] + (layer * 2 + which) * DM;
    const bool last = (layer == 3 && which == 1);
    const int ml = which == 0 ? layer : layer + 1, ms = which == 0 ? 3 : 0;
    float* Xo = last ? p->out + OUT_Y : ws.X();
    for (int row = gw; row < NROW; row += nw) {
        const float* t = ws.T() + (size_t)row * DM;
        f32x4 v[4]; float s = 0.f;
#pragma unroll
        for (int q = 0; q < 4; ++q) { v[q] = *(const f32x4*)(t + q * 256 + lane * 4); s += (v[q].x + v[q].y) + (v[q].z + v[q].w); }
#pragma unroll
        for (int o = 1; o < 64; o <<= 1) s += __shfl_xor(s, o);
        const float mean = s * (1.f / DM); float s2 = 0.f;
#pragma unroll
        for (int q = 0; q < 4; ++q) { v[q] = v[q] - mean; s2 += (v[q].x * v[q].x + v[q].y * v[q].y) + (v[q].z * v[q].z + v[q].w * v[q].w); }
#pragma unroll
        for (int o = 1; o < 64; o <<= 1) s2 += __shfl_xor(s2, o);
        const float rstd = 1.f / sqrtf(s2 * (1.f / DM) + LN_EPS);
        const int cond = cond_of_row(row);
#pragma unroll
        for (int q = 0; q < 4; ++q) {
            const int c = q * 256 + lane * 4;
            const f32x4 y = v[q] * rstd * *(const f32x4*)(gam + c) + *(const f32x4*)(bet + c);
            *(f32x4*)(Xo + (size_t)row * DM + c) = y;
            if (!last) {
                const f32x4 sh = *(const f32x4*)(ws.mod(ml, cond, ms) + c), sc = *(const f32x4*)(ws.mod(ml, cond, ms + 1) + c);
                *(u32x2*)(ws.H() + (size_t)row * DM + c) = pack4(y * (sc + 1.f) + sh);
            }
        }
    }
}

DEVI void out_ln_gemm_phase(PP p, const WS& ws, const bf16_t* A, int K, const bf16_t* Wt, int layer, int which, const float* xlo, const float* xhi, bool xf32, unsigned char* lds) {
    const int gchunk = which == 0 ? 2 : 5;
    const bool last = (layer == 3 && which == 1);
    const int ml = which == 0 ? layer : layer + 1, ms = which == 0 ? 3 : 0;
    const float* gam = p->in[9] + (layer * 2 + which) * DM; const float* bet = p->in[10] + (layer * 2 + which) * DM;
    float* Xo = p->out + OUT_Y;
    bf16_t* Xb = (bf16_t*)ws.X();
    float* part = ws.part() + (size_t)(layer * 2 + which) * NROW * 32;
    unsigned* cnt = (unsigned*)(ws.b + WS_BAR) + 3456 + (layer * 2 + which) * 32;
    for (int t = bid_(); t < 256; t += gridDim.x) {
        const int tm = t & 31, tn = t >> 5;
        const int cond = tm < 16 ? 0 : 1 + ((tm - 16) >> 2);
        const float* gate = ws.mod(layer, cond, gchunk);
        gemm_tile(A + (size_t)tm * 256 * K, K, Wt + (size_t)tn * 128 * K, K, K, lds,
            [&](f32x4 (&acc)[4][4], int wr, int wc, int fr, int fq) {
                const int colb = tn * 128 + wc * 64 + fq * 8;
                const int tid = (wr * 2 + wc) * 64 + fq * 16 + fr;
                {
                    f32x4 gv[4];
#pragma unroll
                    for (int n = 0; n < 4; ++n) gv[n] = *(const f32x4*)(gate + colb + (n >> 1) * 32 + (n & 1) * 4);
#pragma unroll
                    for (int i = 0; i < 4; ++i) {
                        const int row = tm * 256 + wr * 64 + i * 16 + fr;
                        const float* xp = row < NPR ? xlo + (size_t)row * DM : xhi + (size_t)(row - NPR) * DM;
                        const bf16_t* xq = Xb + (size_t)row * DM;
                        float s1 = 0.f, s2 = 0.f;
#pragma unroll
                        for (int n = 0; n < 4; ++n) {
                            f32x4 xv;
                            if (xf32) xv = *(const f32x4*)(xp + colb + (n >> 1) * 32 + (n & 1) * 4);
                            else { const u32x2 u = *(const u32x2*)(xq + colb + (n >> 1) * 32 + (n & 1) * 4); xv.x = __uint_as_float(u.x << 16); xv.y = __uint_as_float(u.x & 0xffff0000u); xv.z = __uint_as_float(u.y << 16); xv.w = __uint_as_float(u.y & 0xffff0000u); }
                            const f32x4 tv = xv * ALPHA + gv[n] * acc[i][n];
                            acc[i][n] = tv;
                            s1 += (tv.x + tv.y) + (tv.z + tv.w);
                            s2 += (tv.x * tv.x + tv.y * tv.y) + (tv.z * tv.z + tv.w * tv.w);
                        }
                        s1 += __shfl_xor(s1, 16); s1 += __shfl_xor(s1, 32);
                        s2 += __shfl_xor(s2, 16); s2 += __shfl_xor(s2, 32);
                        if (fq == 0) { float* rp = (float*)(lds + LDS_RED) + (wc * 256 + wr * 64 + i * 16 + fr) * 2; rp[0] = s1; rp[1] = s2; }
                    }
                }
                __syncthreads();
                if (tid < 256) {
                    const float* rp = (const float*)(lds + LDS_RED);
                    const float v1 = rp[tid * 2] + rp[(256 + tid) * 2], v2 = rp[tid * 2 + 1] + rp[(256 + tid) * 2 + 1];
                    __hip_atomic_store((unsigned long long*)(part + ((size_t)(tm * 8 + tn) * 256 + tid) * 2), (unsigned long long)__float_as_uint(v1) | ((unsigned long long)__float_as_uint(v2) << 32), __ATOMIC_RELAXED, __HIP_MEMORY_SCOPE_AGENT);
                }
                WAITV(0);
                __syncthreads();
                if (tid == 0) {
                    xb_add(&cnt[tm], 1u);
                    unsigned sp = 0;
                    while (xb_ld(&cnt[tm]) < 8u) { __builtin_amdgcn_s_sleep(1); if (++sp > (1u << 24)) break; }
                    __builtin_amdgcn_fence(__ATOMIC_ACQUIRE, "agent");
                    WAITV(0);
                }
                __syncthreads();
                float* stats = (float*)(lds + LDS_RED);
                if (tid < 256) {
                    const float* pp = part + ((size_t)(tm * 8) * 256 + tid) * 2;
                    float s1 = 0.f, s2 = 0.f;
                    f32x2 pv[8];
#pragma unroll
                    for (int q = 0; q < 8; ++q) pv[q] = *(const f32x2*)(pp + q * 512);
#pragma unroll
                    for (int q = 0; q < 8; ++q) { s1 += pv[q].x; s2 += pv[q].y; }
                    const float mean = s1 * (1.f / DM);
                    const float var = fmaxf(s2 * (1.f / DM) - mean * mean, 0.f);
                    stats[2 * tid] = mean; stats[2 * tid + 1] = 1.f / sqrtf(var + LN_EPS);
                }
                __syncthreads();
                const float* shp = ws.mod(ml & 3, cond, ms); const float* scp = ws.mod(ml & 3, cond, ms + 1);
#pragma unroll
                for (int np = 0; np < 2; ++np) {
                    const int c = colb + np * 32;
                    const f32x4 g4a = *(const f32x4*)(gam + c), g4b = *(const f32x4*)(gam + c + 4), b4a = *(const f32x4*)(bet + c), b4b = *(const f32x4*)(bet + c + 4);
                    f32x4 sh4a = (f32x4){0.f, 0.f, 0.f, 0.f}, sh4b = sh4a, sc4a = sh4a, sc4b = sh4a;
                    if (!last) { sh4a = *(const f32x4*)(shp + c); sh4b = *(const f32x4*)(shp + c + 4); sc4a = *(const f32x4*)(scp + c); sc4b = *(const f32x4*)(scp + c + 4); }
#pragma unroll
                    for (int i = 0; i < 4; ++i) {
                        const int rl = wr * 64 + i * 16 + fr, row = tm * 256 + rl;
                        const float mean = stats[2 * rl], rstd = stats[2 * rl + 1];
                        const f32x4 ya = (acc[i][2 * np] - mean) * rstd * g4a + b4a, yb = (acc[i][2 * np + 1] - mean) * rstd * g4b + b4b;
                        if (last) { __builtin_nontemporal_store(ya, (f32x4*)(Xo + (size_t)row * DM + c)); __builtin_nontemporal_store(yb, (f32x4*)(Xo + (size_t)row * DM + c + 4)); }
                        else {
                            const u32x2 xa = pack4(ya), xb = pack4(yb), ha = pack4(ya * (sc4a + 1.f) + sh4a), hb = pack4(yb * (sc4b + 1.f) + sh4b);
                            u32x4 xo, ho; xo.x = xa.x; xo.y = xa.y; xo.z = xb.x; xo.w = xb.y; ho.x = ha.x; ho.y = ha.y; ho.z = hb.x; ho.w = hb.y;
                            *(u32x4*)(Xb + (size_t)row * DM + c) = xo; *(u32x4*)(ws.H() + (size_t)row * DM + c) = ho;
                        }
                    }
                }
            }, (tm * 5 + tn) % (K >> 6));
    }
}

DEVI void ffn_in_phase(PP p, const WS& ws, int layer, unsigned char* lds) {
    const bf16_t* A = ws.H(); const bf16_t* Wt = ws.wt_ffnin(layer); bf16_t* ACT = ws.act();
    for (int t = bid_(); t < 32 * 22; t += gridDim.x) {
        const int tm = t & 31, tn = t >> 5;
        gemm_tile8p(A + (size_t)tm * 256 * DM, Wt + (size_t)tn * 256 * DM, DM, lds,
            [&](f32x4 (&acc)[2][2][4][2], int wr, int wc, int fr, int fq) {
#pragma unroll
                for (int ai = 0; ai < 2; ++ai)
#pragma unroll
                    for (int m = 0; m < 4; ++m) {
                        const int row = tm * 256 + ai * 128 + wr * 64 + m * 16 + fr;
                        u32x4 o8;
#pragma unroll
                        for (int n = 0; n < 2; ++n) {
                            const f32x4 g = acc[ai][0][m][n], u = acc[ai][1][m][n];
                            f32x4 r; r.x = siluf_(g.x) * u.x; r.y = siluf_(g.y) * u.y; r.z = siluf_(g.z) * u.z; r.w = siluf_(g.w) * u.w;
                            const u32x2 pk = pack4(r);
                            if (n == 0) { o8.x = pk.x; o8.y = pk.y; } else { o8.z = pk.x; o8.w = pk.y; }
                        }
                        *(u32x4*)(ACT + (size_t)row * DFF + tn * 128 + wc * 32 + fq * 8) = o8;
                    }
            });
    }
    if (gridDim.x == 256 && bid_() >= 192 && layer < 3) {
        const int lo = layer == 0 ? WT_L0_END : layer == 1 ? WT_B_END : WT_C_END, hi = layer == 0 ? WT_A_END : layer == 1 ? WT_C_END : WT_D_END;
        wt_all(p, ws, lo + (bid_() - 192), 64, hi, lds);
    }
}

DEVI void glu_phase(const WS& ws, int j, unsigned char* lds) {
    const bf16_t* A = ws.bufa(); const bf16_t* Wt = ws.wt_glu(j); bf16_t* O = ws.bufb();
    for (int t = bid_(); t < 32 * 8; t += gridDim.x) {
        const int tm = t & 31, tn = t >> 5;
        gemm_tile8p(A + (size_t)tm * 256 * DM, Wt + (size_t)tn * 256 * DM, DM, lds,
            [&](f32x4 (&acc)[2][2][4][2], int wr, int wc, int fr, int fq) {
#pragma unroll
                for (int ai = 0; ai < 2; ++ai)
#pragma unroll
                    for (int m = 0; m < 4; ++m) {
                        const int row = tm * 256 + ai * 128 + wr * 64 + m * 16 + fr;
                        u32x4 o8;
#pragma unroll
                        for (int n = 0; n < 2; ++n) {
                            const f32x4 v = acc[ai][0][m][n], g = acc[ai][1][m][n];
                            f32x4 r; r.x = v.x * sigmoidf_(g.x); r.y = v.y * sigmoidf_(g.y); r.z = v.z * sigmoidf_(g.z); r.w = v.w * sigmoidf_(g.w);
                            const u32x2 pk = pack4(r);
                            if (n == 0) { o8.x = pk.x; o8.y = pk.y; } else { o8.z = pk.x; o8.w = pk.y; }
                        }
                        *(u32x4*)(O + (size_t)row * DM + tn * 128 + wc * 32 + fq * 8) = o8;
                    }
            });
    }
}

DEVI void s5_in_phase(const WS& ws, int j, unsigned char* lds) {
    const bf16_t* A = ws.H(); const bf16_t* Wt = ws.wt_s5in(j); bf16_t* Uc = ws.act();
    for (int t = bid_(); t < 256; t += gridDim.x) {
        const int tm = t & 31, tn = t >> 5;
        gemm_tile(A + (size_t)tm * 256 * DM, DM, Wt + (size_t)tn * 128 * DM, DM, DM, lds,
            [&](f32x4 (&acc)[4][4], int wr, int wc, int fr, int fq) {
#pragma unroll
                for (int i = 0; i < 4; ++i) {
                    const int chunk = tm * 16 + wr * 4 + i;
#pragma unroll
                    for (int n = 0; n < 4; ++n) {
                        const int g = tn * 8 + wc * 4 + n;
                        *(u32x2*)(Uc + ((size_t)chunk * 64 + g) * 256 + fr * 16 + fq * 4) = pack4(acc[i][n]);
                    }
                }
            }, (tm * 5 + tn) & 15);
    }
}

DEVI void s5_chunk_phase(PP p, const WS& ws, int j, unsigned char* lds) {
    const bf16_t* Uc = ws.act(); bf16_t* Yi = (bf16_t*)ws.T(); bf16_t* Ss = ws.bufb();
    for (int it0 = bid_(); it0 < 512; it0 += gridDim.x) {
        const int it = it0 < 256 ? it0 : (it0 ^ 2);
        const int g = it >> 3, ct = (it >> 2) & 1, mt = it & 3;
        gemm_tile(Uc + ((size_t)ct * 256 * 64 + g) * 256, 16384, ws.mg(j, g) + (size_t)mt * 128 * 256, 256, 256, lds,
            [&](f32x4 (&acc)[4][4], int wr, int wc, int fr, int fq) {
                if (mt < 2) {
#pragma unroll
                    for (int i = 0; i < 4; ++i) {
                        const int chunk = ct * 256 + wr * 64 + i * 16 + fr;
#pragma unroll
                        for (int n = 0; n < 4; ++n) { const int tt = mt * 8 + wc * 4 + n; *(u32x2*)(Yi + (size_t)(chunk * 16 + tt) * DM + g * 16 + fq * 4) = pack4(acc[i][n]); }
                    }
                } else {
                    const int dir = mt - 2, tid = (wr * 2 + wc) * 64 + fq * 16 + fr;
                    float* sl = (float*)lds;
                    __syncthreads();
#pragma unroll
                    for (int i = 0; i < 4; ++i)
#pragma unroll
                        for (int n = 0; n < 4; ++n) *(f32x4*)(sl + (wr * 64 + i * 16 + fr) * 128 + wc * 64 + n * 16 + fq * 4) = acc[i][n];
                    __syncthreads();
                    const int nchain = ct == 0 ? 1024 : 256, n = ct == 0 ? 16 : 64;
                    for (int c = tid; c < nchain; c += NTHR) {
                        const int b = c >> 6, pp = c & 63, base = b * n;
                        const float* l16 = ws.lam16() + ((size_t)((j * 2 + dir) * 64 + g) * 64 + pp) * 2;
                        const float lr = l16[0], li = l16[1];
                        float sr = 0.f, si = 0.f;
                        const size_t so = ((((size_t)(b * 2 + j) * 2 + dir) * 2 + 0) * 64 + g) * 64 + pp;
                        if (ct == 1) { sr = p->in[5][so]; si = p->in[5][so + 4096]; }
                        for (int q = 0; q < n; ++q) {
                            const int lc = dir == 0 ? base + q : base + n - 1 - q;
                            const size_t o = ((size_t)(ct * 256 + lc) * 64 + g) * 256 + dir * 128 + pp;
                            Ss[o] = (bf16_t)(cvt_pk(sr, sr) & 0xffffu); Ss[o + 64] = (bf16_t)(cvt_pk(si, si) & 0xffffu);
                            const float ar = sl[lc * 128 + pp], ai = sl[lc * 128 + 64 + pp];
                            const float nr = lr * sr - li * si + ar; si = lr * si + li * sr + ai; sr = nr;
                        }
                        if (ct == 0) { p->out[OUT_S + so] = sr; p->out[OUT_S + so + 4096] = si; }
                    }
                }
            });
    }
}

DEVI void s5_y_phase(const WS& ws, int j, unsigned char* lds) {
    const bf16_t* Ss = ws.bufb(); const bf16_t* Yi = (const bf16_t*)ws.T(); bf16_t* Z = ws.bufa();
    for (int it = bid_(); it < 256; it += gridDim.x) {
        const int g = it >> 2, ct = (it >> 1) & 1, mt = it & 1;
        gemm_tile(Ss + ((size_t)ct * 256 * 64 + g) * 256, 16384, ws.vg(j, g) + (size_t)mt * 128 * 256, 256, 256, lds,
            [&](f32x4 (&acc)[4][4], int wr, int wc, int fr, int fq) {
#pragma unroll
                for (int i = 0; i < 4; ++i) {
                    const int chunk = ct * 256 + wr * 64 + i * 16 + fr;
#pragma unroll
                    for (int n = 0; n < 4; ++n) {
                        const int tt = mt * 8 + wc * 4 + n;
                        const size_t o = (size_t)(chunk * 16 + tt) * DM + g * 16 + fq * 4;
                        const u32x2 yu = *(const u32x2*)(Yi + o);
                        f32x4 y = acc[i][n]; y.x += __uint_as_float(yu.x << 16); y.y += __uint_as_float(yu.x & 0xffff0000u); y.z += __uint_as_float(yu.y << 16); y.w += __uint_as_float(yu.y & 0xffff0000u);
                        f32x4 z; z.x = gelu_tanh(y.x); z.y = gelu_tanh(y.y); z.z = gelu_tanh(y.z); z.w = gelu_tanh(y.w);
                        *(u32x2*)(Z + o) = pack4(z);
                    }
                }
            });
    }
}

DEVI void qkv_phase(PP p, const WS& ws, int j, unsigned char* lds) {
    const bf16_t* A = ws.H(); const bf16_t* Wt = ws.wt_qkv(j);
    for (int t = bid_(); t < 32 * 6; t += gridDim.x) {
        const int tm = t & 31, tn = t >> 5;
        if (tn == 5) {
            gemm_tile8p<false>(A + (size_t)tm * 256 * DM, Wt + (size_t)tn * 256 * DM, DM, lds,
                [&](f32x4 (&acc)[2][2][4][2], int wr, int wc, int fr, int fq) {
                    const bool sample = tm >= 16;
                    const int b = sample ? (tm - 16) >> 2 : tm;
                    const int lq = sample ? ((tm - 16) & 3) * 256 : 0, skv = sample ? 1536 : 256;
#pragma unroll
                    for (int bj = 0; bj < 2; ++bj) {
                        bf16_t* vt = (sample ? ws.vts(j) : ws.vtp()) + (size_t)(b * 2 + bj) * 128 * skv;
#pragma unroll
                        for (int n = 0; n < 2; ++n) {
                            const int d = (wc >> 1) * 64 + n * 32 + (wc & 1) * 16 + fr;
#pragma unroll
                            for (int ai = 0; ai < 2; ++ai)
#pragma unroll
                                for (int m = 0; m < 4; ++m) {
                                    const int l = lq + ai * 128 + wr * 64 + m * 16 + fq * 4;
                                    *(u32x2*)(vt + (size_t)d * skv + l) = pack4(acc[ai][bj][m][n]);
                                    if (!sample) { float* o = p->out + OUT_V + ((((size_t)b * 2 + j) * 256 + l) * 2 + bj) * 128 + d; o[0] = acc[ai][bj][m][n].x; o[256] = acc[ai][bj][m][n].y; o[512] = acc[ai][bj][m][n].z; o[768] = acc[ai][bj][m][n].w; }
                                }
                        }
                    }
                });
            continue;
        }
        gemm_tile8p(A + (size_t)tm * 256 * DM, Wt + (size_t)tn * 256 * DM, DM, lds,
            [&](f32x4 (&acc)[2][2][4][2], int wr, int wc, int fr, int fq) {
                const bool sample = tm >= 16;
                const int b = sample ? (tm - 16) >> 2 : tm;
                const int lq = sample ? ((tm - 16) & 3) * 256 : 0;
                const int d0 = (wc >> 1) * 64 + (wc & 1) * 16 + fq * 4;
                {
                    float* red = (float*)(lds + 131072);
#pragma unroll
                    for (int ai = 0; ai < 2; ++ai)
#pragma unroll
                        for (int bj = 0; bj < 2; ++bj)
#pragma unroll
                            for (int m = 0; m < 4; ++m) {
                                const f32x4 u = acc[ai][bj][m][0], v = acc[ai][bj][m][1];
                                float ssq = (u.x * u.x + u.y * u.y) + (u.z * u.z + u.w * u.w) + (v.x * v.x + v.y * v.y) + (v.z * v.z + v.w * v.w);
                                ssq += __shfl_xor(ssq, 16); ssq += __shfl_xor(ssq, 32);
                                if (fq == 0) red[((((ai * 2 + bj) * 2 + wr) * 4 + m) * 16 + fr) * 4 + wc] = ssq;
                            }
                    __syncthreads();
                    const float* gain = (tn < 4 ? p->in[23] : p->in[24]) + j * 128;
                    const f32x4 g0 = *(const f32x4*)(gain + d0), g1 = *(const f32x4*)(gain + d0 + 32);
                    const float* rope = ws.rope();
#pragma unroll
                    for (int ai = 0; ai < 2; ++ai)
#pragma unroll
                        for (int m = 0; m < 4; ++m) {
                            const int rl = ai * 128 + wr * 64 + m * 16 + fr, row = tm * 256 + rl, l = lq + rl;
                            f32x4 r0 = (f32x4){1.f, 0.f, 1.f, 0.f}, r1 = r0;
                            if (sample) { const int pos = (wc >> 1) == 0 ? (l >> 6) : (l & 63); const float* rp = rope + (pos * 32 + (wc & 1) * 16 + fq * 4) * 2; r0 = *(const f32x4*)rp; r1 = *(const f32x4*)(rp + 4); }
#pragma unroll
                            for (int bj = 0; bj < 2; ++bj) {
                                const f32x4 q4 = *(const f32x4*)(red + ((((ai * 2 + bj) * 2 + wr) * 4 + m) * 16 + fr) * 4);
                                const float rstd = 1.f / sqrtf(((q4.x + q4.y) + (q4.z + q4.w)) * (1.f / 128.f) + RMS_EPS);
                                const f32x4 x1 = acc[ai][bj][m][0] * rstd * g0, x2 = acc[ai][bj][m][1] * rstd * g1;
                                f32x4 y1, y2;
                                y1.x = x1.x * r0.x - x2.x * r0.y; y2.x = x2.x * r0.x + x1.x * r0.y;
                                y1.y = x1.y * r0.z - x2.y * r0.w; y2.y = x2.y * r0.z + x1.y * r0.w;
                                y1.z = x1.z * r1.x - x2.z * r1.y; y2.z = x2.z * r1.x + x1.z * r1.y;
                                y1.w = x1.w * r1.z - x2.w * r1.w; y2.w = x2.w * r1.z + x1.w * r1.w;
                                if (tn < 4) {
                                    bf16_t* qp = ws.bufa() + (size_t)row * DM + (tn * 2 + bj) * 128 + d0;
                                    *(u32x2*)qp = pack4(y1); *(u32x2*)(qp + 32) = pack4(y2);
                                } else {
                                    const int kvh = bj;
                                    bf16_t* kp = sample ? ws.ks(j) + ((size_t)(b * 2 + kvh) * 1536 + l) * 128 + d0 : ws.kp() + ((size_t)(b * 2 + kvh) * 256 + l) * 128 + d0;
                                    *(u32x2*)kp = pack4(y1); *(u32x2*)(kp + 32) = pack4(y2);
                                    if (!sample) { float* o = p->out + OUT_K + ((((size_t)b * 2 + j) * 256 + l) * 2 + kvh) * 128 + d0; __builtin_nontemporal_store(y1, (f32x4*)o); __builtin_nontemporal_store(y2, (f32x4*)(o + 32)); }
                                }
                            }
                        }
                }
            });
    }    if (gridDim.x == 256 && bid_() >= 192) {
        const int lo = j == 0 ? WT_A_END : WT_D_END, hi = j == 0 ? WT_B_END : WT_TOT, ib = bid_() - 192;
        if (j == 0) {
            for (int q = ib; q < 128; q += 64) adaln_item(p, ws, 192 + q, lds);
        } else {
            adaln_item(p, ws, 320 + ib, lds);
        }
        wt_all(p, ws, lo + ib, 64, hi, lds);
    }
}

constexpr int AT_KROW = 288, AT_VROW = 288, AT_KB = 64 * AT_KROW, AT_VB = 128 * AT_VROW, AT_STAGE = AT_KB + AT_VB;
DEVI void attn_phase(const WS& ws, int j, unsigned char* lds) {
    const int tid = tid_(), lane = tid & 63, w = tid >> 6, fr = lane & 15, fq = lane >> 4;
    const bf16_t* Q = ws.bufa(); bf16_t* AO = ws.bufb();
    for (int it = bid_(); it < 512; it += gridDim.x) {
        int b, h, qb, skv, row0; const bf16_t *Kb, *Vb;
        if (it < 256) { b = it >> 6; h = (it >> 3) & 7; qb = it & 7; skv = 1536; row0 = NPR + b * 1024 + qb * 128;
            Kb = ws.ks(j) + (size_t)(b * 2 + (h >> 2)) * 1536 * 128; Vb = ws.vts(j) + (size_t)(b * 2 + (h >> 2)) * 128 * 1536; }
        else { const int i2 = it - 256; b = i2 >> 4; h = (i2 >> 1) & 7; qb = i2 & 1; skv = 256; row0 = b * 256 + qb * 128;
            Kb = ws.kp() + (size_t)(b * 2 + (h >> 2)) * 256 * 128; Vb = ws.vtp() + (size_t)(b * 2 + (h >> 2)) * 128 * 256; }
        const int qrow = row0 + w * 16 + fr;
        bf16x8 qf[4];
#pragma unroll
        for (int s = 0; s < 4; ++s) qf[s] = *(const bf16x8*)(Q + (size_t)qrow * DM + h * 128 + s * 32 + fq * 8);
        f32x4 o[8];
#pragma unroll
        for (int m = 0; m < 8; ++m) o[m] = (f32x4){0.f, 0.f, 0.f, 0.f};
        float mrun = -1e30f, lrun = 0.f;
        const int kr0 = tid >> 4, kc = tid & 15;
        const int vr0 = tid >> 3, vc = tid & 7;
        const int vs = vc >> 2, vu = vc & 3;
        const int vslot_lo = vs * 32 + (2 * (vu & 1)) * 8 + (vu >> 1) * 4, vslot_hi = vslot_lo + 8;
        const bf16_t* gk = Kb + (size_t)kr0 * 128 + kc * 8;
        const bf16_t* gv = Vb + (size_t)vr0 * skv + vc * 8;
        u32x4 rk[2], rv[2];
        const int nt = skv >> 6;
        rk[0] = *(const u32x4*)(gk); rk[1] = *(const u32x4*)(gk + 32 * 128);
        rv[0] = *(const u32x4*)(gv); rv[1] = *(const u32x4*)(gv + (size_t)64 * skv);
        {
            unsigned char* sk = lds; unsigned char* sv = lds + AT_KB;
            *(u32x4*)(sk + kr0 * AT_KROW + kc * 16) = rk[0]; *(u32x4*)(sk + (kr0 + 32) * AT_KROW + kc * 16) = rk[1];
#pragma unroll
            for (int q = 0; q < 2; ++q) {
                unsigned char* r = sv + (vr0 + 64 * q) * AT_VROW;
                u32x2 lo; lo.x = rv[q].x; lo.y = rv[q].y; u32x2 hi; hi.x = rv[q].z; hi.y = rv[q].w;
                *(u32x2*)(r + vslot_lo * 2) = lo; *(u32x2*)(r + vslot_hi * 2) = hi;
            }
        }
        __syncthreads();
        for (int kt = 0; kt < nt; ++kt) {
            const bool more = kt + 1 < nt;
            if (more) {
                const int k0 = (kt + 1) * 64;
                rk[0] = *(const u32x4*)(gk + (size_t)k0 * 128); rk[1] = *(const u32x4*)(gk + (size_t)(k0 + 32) * 128);
                rv[0] = *(const u32x4*)(gv + k0); rv[1] = *(const u32x4*)(gv + (size_t)64 * skv + k0);
            }
            const unsigned char* sk = lds + (kt & 1) * AT_STAGE; const unsigned char* sv = sk + AT_KB;
            f32x4 sc[4];
#pragma unroll
            for (int t = 0; t < 4; ++t) {
                sc[t] = (f32x4){0.f, 0.f, 0.f, 0.f};
#pragma unroll
                for (int s = 0; s < 4; ++s) {
                    const bf16x8 kf = *(const bf16x8*)(sk + (t * 16 + fr) * AT_KROW + s * 64 + fq * 16);
                    sc[t] = __builtin_amdgcn_mfma_f32_16x16x32_bf16(kf, qf[s], sc[t], 0, 0, 0);
                }
            }
            bf16x8 vfr[8][2];
#pragma unroll
            for (int m = 0; m < 8; ++m)
#pragma unroll
                for (int s = 0; s < 2; ++s) vfr[m][s] = *(const bf16x8*)(sv + (m * 16 + fr) * AT_VROW + s * 64 + fq * 16);
            float mx = sc[0].x;
#pragma unroll
            for (int t = 0; t < 4; ++t) mx = fmaxf(fmaxf(fmaxf(mx, sc[t].x), fmaxf(sc[t].y, sc[t].z)), sc[t].w);
            mx = fmaxf(mx, __shfl_xor(mx, 16)); mx = fmaxf(mx, __shfl_xor(mx, 32));
            const float mnew = fmaxf(mrun, mx);
            const float alpha = __builtin_amdgcn_exp2f((mrun - mnew) * SM_C);
            mrun = mnew;
            const float mb = -mnew * SM_C;
            float ls = 0.f;
#pragma unroll
            for (int t = 0; t < 4; ++t) {
                sc[t].x = __builtin_amdgcn_exp2f(sc[t].x * SM_C + mb); sc[t].y = __builtin_amdgcn_exp2f(sc[t].y * SM_C + mb);
                sc[t].z = __builtin_amdgcn_exp2f(sc[t].z * SM_C + mb); sc[t].w = __builtin_amdgcn_exp2f(sc[t].w * SM_C + mb);
                ls += (sc[t].x + sc[t].y) + (sc[t].z + sc[t].w);
            }
            lrun = lrun * alpha + ls;
#pragma unroll
            for (int m = 0; m < 8; ++m) o[m] = o[m] * alpha;
            bf16x8 pf[2];
#pragma unroll
            for (int s = 0; s < 2; ++s) {
                u32x4 u; u.x = cvt_pk(sc[2 * s].x, sc[2 * s].y); u.y = cvt_pk(sc[2 * s].z, sc[2 * s].w);
                u.z = cvt_pk(sc[2 * s + 1].x, sc[2 * s + 1].y); u.w = cvt_pk(sc[2 * s + 1].z, sc[2 * s + 1].w);
                pf[s] = __builtin_bit_cast(bf16x8, u);
            }
#pragma unroll
            for (int m = 0; m < 8; ++m)
#pragma unroll
                for (int s = 0; s < 2; ++s) o[m] = __builtin_amdgcn_mfma_f32_16x16x32_bf16(vfr[m][s], pf[s], o[m], 0, 0, 0);
            if (more) {
                unsigned char* wk = lds + ((kt + 1) & 1) * AT_STAGE; unsigned char* wv = wk + AT_KB;
                *(u32x4*)(wk + kr0 * AT_KROW + kc * 16) = rk[0]; *(u32x4*)(wk + (kr0 + 32) * AT_KROW + kc * 16) = rk[1];
#pragma unroll
                for (int q = 0; q < 2; ++q) {
                    unsigned char* r = wv + (vr0 + 64 * q) * AT_VROW;
                    u32x2 lo; lo.x = rv[q].x; lo.y = rv[q].y; u32x2 hi; hi.x = rv[q].z; hi.y = rv[q].w;
                    *(u32x2*)(r + vslot_lo * 2) = lo; *(u32x2*)(r + vslot_hi * 2) = hi;
                }
            }
            __syncthreads();
        }
        float l = lrun; l += __shfl_xor(l, 16); l += __shfl_xor(l, 32);
        const float inv = 1.f / l;
#pragma unroll
        for (int m = 0; m < 8; ++m) *(u32x2*)(AO + (size_t)qrow * DM + h * 128 + m * 16 + fq * 4) = pack4(o[m] * inv);
    }
}

constexpr int N_PHASES = 1 + 7 + 5 + 7 + 5;
#ifndef REP_FFNIN
#define REP_FFNIN 1
#endif
#ifndef REP_ATTN
#define REP_ATTN 1
#endif
#ifndef REP_PREP
#define REP_PREP 1
#endif
#ifndef DBG_N
#define DBG_N 1000
#endif
DEVI void run_phase(PP p, const WS& ws, int ph, unsigned char* lds) {
    if (ph == 0) { for (int rep = 0; rep < REP_PREP; ++rep) prep_a(p, ws, lds); return; }
    int r = ph - 1, layer = 0;
    if (r >= 7) { r -= 7; layer = 1; if (r >= 5) { r -= 5; layer = 2; if (r >= 7) { r -= 7; layer = 3; } } }
    const int j = layer >> 1;
    const bool s5 = (layer & 1) == 0;
    const float* xlo = layer == 0 ? p->in[0] : ws.X();
    const float* xhi = layer == 0 ? p->in[1] : ws.X() + (size_t)NPR * DM;
    int k = r;
    if (s5) {
        if (r == 0) { s5_in_phase(ws, j, lds); return; }
        if (r == 1) { s5_chunk_phase(p, ws, j, lds); return; }
        if (r == 2) { s5_y_phase(ws, j, lds); return; }
        if (r == 3) { glu_phase(ws, j, lds); return; }
        k = r - 4;
        if (k == 0) { out_ln_gemm_phase(p, ws, ws.bufb(), DM, ws.wt_s5out(j), layer, 0, xlo, xhi, layer == 0, lds); return; }
    } else {
        if (r == 0) { qkv_phase(p, ws, j, lds); return; }
        if (r == 1) { for (int rep = 0; rep < REP_ATTN; ++rep) attn_phase(ws, j, lds); return; }
        k = r - 2;
        if (k == 0) { out_ln_gemm_phase(p, ws, ws.bufb(), DM, ws.wt_o(j), layer, 0, xlo, xhi, layer == 0, lds); return; }
    }
    if (k == 1) { for (int rep = 0; rep < REP_FFNIN; ++rep) ffn_in_phase(p, ws, layer, lds); return; }
    out_ln_gemm_phase(p, ws, ws.act(), DFF, ws.wt_ffnout(layer), layer, 1, xlo, xhi, false, lds);
}

__global__ void __launch_bounds__(NTHR) mega(Params p_) {
    extern __shared__ __attribute__((aligned(16))) unsigned char lds[];
    volatile LAS unsigned* xbw = (volatile LAS unsigned*)(LAS unsigned char*)(lds + LDS_XB);
    if (threadIdx.x < 4) xbw[threadIdx.x] = 0u;
    __syncthreads();
    const int ph_lo = p_.ph_lo, ph_hi = p_.ph_hi;
    XcdBarrier xb = xcd_barrier_post((unsigned*)(p_.ws + WS_BAR), xbw);
    for (int ph = ph_lo; ph < ph_hi; ++ph) {
        {
            PP p = (PP)__builtin_amdgcn_kernarg_segment_ptr();
            asm volatile("" : "+s"(p));
            WS ws; ws.b = p->ws;
            run_phase(p, ws, ph, lds);
#ifdef DBG_TWICE
            if (ph == 2) { xcd_barrier(xb); run_phase(p, ws, ph, lds); }
#endif
        }
        if (ph + 1 < ph_hi) {
#if USE_CG
            cg::this_grid().sync();
#else
            if (ph_hi < 0) cg::this_grid().sync();
            xcd_barrier(xb);
#endif
        }
    }
}

extern "C" void kernel_launch(void* const* d_in, const int* in_sizes, int n_in, void* d_out, int out_size, void* d_ws, size_t ws_size, hipStream_t stream) {
    static int grid = 0;
    if (grid == 0) {
        if (n_in != 28 || ws_size < WS_END) { fprintf(stderr, "kernel_launch: unexpected n_in %d or ws_size %zu (< %zu)\n", n_in, ws_size, (size_t)WS_END); grid = -1; return; }
        int dev = 0, cus = 0, per_cu = 0;
        (void)hipGetDevice(&dev);
        (void)hipDeviceGetAttribute(&cus, hipDeviceAttributeMultiprocessorCount, dev);
        (void)hipFuncSetAttribute((const void*)mega, hipFuncAttributeMaxDynamicSharedMemorySize, LDS_BYTES);
        (void)hipOccupancyMaxActiveBlocksPerMultiprocessor(&per_cu, (const void*)mega, NTHR, LDS_BYTES);
        (void)hipGetLastError();
        if (per_cu < 1) per_cu = 1;
        grid = cus * 1;
    }
    if (grid < 0) return;
    (void)hipMemsetAsync((unsigned char*)d_ws + WS_BAR, 0, 16384, stream);
    Params p{};
    for (int i = 0; i < 28; ++i) p.in[i] = (const float*)d_in[i];
    p.out = (float*)d_out; p.ws = (unsigned char*)d_ws; p.ph_lo = 0; p.ph_hi = N_PHASES;
    void* args[] = {&p};
    hipError_t e = hipLaunchCooperativeKernel((const void*)mega, dim3(grid), dim3(NTHR), args, LDS_BYTES, stream);
    if (e != hipSuccess) fprintf(stderr, "cooperative launch failed: %s (grid %d)\n", hipGetErrorString(e), grid);
}
```
